# Optimizing an MI355X kernel written in HIP

```python
import math
import jax, jax.numpy as jnp
from jax import lax
import numpy as np

D_MODEL = 2048
BATCH = 4
SEQ = 4096
DEPTH = 1

CHUNK = 64
EPS = 1e-6
FOX_HEADS = 8
FOX_HEAD_DIM = 128
FOX_WIDTH = FOX_HEADS * FOX_HEAD_DIM
Q_BLOCK = 128
HGRN_HEADS = 8
HGRN_DK = 128
HGRN_DV = 128
HGRN_KW = HGRN_HEADS * HGRN_DK
HGRN_VW = HGRN_HEADS * HGRN_DV
COL_SIZES = (FOX_WIDTH, FOX_WIDTH, FOX_WIDTH, FOX_HEADS,
             HGRN_KW, HGRN_KW, HGRN_VW, HGRN_VW,
             D_MODEL, D_MODEL)
N_COLS = sum(COL_SIZES)
N_GROUPS = 4
EXPERTS_PER_GROUP = 8
N_EXPERTS = N_GROUPS * EXPERTS_PER_GROUP
TOP_K = 2
D_FF_EXPERT = 1024
MOE_BLOCK = 256

kernel_name = "fox_hgrn2_gated_hier_moe_block"


def rms_norm(x, g):
    x32 = x.astype(jnp.float32)
    y = x32 * lax.rsqrt(jnp.mean(x32 * x32, axis=-1, keepdims=True) + EPS)
    return (y * g.astype(jnp.float32)).astype(x.dtype)


def forgetting_attention(q, k, v, log_f):
    seq = q.shape[2]
    c = jnp.cumsum(log_f, axis=-1)
    scale = FOX_HEAD_DIM ** -0.5
    outs = []
    for blk in range(seq // Q_BLOCK):
        lo, hi = blk * Q_BLOCK, (blk + 1) * Q_BLOCK
        s = jnp.einsum('bhqd,bhkd->bhqk', q[:, :, lo:hi], k[:, :, :hi]).astype(jnp.float32) * scale
        s = s + c[:, :, lo:hi, None] - c[:, :, None, :hi]
        mask = jnp.arange(hi)[None, :] <= jnp.arange(lo, hi)[:, None]
        p = jax.nn.softmax(jnp.where(mask, s, -jnp.inf), axis=-1)
        outs.append(jnp.einsum('bhqk,bhkd->bhqd', p.astype(v.dtype), v[:, :, :hi]))
    return jnp.concatenate(outs, axis=2)


def hgrn2_chunkwise(q, k, v, log_f):
    b_, h_, seq, dk = q.shape
    dv = v.shape[-1]
    nc = seq // CHUNK

    def to_chunks(t):
        return t.reshape(b_, h_, nc, CHUNK, t.shape[-1]).transpose(2, 0, 1, 3, 4)

    causal = jnp.tril(jnp.ones((CHUNK, CHUNK), dtype=bool))[:, :, None]

    def step(state, inp):
        qc, kc, vc, lfc = inp
        b = jnp.cumsum(lfc, axis=2)
        inter = jnp.einsum('bhtk,bhkv->bhtv', qc * jnp.exp(b), state)
        diff = b[:, :, :, None, :] - b[:, :, None, :, :]
        decay = jnp.exp(jnp.where(causal, diff, -jnp.inf))
        scores = jnp.einsum('bhtsk,bhsk->bhts', qc[:, :, :, None, :] * decay, kc)
        intra = jnp.einsum('bhts,bhsv->bhtv', scores, vc)
        b_last = b[:, :, -1:, :]
        new_state = jnp.exp(b_last[:, :, 0, :, None]) * state + \
            jnp.einsum('bhsk,bhsv->bhkv', kc * jnp.exp(b_last - b), vc)
        return new_state, inter + intra

    state0 = jnp.zeros((b_, h_, dk, dv), jnp.float32)
    _, out = lax.scan(step, state0, (to_chunks(q), to_chunks(k), to_chunks(v), to_chunks(log_f)))
    return out.transpose(1, 2, 0, 3, 4).reshape(b_, h_, seq, dv)


def expert_ffn(xb, w1, w3, w2):
    return (jax.nn.silu(xb @ w1) * (xb @ w3)) @ w2


def hier_moe(h, w_group, b_group, w_expert, b_expert, w1, w3, w2):
    t_tok, d = h.shape
    pg = jax.nn.softmax((h @ w_group + b_group).astype(jnp.float32), axis=-1)
    g_w, g_idx = lax.top_k(pg, 1)
    le = (h @ w_expert + b_expert).astype(jnp.float32).reshape(t_tok, N_GROUPS, EXPERTS_PER_GROUP)
    le_g = jnp.einsum('tge,tg->te', le, jax.nn.one_hot(g_idx[:, 0], N_GROUPS, dtype=jnp.float32))
    pe = jax.nn.softmax(le_g, axis=-1)
    top_w, top_i = lax.top_k(pe, TOP_K)
    top_w = top_w / jnp.sum(top_w, axis=-1, keepdims=True)
    gate = (g_w * top_w).reshape(-1)
    e_flat = (g_idx * EXPERTS_PER_GROUP + top_i).reshape(-1).astype(jnp.int32)
    tok_flat = jnp.repeat(jnp.arange(t_tok, dtype=jnp.int32), TOP_K)
    n_assign = t_tok * TOP_K

    order = jnp.argsort(e_flat)
    e_s, tok_s, w_s = e_flat[order], tok_flat[order], gate[order]
    counts = jnp.bincount(e_flat, length=N_EXPERTS)
    padded = ((counts + MOE_BLOCK - 1) // MOE_BLOCK) * MOE_BLOCK
    pad_end = jnp.cumsum(padded)
    pad_start = pad_end - padded
    start = jnp.cumsum(counts) - counts
    dest = pad_start[e_s] + (jnp.arange(n_assign) - start[e_s])
    n_blocks = -(-n_assign // MOE_BLOCK) + N_EXPERTS
    x_buf = jnp.zeros((n_blocks * MOE_BLOCK, d), h.dtype).at[dest].set(h[tok_s])
    blk_start = jnp.arange(n_blocks) * MOE_BLOCK
    blk_expert = jnp.minimum(jnp.sum(pad_end[None, :] <= blk_start[:, None], axis=1), N_EXPERTS - 1)

    def run_block(args):
        xb, e = args
        return expert_ffn(xb, w1[e], w3[e], w2[e])

    y_buf = lax.map(run_block, (x_buf.reshape(n_blocks, MOE_BLOCK, d), blk_expert)).reshape(-1, d)
    y = y_buf[dest] * w_s[:, None].astype(h.dtype)
    return jax.ops.segment_sum(y, tok_s, num_segments=t_tok)


def setup_inputs(seed: int = 0) -> dict:
    key = jax.random.key(seed)
    ks = jax.random.split(key, 20)
    f32 = jnp.float32
    nrm = lambda k, shape, s: jax.random.normal(k, shape, f32) * s
    return {
        "x": jax.random.normal(ks[0], (BATCH, SEQ, D_MODEL), f32),
        "norm_mix_g": 1.0 + nrm(ks[1], (DEPTH, D_MODEL), 0.02),
        "w_in": nrm(ks[2], (DEPTH, D_MODEL, N_COLS), D_MODEL ** -0.5),
        "b_fgate": 2.0 + nrm(ks[3], (DEPTH, FOX_HEADS), 0.5),
        "hgrn_lb_logits": nrm(ks[4], (DEPTH + 1, HGRN_KW), 0.5),
        "hgrn_norm_g": 1.0 + nrm(ks[5], (DEPTH, HGRN_VW), 0.02),
        "w_branch_a": nrm(ks[6], (DEPTH, FOX_WIDTH, D_MODEL), FOX_WIDTH ** -0.5),
        "w_branch_b": nrm(ks[7], (DEPTH, HGRN_VW, D_MODEL), HGRN_VW ** -0.5),
        "w_out": nrm(ks[8], (DEPTH, D_MODEL, D_MODEL), D_MODEL ** -0.5),
        "norm_ffn_g": 1.0 + nrm(ks[9], (DEPTH, D_MODEL), 0.02),
        "w_group": nrm(ks[10], (DEPTH, D_MODEL, N_GROUPS), D_MODEL ** -0.5),
        "b_group": nrm(ks[11], (DEPTH, N_GROUPS), 0.01),
        "w_expert": nrm(ks[12], (DEPTH, D_MODEL, N_EXPERTS), D_MODEL ** -0.5),
        "b_expert": nrm(ks[13], (DEPTH, N_EXPERTS), 0.01),
        "moe_w1": nrm(ks[14], (DEPTH, N_EXPERTS, D_MODEL, D_FF_EXPERT), D_MODEL ** -0.5),
        "moe_w3": nrm(ks[15], (DEPTH, N_EXPERTS, D_MODEL, D_FF_EXPERT), D_MODEL ** -0.5),
        "moe_w2": nrm(ks[16], (DEPTH, N_EXPERTS, D_FF_EXPERT, D_MODEL), D_FF_EXPERT ** -0.5),
        "norm_final_g": 1.0 + nrm(ks[17], (D_MODEL,), 0.02),
    }


def reference(x, norm_mix_g, w_in, b_fgate, hgrn_lb_logits, hgrn_norm_g, w_branch_a, w_branch_b,
              w_out, norm_ffn_g, w_group, b_group, w_expert, b_expert, moe_w1, moe_w3, moe_w2,
              norm_final_g):
    bsz, seq, d = x.shape
    f32 = jnp.float32
    split_idx = list(np.cumsum(COL_SIZES)[:-1])
    lb_all = jnp.cumsum(jax.nn.softmax(hgrn_lb_logits.astype(f32), axis=0), axis=0)

    def heads(t, n, hd):
        return t.reshape(bsz, seq, n, hd).transpose(0, 2, 1, 3)

    for layer in range(DEPTH):
        h = rms_norm(x, norm_mix_g[layer])
        proj = h @ w_in[layer]
        qa, ka, va, fa, qb, fb, ib, gb, gate_a, gate_b = jnp.split(proj, split_idx, axis=-1)

        log_f_a = jax.nn.log_sigmoid((fa + b_fgate[layer]).astype(f32)).transpose(0, 2, 1)
        oa = forgetting_attention(heads(qa, FOX_HEADS, FOX_HEAD_DIM), heads(ka, FOX_HEADS, FOX_HEAD_DIM),
                                  heads(va, FOX_HEADS, FOX_HEAD_DIM), log_f_a)
        ya = oa.transpose(0, 2, 1, 3).reshape(bsz, seq, FOX_WIDTH) @ w_branch_a[layer]

        lb = lb_all[layer]
        f_b = lb + (1.0 - lb) * jax.nn.sigmoid(fb.astype(f32))
        ob = hgrn2_chunkwise(heads(qb.astype(f32), HGRN_HEADS, HGRN_DK),
                             heads(1.0 - f_b, HGRN_HEADS, HGRN_DK),
                             heads(ib.astype(f32), HGRN_HEADS, HGRN_DV),
                             heads(jnp.log(f_b), HGRN_HEADS, HGRN_DK))
        ob = rms_norm(ob.transpose(0, 2, 1, 3).astype(x.dtype),
                      hgrn_norm_g[layer].reshape(HGRN_HEADS, HGRN_DV)).reshape(bsz, seq, HGRN_VW)
        yb = (ob * jax.nn.silu(gb)) @ w_branch_b[layer]

        merged = jax.nn.sigmoid(gate_a) * ya + jax.nn.sigmoid(gate_b) * yb
        x = x + merged @ w_out[layer]

        h2 = rms_norm(x, norm_ffn_g[layer]).reshape(bsz * seq, d)
        x = x + hier_moe(h2, w_group[layer], b_group[layer], w_expert[layer], b_expert[layer],
                         moe_w1[layer], moe_w3[layer], moe_w2[layer]).reshape(bsz, seq, d)

    return rms_norm(x, norm_final_g)
```

```cpp
#include <hip/hip_runtime.h>
#include <cstdio>
#include <cstdint>
#ifndef PJ_V8
#define PJ_V8 1
#endif
#ifndef PJ_IB8
#define PJ_IB8 0
#endif
#ifndef PJ_GB8
#define PJ_GB8 0
#endif
#ifndef P5_F8
#define P5_F8 0
#endif
#ifndef P6_F8
#define P6_F8 1
#endif
#ifndef P1_CONV_WGS
#define P1_CONV_WGS 32
#endif
#ifndef SKIP_T0
#define SKIP_T0 20.0f
#endif
struct PjList { int k[7]; int n; };
constexpr PjList pj_make(bool f8) { PjList r{}; r.n = 0; for (int kind = 0; kind < 7; ++kind) { const bool is8 = (kind == 2 && PJ_V8) || (kind == 5 && PJ_IB8) || (kind == 6 && PJ_GB8); if (is8 == f8) r.k[r.n++] = kind; } return r; }
constexpr PjList PJ16 = pj_make(false), PJ8 = pj_make(true);
__host__ __device__ __forceinline__ int pj_kind16(int g) { int kind = 0;
#pragma unroll
    for (int i = 0; i < PJ16.n; ++i) if (g == i) kind = PJ16.k[i];
    return kind; }
__host__ __device__ __forceinline__ int pj_kind8(int g) { int kind = 0;
#pragma unroll
    for (int i = 0; i < PJ8.n; ++i) if (g == i) kind = PJ8.k[i];
    return kind; }
__host__ __device__ __forceinline__ int pj_srccol(int kind) { return kind < 3 ? 1024 * kind : 3080 + 1024 * (kind - 3); }
namespace pg8 {
#define PG8_LAS __attribute__((address_space(3)))
typedef unsigned short bf16_t;
typedef short bf16x8 __attribute__((ext_vector_type(8)));
typedef float f32x4 __attribute__((ext_vector_type(4)));
typedef unsigned u32x4 __attribute__((ext_vector_type(4)));
typedef int v4i_t __attribute__((ext_vector_type(4)));
typedef int v8i_t __attribute__((ext_vector_type(8)));
constexpr int BM = 256, BK = 64, HALF = 128, HTB = HALF * BK * 2  , STAGE_BYTES = 8 * HTB, NXCD = 8, WGM = 8;

__host__ __device__ __forceinline__ int lds_byte(int r, int c) { const int st = (r >> 4) * 2 + (c >> 5), rr = r & 15, cc = c & 31, ob = rr * 64 + cc * 2; return st * 1024 + (ob ^ (((ob >> 9) & 1) << 5)); }
__host__ __device__ __forceinline__ void stage_rc(int b, int& R, int& C) { const int st = b / 1024, sb = b % 1024, swz = sb ^ (((sb >> 9) & 1) << 5); R = (st >> 1) * 16 + swz / 64; C = (st & 1) * 32 + (swz % 64) / 2; }
__host__ __device__ __forceinline__ int perm32(int rho) { const int n = rho >> 4, i = rho & 15; return 8 * (i >> 2) + 4 * n + (i & 3); }

struct Unit { int pm, pn, pb; };
struct Gemm { const bf16_t* A; const bf16_t* Bt; int M, N, K; const void* base; };

struct StaticOrder {
    int nM, nN, nwg, G, c;
    __host__ __device__ void init(int M, int N, int G_, int c_) { nM = M / BM; nN = N / BM; nwg = nM * nN; G = G_; c = c_; }
    __host__ __device__ bool next(int i, Unit& u) const {
        const long L = (long)i * G + c; if (L >= nwg) return false;
        int wgid = (int)L; { const int q = nwg / NXCD, r = nwg % NXCD, xcd = wgid % NXCD, off = wgid / NXCD; wgid = (xcd < r ? xcd * (q + 1) : r * (q + 1) + (xcd - r) * q) + off; }
        const int nig = WGM * nN, gid = wgid / nig, fm = gid * WGM, gsz = (nM - fm) < WGM ? (nM - fm) : WGM;
        u.pm = fm + ((wgid % nig) % gsz); u.pn = (wgid % nig) / gsz; u.pb = u.pn; return true;
    }
    __device__ __forceinline__ void a_ready(const Unit&) const {}
    __device__ __forceinline__ void done(const Unit&) const {}
};

struct StaticOrderSig : StaticOrder {
    unsigned* flag; Unit lastu;
    __device__ void init_sig(int M, int N, int G_, int c_, unsigned* flag_) { init(M, N, G_, c_); flag = flag_; const int n = (nwg - c_ + G_ - 1) / G_, nmax = (nwg + G_ - 1) / G_; lastu.pm = -1; lastu.pn = -1; lastu.pb = -1; if (n > 0 && n == nmax) next(n - 1, lastu); }
    __device__ __forceinline__ void a_ready(const Unit& u) const { if (u.pm == lastu.pm && u.pn == lastu.pn && threadIdx.x == 0) __hip_atomic_store(flag, 1u, __ATOMIC_RELAXED, __HIP_MEMORY_SCOPE_AGENT); }
};
typedef float f32x2c_t __attribute__((ext_vector_type(2))); typedef __bf16 bf16x2c_t __attribute__((ext_vector_type(2)));
__device__ __forceinline__ unsigned cvt_pk_bf16(float lo, float hi) { const f32x2c_t v = {lo, hi}; const bf16x2c_t b = __builtin_convertvector(v, bf16x2c_t); return __builtin_bit_cast(unsigned, b); }
typedef float f32x2 __attribute__((ext_vector_type(2)));

__device__ __forceinline__ float bf_lo(unsigned u) { return __uint_as_float(u << 16); }
__device__ __forceinline__ float bf_hi(unsigned u) { return __uint_as_float(u & 0xffff0000u); }
__device__ __forceinline__ float sigmoidf_(float x) { return __builtin_amdgcn_rcpf(1.0f + __builtin_amdgcn_exp2f(-1.4426950408889634f * x)); }
__device__ __forceinline__ u32x4 pack8f(const f32x4 a, const f32x4 b) { u32x4 w; w.x = cvt_pk_bf16(a[0], a[1]); w.y = cvt_pk_bf16(a[2], a[3]); w.z = cvt_pk_bf16(b[0], b[1]); w.w = cvt_pk_bf16(b[2], b[3]); return w; }
__device__ __forceinline__ void unpack8f(const u32x4 w, f32x4& a, f32x4& b) { a = (f32x4){bf_lo(w.x), bf_hi(w.x), bf_lo(w.y), bf_hi(w.y)}; b = (f32x4){bf_lo(w.z), bf_hi(w.z), bf_lo(w.w), bf_hi(w.w)}; }

struct EpiProj {
    static constexpr bool PERM = true, AFTER_DRAIN = false;
    bf16_t* qkv;
    bf16_t* hg;
    bf16_t* gt;
    const float* rstd; unsigned* nrm;
    __device__ __forceinline__ void operator()(const f32x4 (&acc)[2][2][4][2], const Unit& u, int wr, int wc, int fr, int fq) const {
        const int row0 = u.pm * BM + wr * 64 + fr; const int lanecol = wc * 32 + 8 * fq; float mx0 = 0.f, mx1 = 0.f; float ssv[2][4][2];
        bf16_t* base; size_t ld, bjoff; size_t rowbase;
        const int kind = pj_kind16(u.pn >> 2), sub = u.pn & 3;
        if (kind < 3) { const int which = kind, hp = sub, b = u.pm >> 4; base = qkv + (size_t)which * ((size_t)16384 * 1024) + ((size_t)(b * 8 + 2 * hp) * 4096) * 128; ld = 128; bjoff = (size_t)4096 * 128; rowbase = (size_t)(row0 & 4095); }
        else { base = hg + (size_t)(kind - 3) * ((size_t)16384 * 1024) + sub * 256; ld = 1024; bjoff = 128; rowbase = (size_t)row0; }
        float rsv[2][4];
#pragma unroll
        for (int ai = 0; ai < 2; ++ai)
#pragma unroll
            for (int m = 0; m < 4; ++m) rsv[ai][m] = rstd[row0 + ai * HALF + m * 16];
        __builtin_amdgcn_sched_barrier(0);
#pragma unroll
        for (int ai = 0; ai < 2; ++ai)
#pragma unroll
            for (int m = 0; m < 4; ++m) { const int r = ai * HALF + m * 16; const float rs = rsv[ai][m]; bf16_t* rowp = base + (rowbase + r) * ld + lanecol;
#pragma unroll
                for (int bj = 0; bj < 2; ++bj) { const f32x4 v0 = acc[ai][bj][m][0] * rs, v1 = acc[ai][bj][m][1] * rs; *(u32x4*)(rowp + bj * bjoff) = pack8f(v0, v1);
                    ssv[ai][m][bj] = (v0[0] * v0[0] + v0[1] * v0[1]) + (v0[2] * v0[2] + v0[3] * v0[3]) + (v1[0] * v1[0] + v1[1] * v1[1]) + (v1[2] * v1[2] + v1[3] * v1[3]); } }
        if (kind < 2) {
#pragma unroll
            for (int ai = 0; ai < 2; ++ai)
#pragma unroll
                for (int m = 0; m < 4; ++m)
#pragma unroll
                    for (int bj = 0; bj < 2; ++bj) ssv[ai][m][bj] += __shfl_xor(ssv[ai][m][bj], 16);
#pragma unroll
            for (int ai = 0; ai < 2; ++ai)
#pragma unroll
                for (int m = 0; m < 4; ++m)
#pragma unroll
                    for (int bj = 0; bj < 2; ++bj) ssv[ai][m][bj] += __shfl_xor(ssv[ai][m][bj], 32);
#pragma unroll
            for (int ai = 0; ai < 2; ++ai)
#pragma unroll
                for (int m = 0; m < 4; ++m) { mx0 = fmaxf(mx0, ssv[ai][m][0]); mx1 = fmaxf(mx1, ssv[ai][m][1]); }
#pragma unroll
            for (int o = 1; o < 16; o <<= 1) { mx0 = fmaxf(mx0, __shfl_xor(mx0, o)); mx1 = fmaxf(mx1, __shfl_xor(mx1, o)); }
            if (fr == 0 && fq == 0) { const int which = kind, hp = sub, b = u.pm >> 4; unsigned* p = nrm + ((which * 32 + b * 8 + 2 * hp) * 4 + wc);
                atomicMax(p, __float_as_uint(mx0)); atomicMax(p + 4, __float_as_uint(mx1)); } }
    }
};
__device__ __forceinline__ float clamp448(float x) { return fminf(fmaxf(x, -448.f), 448.f); }
__device__ __forceinline__ unsigned pk4_fp8(float a, float b, float c, float d) { int w = 0; w = __builtin_amdgcn_cvt_pk_fp8_f32(clamp448(a), clamp448(b), w, false); w = __builtin_amdgcn_cvt_pk_fp8_f32(clamp448(c), clamp448(d), w, true); return (unsigned)w; }
typedef unsigned u32x2 __attribute__((ext_vector_type(2)));
__device__ __forceinline__ float cl43(float x) { return fminf(fmaxf(x, -43.f), 43.f); }
struct EpiProjG8 {
    static constexpr bool PERM = true, AFTER_DRAIN = false;
    bf16_t* gt; const float* rstd; bf16_t* qkv; bf16_t* hg;
    __device__ __forceinline__ void operator()(const f32x4 (&acc)[2][2][4][2], const Unit& u, int wr, int wc, int fr, int fq) const {
        if (u.pn >= 16) {
            const int row0 = u.pm * BM + wr * 64 + fr; const int lanecol = wc * 32 + 8 * fq; const int kind = pj_kind8((u.pn - 16) >> 2), sub = u.pn & 3;
            bf16_t* base; size_t ld, bjoff; size_t rowbase;
            if (kind < 3) { const int b = u.pm >> 4; base = qkv + (size_t)kind * ((size_t)16384 * 1024) + ((size_t)(b * 8 + 2 * sub) * 4096) * 128; ld = 128; bjoff = (size_t)4096 * 128; rowbase = (size_t)(row0 & 4095); }
            else { base = hg + (size_t)(kind - 3) * ((size_t)16384 * 1024) + sub * 256; ld = 1024; bjoff = 128; rowbase = (size_t)row0; }
            float rsv[2][4];
#pragma unroll
            for (int ai = 0; ai < 2; ++ai)
#pragma unroll
                for (int m = 0; m < 4; ++m) rsv[ai][m] = rstd[row0 + ai * HALF + m * 16];
            __builtin_amdgcn_sched_barrier(0);
#pragma unroll
            for (int ai = 0; ai < 2; ++ai)
#pragma unroll
                for (int m = 0; m < 4; ++m) { const int r = ai * HALF + m * 16; const float rs = rsv[ai][m] * (1.0f / 4096.0f); bf16_t* rowp = base + (rowbase + r) * ld + lanecol;
#pragma unroll
                    for (int bj = 0; bj < 2; ++bj) *(u32x4*)(rowp + bj * bjoff) = pack8f(acc[ai][bj][m][0] * rs, acc[ai][bj][m][1] * rs); }
            return;
        }
        const __amdgpu_buffer_rsrc_t rg = __builtin_amdgcn_make_buffer_rsrc((void*)gt, 0, 16384 * 2048 * 2, 0x00020000), rg2 = __builtin_amdgcn_make_buffer_rsrc((void*)(gt + (size_t)16384 * 2048), 0, 16384 * 2048 * 2, 0x00020000);
        const __amdgpu_buffer_rsrc_t rr = __builtin_amdgcn_make_buffer_rsrc((void*)rstd, 0, 16384 * 4, 0x00020000);
        const int row0 = u.pm * BM + wr * 64 + fr; const int colb = (u.pn * HALF + wc * 32 + 8 * fq) * 2;
        float rsv[2][4];
#pragma unroll
        for (int ai = 0; ai < 2; ++ai)
#pragma unroll
            for (int m = 0; m < 4; ++m) rsv[ai][m] = __builtin_bit_cast(float, __builtin_amdgcn_raw_buffer_load_b32(rr, (row0 + ai * HALF + m * 16) * 4, 0, 0));
        __builtin_amdgcn_sched_barrier(0);
#pragma unroll
        for (int ai = 0; ai < 2; ++ai)
#pragma unroll
            for (int m = 0; m < 4; ++m) { const int r = row0 + ai * HALF + m * 16; const float rs = rsv[ai][m] * (-1.4426950408889634f / 4096.0f);
                f32x4 q0, q1, s0, s1;
#pragma unroll
                for (int i = 0; i < 4; ++i) { const float ea0 = fminf(1.0f + __builtin_amdgcn_exp2f(acc[ai][0][m][0][i] * rs), 1e13f), eb0 = fminf(1.0f + __builtin_amdgcn_exp2f(acc[ai][1][m][0][i] * rs), 1e13f);
                    const float ea1 = fminf(1.0f + __builtin_amdgcn_exp2f(acc[ai][0][m][1][i] * rs), 1e13f), eb1 = fminf(1.0f + __builtin_amdgcn_exp2f(acc[ai][1][m][1][i] * rs), 1e13f);
                    q0[i] = eb0 * __builtin_amdgcn_rcpf(ea0); q1[i] = eb1 * __builtin_amdgcn_rcpf(ea1); s0[i] = __builtin_amdgcn_rcpf(eb0); s1[i] = __builtin_amdgcn_rcpf(eb1); }
                __builtin_amdgcn_raw_buffer_store_b128(pack8f(q0, q1), rg, r * 4096 + colb, 0, 0);
                __builtin_amdgcn_raw_buffer_store_b128(pack8f(s0, s1), rg2, r * 4096 + colb, 0, 0); }
    }
};
struct EpiPlain {
    static constexpr bool PERM = true, AFTER_DRAIN = false;
    bf16_t* O; int ldc;
    __device__ __forceinline__ void operator()(const f32x4 (&acc)[2][2][4][2], const Unit& u, int wr, int wc, int fr, int fq) const {
        const int row0 = u.pm * BM + wr * 64 + fr, col0 = u.pn * BM + wc * 32 + 8 * fq;
#pragma unroll
        for (int ai = 0; ai < 2; ++ai)
#pragma unroll
            for (int m = 0; m < 4; ++m) { bf16_t* rowp = O + (size_t)(row0 + ai * HALF + m * 16) * ldc + col0;
#pragma unroll
                for (int bj = 0; bj < 2; ++bj) *(u32x4*)(rowp + bj * HALF) = pack8f(acc[ai][bj][m][0], acc[ai][bj][m][1]); }
    }
};
struct EpiPlainS {
    static constexpr bool PERM = true, AFTER_DRAIN = false;
    bf16_t* O; int ldc; float s;
    __device__ __forceinline__ void operator()(const f32x4 (&acc)[2][2][4][2], const Unit& u, int wr, int wc, int fr, int fq) const {
        const int row0 = u.pm * BM + wr * 64 + fr, col0 = u.pn * BM + wc * 32 + 8 * fq;
#pragma unroll
        for (int ai = 0; ai < 2; ++ai)
#pragma unroll
            for (int m = 0; m < 4; ++m) { bf16_t* rowp = O + (size_t)(row0 + ai * HALF + m * 16) * ldc + col0;
#pragma unroll
                for (int bj = 0; bj < 2; ++bj) *(u32x4*)(rowp + bj * HALF) = pack8f(acc[ai][bj][m][0] * s, acc[ai][bj][m][1] * s); }
    }
};
struct EpiPlainS8 {
    static constexpr bool PERM = true, AFTER_DRAIN = false;
    unsigned char* O; int ldc; float s;
    __device__ __forceinline__ void operator()(const f32x4 (&acc)[2][2][4][2], const Unit& u, int wr, int wc, int fr, int fq) const {
        const int row0 = u.pm * BM + wr * 64 + fr, col0 = u.pn * BM + wc * 32 + 8 * fq;
#pragma unroll
        for (int ai = 0; ai < 2; ++ai)
#pragma unroll
            for (int m = 0; m < 4; ++m) { unsigned char* rowp = O + (size_t)(row0 + ai * HALF + m * 16) * ldc + col0;
#pragma unroll
                for (int bj = 0; bj < 2; ++bj) { const f32x4 v0 = acc[ai][bj][m][0] * s, v1 = acc[ai][bj][m][1] * s; u32x2 w; w.x = pk4_fp8(v0[0], v0[1], v0[2], v0[3]); w.y = pk4_fp8(v1[0], v1[1], v1[2], v1[3]); *(u32x2*)(rowp + bj * HALF) = w; } }
    }
};
template <bool ADD> struct EpiGate {
    static constexpr bool PERM = true, AFTER_DRAIN = false;
    bf16_t* O; const bf16_t* gate; const bf16_t* prev;
    __device__ __forceinline__ void operator()(const f32x4 (&acc)[2][2][4][2], const Unit& u, int wr, int wc, int fr, int fq) const {
        const int row0 = u.pm * BM + wr * 64 + fr, col0 = u.pn * BM + wc * 32 + 8 * fq;
#pragma unroll
        for (int ai = 0; ai < 2; ++ai)
#pragma unroll
            for (int m = 0; m < 4; ++m) { const size_t off = (size_t)(row0 + ai * HALF + m * 16) * 2048 + col0;
#pragma unroll
                for (int bj = 0; bj < 2; ++bj) { f32x4 g0, g1; unpack8f(*(const u32x4*)(gate + off + bj * HALF), g0, g1);
                    f32x4 v0, v1;
#pragma unroll
                    for (int i = 0; i < 4; ++i) { v0[i] = sigmoidf_(g0[i]) * acc[ai][bj][m][0][i]; v1[i] = sigmoidf_(g1[i]) * acc[ai][bj][m][1][i]; }
                    if (ADD) { f32x4 p0, p1; unpack8f(*(const u32x4*)(prev + off + bj * HALF), p0, p1); v0 += p0; v1 += p1; }
                    *(u32x4*)(O + off + bj * HALF) = pack8f(v0, v1); } }
    }
};
template <bool IN8, bool OUT8> struct EpiGate2T {
    static constexpr bool PERM = true, AFTER_DRAIN = false, MID = true;
    bf16_t* O; const bf16_t* rat; const bf16_t* sb;
    __device__ __forceinline__ void mid(f32x4 (&acc)[2][2][4][2], const Unit& u, int wr, int wc, int fr, int fq) const {
        const int row0 = u.pm * BM + wr * 64 + fr, col0 = u.pn * BM + wc * 32 + 8 * fq;
#pragma unroll
        for (int ai = 0; ai < 2; ++ai)
#pragma unroll
            for (int m = 0; m < 4; ++m) { const size_t off = (size_t)(row0 + ai * HALF + m * 16) * 2048 + col0;
#pragma unroll
                for (int bj = 0; bj < 2; ++bj) { f32x4 a0, a1; unpack8f(*(const u32x4*)(rat + off + bj * HALF), a0, a1); acc[ai][bj][m][0] *= a0; acc[ai][bj][m][1] *= a1; } }
    }
    __device__ __forceinline__ void operator()(const f32x4 (&acc)[2][2][4][2], const Unit& u, int wr, int wc, int fr, int fq) const {
        const int row0 = u.pm * BM + wr * 64 + fr, col0 = u.pn * BM + wc * 32 + 8 * fq;
        constexpr float sc = (IN8 ? 1.0f / 4096.0f : 1.0f) * (OUT8 ? 16.0f : 1.0f);
#pragma unroll
        for (int ai = 0; ai < 2; ++ai) {
            u32x4 gv[4][2];
#pragma unroll
            for (int m = 0; m < 4; ++m)
#pragma unroll
                for (int bj = 0; bj < 2; ++bj) gv[m][bj] = *(const u32x4*)(sb + (size_t)(row0 + ai * HALF + m * 16) * 2048 + col0 + bj * HALF);
            __builtin_amdgcn_sched_barrier(0);
#pragma unroll
            for (int m = 0; m < 4; ++m) { const size_t off = (size_t)(row0 + ai * HALF + m * 16) * 2048 + col0;
#pragma unroll
                for (int bj = 0; bj < 2; ++bj) { f32x4 g0, g1; unpack8f(gv[m][bj], g0, g1); const f32x4 v0 = acc[ai][bj][m][0] * g0 * sc, v1 = acc[ai][bj][m][1] * g1 * sc;
                    if constexpr (OUT8) { u32x2 w; w.x = pk4_fp8(v0[0], v0[1], v0[2], v0[3]); w.y = pk4_fp8(v1[0], v1[1], v1[2], v1[3]); *(u32x2*)((unsigned char*)O + off + bj * HALF) = w; }
                    else *(u32x4*)(O + off + bj * HALF) = pack8f(v0, v1); } } }
    }
};
struct EpiResid {
    static constexpr bool PERM = true, AFTER_DRAIN = false;
    bf16_t* O; const float* X;
    __device__ __forceinline__ void operator()(const f32x4 (&acc)[2][2][4][2], const Unit& u, int wr, int wc, int fr, int fq) const {
        const int row0 = u.pm * BM + wr * 64 + fr, col0 = u.pn * BM + wc * 32 + 8 * fq;
#pragma unroll
        for (int ai = 0; ai < 2; ++ai)
#pragma unroll
            for (int m = 0; m < 4; ++m) { const size_t off = (size_t)(row0 + ai * HALF + m * 16) * 2048 + col0;
#pragma unroll
                for (int bj = 0; bj < 2; ++bj) { const f32x4 x0 = *(const f32x4*)(X + off + bj * HALF), x1 = *(const f32x4*)(X + off + bj * HALF + 4);
                    *(u32x4*)(O + off + bj * HALF) = pack8f(acc[ai][bj][m][0] + x0, acc[ai][bj][m][1] + x1); } }
    }
};
template <bool IN8> struct EpiResid8T {
    static constexpr bool PERM = true, AFTER_DRAIN = false;
    bf16_t* O; const bf16_t* X; unsigned char* O8;
    __device__ __forceinline__ void operator()(const f32x4 (&acc)[2][2][4][2], const Unit& u, int wr, int wc, int fr, int fq) const {
        const int row0 = u.pm * BM + wr * 64 + fr, col0 = u.pn * BM + wc * 32 + 8 * fq;
#pragma unroll
        for (int ai = 0; ai < 2; ++ai) {
            u32x4 xv[4][2];
#pragma unroll
            for (int m = 0; m < 4; ++m)
#pragma unroll
                for (int bj = 0; bj < 2; ++bj) xv[m][bj] = *(const u32x4*)(X + (size_t)(row0 + ai * HALF + m * 16) * 2048 + col0 + bj * HALF);
            __builtin_amdgcn_sched_barrier(0);
#pragma unroll
            for (int m = 0; m < 4; ++m) { const size_t off = (size_t)(row0 + ai * HALF + m * 16) * 2048 + col0;
#pragma unroll
                for (int bj = 0; bj < 2; ++bj) { f32x4 x0, x1; unpack8f(xv[m][bj], x0, x1); const f32x4 v0 = acc[ai][bj][m][0] * (IN8 ? 1.0f / 4096.0f : 1.0f) + x0, v1 = acc[ai][bj][m][1] * (IN8 ? 1.0f / 4096.0f : 1.0f) + x1;
                    *(u32x4*)(O + off + bj * HALF) = pack8f(v0, v1);
                    u32x2 w; w.x = pk4_fp8(16.f * v0[0], 16.f * v0[1], 16.f * v0[2], 16.f * v0[3]); w.y = pk4_fp8(16.f * v1[0], 16.f * v1[1], 16.f * v1[2], 16.f * v1[3]); *(u32x2*)(O8 + off + bj * HALF) = w; } } }
    }
};
struct EpiMoe1 {
    static constexpr bool PERM = true, AFTER_DRAIN = false;
    bf16_t* Hb; const float* rowscale;
    __device__ __forceinline__ void operator()(const f32x4 (&acc)[2][2][4][2], const Unit& u, int wr, int wc, int fr, int fq) const {
        const int row0 = u.pm * BM + wr * 64 + fr, col0 = u.pn * HALF + wc * 32 + 8 * fq;
#pragma unroll
        for (int ai = 0; ai < 2; ++ai)
#pragma unroll
            for (int m = 0; m < 4; ++m) { const int row = row0 + ai * HALF + m * 16; const float rs = rowscale[row]; f32x4 v0, v1;
#pragma unroll
                for (int i = 0; i < 4; ++i) { const float a0 = acc[ai][0][m][0][i] * rs, b0 = acc[ai][1][m][0][i] * rs, a1 = acc[ai][0][m][1][i] * rs, b1 = acc[ai][1][m][1][i] * rs;
                    v0[i] = a0 * sigmoidf_(a0) * b0; v1[i] = a1 * sigmoidf_(a1) * b1; }
                *(u32x4*)(Hb + (size_t)row * 1024 + col0) = pack8f(v0, v1); }
    }
};
struct EpiMoe1G {
    static constexpr bool PERM = true, AFTER_DRAIN = false;
    bf16_t* Hb; const float* slot_rs; const PG8_LAS int* tab;
    __device__ __forceinline__ void operator()(const f32x4 (&acc)[2][2][4][2], const Unit& u, int wr, int wc, int fr, int fq) const {
        const int row0 = u.pm * BM + wr * 64 + fr, col0 = u.pn * HALF + wc * 32 + 8 * fq; const int e = tab[34 + u.pm], ps = tab[e], cn = tab[194 + e];
#pragma unroll
        for (int ai = 0; ai < 2; ++ai)
#pragma unroll
            for (int m = 0; m < 4; ++m) { const int row = row0 + ai * HALF + m * 16, slot = row - ps; const float rs = slot < cn ? slot_rs[(size_t)e * 16384 + slot] : 0.f; f32x4 v0, v1;
#pragma unroll
                for (int i = 0; i < 4; ++i) { const float a0 = acc[ai][0][m][0][i] * rs, b0 = acc[ai][1][m][0][i] * rs, a1 = acc[ai][0][m][1][i] * rs, b1 = acc[ai][1][m][1][i] * rs;
                    v0[i] = a0 * sigmoidf_(a0) * b0; v1[i] = a1 * sigmoidf_(a1) * b1; }
                *(u32x4*)(Hb + (size_t)row * 1024 + col0) = pack8f(v0, v1); }
    }
};
struct EpiMoe1G8 {
    static constexpr bool PERM = true, AFTER_DRAIN = false;
    unsigned char* Hb; const float* slot_rs; const PG8_LAS int* tab;
    __device__ __forceinline__ void operator()(const f32x4 (&acc)[2][2][4][2], const Unit& u, int wr, int wc, int fr, int fq) const {
        const int e = tab[34 + u.pm], ps = tab[e], cn = tab[194 + e];
        const int slot0 = u.pm * BM + wr * 64 + fr - ps; const float* rsp = slot_rs + (size_t)e * 16384 + slot0; const int hoff = (u.pm * BM + wr * 64 + fr) * 1024 + (u.pn * HALF + wc * 32 + 8 * fq);
        const __amdgpu_buffer_rsrc_t rh = __builtin_amdgcn_make_buffer_rsrc((void*)Hb, 0, 160 * 256 * 1024, 0x00020000);
#pragma unroll
        for (int ai = 0; ai < 2; ++ai) {
            float rsv[4];
#pragma unroll
            for (int m = 0; m < 4; ++m) { const int dr = ai * HALF + m * 16; rsv[m] = (slot0 + dr) < cn ? rsp[dr] : 0.f; }
            __builtin_amdgcn_sched_barrier(0);
#pragma unroll
            for (int m = 0; m < 4; ++m) { const int dr = ai * HALF + m * 16; const float rs = rsv[m] * (1.0f / 4096.0f); f32x4 v0, v1;
#pragma unroll
                for (int i = 0; i < 4; ++i) { const float a0 = acc[ai][0][m][0][i] * rs, b0 = acc[ai][1][m][0][i] * rs, a1 = acc[ai][0][m][1][i] * rs, b1 = acc[ai][1][m][1][i] * rs;
                    v0[i] = 8.f * a0 * sigmoidf_(a0) * b0; v1[i] = 8.f * a1 * sigmoidf_(a1) * b1; }
                u32x2 w; w.x = pk4_fp8(v0[0], v0[1], v0[2], v0[3]); w.y = pk4_fp8(v1[0], v1[1], v1[2], v1[3]); __builtin_amdgcn_raw_buffer_store_b64(w, rh, hoff + dr * 1024, 0, 16);
                }
            asm volatile("" ::: "memory"); }
    }
};
struct MoeGatherOrder {
    int nblk, G, c, tiles_per_e; const PG8_LAS int* tab; const int* tlist; PG8_LAS unsigned* park; unsigned* cnt; mutable int pend;
    __device__ __forceinline__ bool next(int i, Unit& u) const {
        const long L = (long)i * G + c; const int idx = (int)(L >> 3); if (idx >= nblk) return false;
        u.pm = idx; u.pn = (int)(L & 7); u.pb = tab[34 + idx] * tiles_per_e + u.pn; return true;
    }
    __device__ __forceinline__ int arow(const Unit& u, int r) const { const int e = tab[34 + u.pm], slot = u.pm * BM + r - tab[e], cm = tab[194 + e] - 1; return tlist[(size_t)e * 16384 + (slot < cm ? slot : cm)]; }
    __device__ __forceinline__ void a_ready(const Unit&) const {}
    __device__ __forceinline__ void publish(int blk) const { if ((threadIdx.x & 63) == 0) __hip_atomic_fetch_add(cnt + 64 * blk, 1u, __ATOMIC_RELAXED, __HIP_MEMORY_SCOPE_AGENT); }
    __device__ __forceinline__ void done(const Unit& u) const { if (pend >= 0) publish(pend); pend = u.pm; }
    __device__ __forceinline__ void flush() const { asm volatile("s_waitcnt vmcnt(0)" ::: "memory"); if (pend >= 0) publish(pend); pend = -1; }
};
struct MoeCountedOrder {
    int nblk, G, c, i0, n1, tiles_per_e; const PG8_LAS int* blk_e; const unsigned* cnt; volatile PG8_LAS int* bc; mutable unsigned ahead;
    __device__ __forceinline__ bool next(int i, Unit& u) const {
        const long L = (long)(i + i0) * G + c - n1; const int idx = (int)(L >> 3); if (idx >= nblk) return false;
        u.pm = idx; u.pn = (int)(L & 7); u.pb = blk_e[idx] * tiles_per_e + u.pn; return true;
    }
    __device__ __forceinline__ void a_ready(const Unit& u) const {
        if (ahead & 1u) { ahead >>= 1; return; }
        if (threadIdx.x < 64) { unsigned polls = 0, m;
            const int step = G >> 3, bj = u.pm + step * (int)threadIdx.x;
            for (;;) { const unsigned v = (threadIdx.x < 8 && bj < nblk) ? __hip_atomic_load(cnt + 64 * bj, __ATOMIC_RELAXED, __HIP_MEMORY_SCOPE_AGENT) : 64u;
                m = (unsigned)__ballot(v >= 64u) & 0xffu;
                if ((m & 1u) || ++polls > (1u << 20)) break; __builtin_amdgcn_s_sleep(2); }
            __builtin_amdgcn_fence(__ATOMIC_ACQUIRE, "agent");
            asm volatile("s_waitcnt vmcnt(0)" ::: "memory");
            if (threadIdx.x == 0) bc[0] = (int)m; asm volatile("s_waitcnt lgkmcnt(0)" ::: "memory"); }
        asm volatile("" ::: "memory"); __builtin_amdgcn_s_barrier(); asm volatile("" ::: "memory");
        ahead = ((unsigned)__builtin_amdgcn_readfirstlane(bc[0])) >> 1;
    }
    __device__ __forceinline__ void done(const Unit&) const {}
};
struct MoeOrder {
    int nblk, G, c, tiles_per_e; const PG8_LAS int* blk_e;
    __device__ __forceinline__ bool next(int i, Unit& u) const {
        const long L = (long)i * G + c; const int idx = (int)(L >> 3); if (idx >= nblk) return false;
        u.pm = idx; u.pn = (int)(L & 7); u.pb = blk_e[idx] * tiles_per_e + u.pn; return true;
    }
    __device__ __forceinline__ void a_ready(const Unit&) const {}
    __device__ __forceinline__ void done(const Unit&) const {}
};
template <class E_, class = void> struct epi_has_mid { static constexpr bool v = false; };
template <class E_> struct epi_has_mid<E_, decltype((void)E_::MID)> { static constexpr bool v = E_::MID; };
template <class Epi, class Sched, bool ALIGN_EPI = false, bool SP2 = false, bool GATHER = false, bool F8 = false>
__device__ __forceinline__ void gemm_phase(PG8_LAS unsigned char* lds, const Gemm g, const Sched& S, const Epi& E) {
    const int tid = threadIdx.x, wid = __builtin_amdgcn_readfirstlane(tid >> 6), lane = tid & 63, wr = wid >> 2, wc = wid & 3, fr = lane & 15, fq = lane >> 4;
    const int K = g.K, nt = K / BK;
    unsigned voffA[2], voffB[2];
#pragma unroll
    for (int i = 0; i < 2; ++i) { int R, C; stage_rc(tid * 16 + i * 8192, R, C); const int Rb = Epi::PERM ? ((R & ~31) + perm32(R & 31)) : R;
        voffA[i] = (unsigned)(R * K + C) * 2u; voffB[i] = (unsigned)(Rb * K + C) * 2u; }
    static_assert(!GATHER || SP2, "GATHER is implemented for the SP2 loop");
    unsigned cvA[2][2] = {{0u, 0u}, {0u, 0u}}; const unsigned svA[2][2] = {{0u, 0u}, {0u, 0u}};
    const unsigned kstep = (unsigned)(BK * 2);
    const unsigned hstep = (unsigned)HALF * (unsigned)K * 2u;
    const unsigned tstep = 2u * hstep;
    const unsigned qstep = 64u * (unsigned)K * 2u;
    const unsigned ldsw = (unsigned)wid * 1024u;
    const int aoff = F8 ? (lds_byte(wr * 64 + fr, fq * 16) + 16 * (fq & 1)) : lds_byte(wr * 64 + fr, fq * 8), boff = F8 ? (lds_byte(wc * 32 + fr, fq * 16) + 16 * (fq & 1)) : lds_byte(wc * 32 + fr, fq * 8);
    static_assert(!F8 || SP2, "F8 is implemented for the SP2 loop");
#define PG8_SA(b, h) (((b) * 2 + (h)) * HTB)
#define PG8_SB(b, h) ((4 + (b) * 2 + (h)) * HTB)
#define PG8_STAGE(bufoff, gbase, voff) do { _Pragma("unroll") for (int _i = 0; _i < 2; ++_i) \
        __builtin_amdgcn_raw_ptr_buffer_load_lds(rsw, (PG8_LAS void*)(lds + (bufoff) + ldsw + _i * 8192), 16, (int)(voff)[_i], (int)(gbase), 0, 0); } while (0)
#define PG8_STAGE1(bufoff, gbase, voff0) do { _Pragma("unroll") for (int _i = 0; _i < 2; ++_i) \
        __builtin_amdgcn_raw_ptr_buffer_load_lds(rsw, (PG8_LAS void*)(lds + (bufoff) + ldsw + _i * 8192), 16, (int)(voff0), (int)((gbase) + (unsigned)_i * qstep), 0, 0); } while (0)
#define PG8_STAGE_A(bufoff, ptr, h, nx) do { if constexpr (GATHER) { unsigned vo_[2]; vo_[0] = (nx) ? svA[h][0] : cvA[h][0]; vo_[1] = (nx) ? svA[h][1] : cvA[h][1]; PG8_STAGE(bufoff, ptr, vo_); } \
        else { PG8_STAGE1(bufoff, (ptr) + (h) * hstep, voffA[0]); } } while (0)
#define PG8_GOFF(dst, u) do { int t_ = threadIdx.x; asm volatile("" : "+v"(t_)); _Pragma("unroll") for (int i_ = 0; i_ < 2; ++i_) { int R_, C_; stage_rc(t_ * 16 + i_ * 8192, R_, C_); _Pragma("unroll") for (int h_ = 0; h_ < 2; ++h_) dst[h_][i_] = (unsigned)S.arow(u, h_ * HALF + R_) * (unsigned)(K * 2) + (unsigned)C_ * 2u; } } while (0)
#define PG8_LDA(dst, b, h) do { if constexpr (F8) { _Pragma("unroll") for (int m = 0; m < 4; ++m) { const v4i_t lo_ = *(const PG8_LAS v4i_t*)(lds + PG8_SA(b, h) + aoff + m * 2048), hi_ = *(const PG8_LAS v4i_t*)(lds + PG8_SA(b, h) + (aoff ^ 16) + m * 2048); \
            dst##8[m] = __builtin_shufflevector(lo_, hi_, 0, 1, 2, 3, 4, 5, 6, 7); } } \
        else { _Pragma("unroll") for (int m = 0; m < 4; ++m) _Pragma("unroll") for (int k = 0; k < 2; ++k) dst[m][k] = *(const PG8_LAS bf16x8*)(lds + PG8_SA(b, h) + aoff + m * 2048 + k * 1024); } } while (0)
#define PG8_LDB(dst, b, h) do { if constexpr (F8) { _Pragma("unroll") for (int n = 0; n < 2; ++n) { const v4i_t lo_ = *(const PG8_LAS v4i_t*)(lds + PG8_SB(b, h) + boff + n * 2048), hi_ = *(const PG8_LAS v4i_t*)(lds + PG8_SB(b, h) + (boff ^ 16) + n * 2048); \
            dst##8[n] = __builtin_shufflevector(lo_, hi_, 0, 1, 2, 3, 4, 5, 6, 7); } } \
        else { _Pragma("unroll") for (int n = 0; n < 2; ++n) _Pragma("unroll") for (int k = 0; k < 2; ++k) dst[n][k] = *(const PG8_LAS bf16x8*)(lds + PG8_SB(b, h) + boff + n * 2048 + k * 1024); } } while (0)
#define PG8_MMA(ai, bj, At, Bt) do { __builtin_amdgcn_s_setprio(1); if constexpr (F8) { _Pragma("unroll") for (int m = 0; m < 4; ++m) _Pragma("unroll") for (int n = 0; n < 2; ++n) \
            acc[ai][bj][m][n] = __builtin_amdgcn_mfma_scale_f32_16x16x128_f8f6f4(Bt##8[n], At##8[m], acc[ai][bj][m][n], 0, 0, 0, 0, 0, 0); } \
        else { _Pragma("unroll") for (int m = 0; m < 4; ++m) _Pragma("unroll") for (int n = 0; n < 2; ++n) _Pragma("unroll") for (int k = 0; k < 2; ++k) \
            acc[ai][bj][m][n] = __builtin_amdgcn_mfma_f32_16x16x32_bf16(Bt[n][k], At[m][k], acc[ai][bj][m][n], 0, 0, 0); } __builtin_amdgcn_s_setprio(0); } while (0)
#define PG8_WAIT_V(n) asm volatile("s_waitcnt vmcnt(" #n ")" ::: "memory")
#define PG8_WAIT_L(n) asm volatile("s_waitcnt lgkmcnt(" #n ")" ::: "memory")
#define PG8_BAR __builtin_amdgcn_s_barrier()
#define PG8_SCHED __builtin_amdgcn_sched_barrier(0)
    Unit cur, nxt; int ui = 0;
    if (!S.next(0, cur)) return;
    f32x4 acc[2][2][4][2];
#pragma unroll
    for (int a = 0; a < 2; ++a)
#pragma unroll
        for (int b = 0; b < 2; ++b)
#pragma unroll
            for (int m = 0; m < 4; ++m)
#pragma unroll
                for (int n = 0; n < 2; ++n) acc[a][b][m][n] = (f32x4){0.f, 0.f, 0.f, 0.f};
    bf16x8 At[4][2], B0[2][2], B1[2][2]; v8i_t At8[4], B08[2], B18[2];
    const __amdgpu_buffer_rsrc_t rsw = __builtin_amdgcn_make_buffer_rsrc((void*)g.base, 0, 0x7ffffff0, 0x00020000);
    const unsigned oA0 = (unsigned)((const char*)g.A - (const char*)g.base), oB0 = (unsigned)((const char*)g.Bt - (const char*)g.base);
    unsigned cA = oA0 + (GATHER ? 0u : (unsigned)cur.pm * tstep); unsigned cB = oB0 + (unsigned)cur.pb * tstep;
    if constexpr (GATHER) PG8_GOFF(cvA, cur);
    S.a_ready(cur);
    if constexpr (SP2) {
        PG8_STAGE1(PG8_SB(0, 0), cB, voffB[0]); PG8_STAGE1(PG8_SB(0, 1), cB + hstep, voffB[0]); PG8_STAGE_A(PG8_SA(0, 0), cA, 0, false); PG8_STAGE_A(PG8_SA(0, 1), cA, 1, false);
        if (wr == 1) PG8_BAR;
        PG8_WAIT_V(2); PG8_BAR;
        PG8_STAGE1(PG8_SB(1, 0), cB + kstep, voffB[0]); PG8_STAGE_A(PG8_SA(1, 0), cA + kstep, 0, false); PG8_STAGE1(PG8_SB(1, 1), cB + hstep + kstep, voffB[0]);
        PG8_WAIT_V(6); PG8_BAR;
    } else {
        PG8_STAGE1(PG8_SB(0, 0), cB, voffB[0]); PG8_STAGE(PG8_SA(0, 0), cA, voffA); PG8_STAGE1(PG8_SB(0, 1), cB + hstep, voffB[0]); PG8_STAGE(PG8_SA(0, 1), cA + hstep, voffA);
        if (wr == 1) PG8_BAR;
        PG8_WAIT_V(4); PG8_BAR;
        PG8_STAGE1(PG8_SB(1, 0), cB + kstep, voffB[0]); PG8_STAGE(PG8_SA(1, 0), cA + kstep, voffA); PG8_STAGE1(PG8_SB(1, 1), cB + hstep + kstep, voffB[0]);
        PG8_WAIT_V(6); PG8_BAR;
    }
    for (;;) {
        const bool has_next = S.next(ui + 1, nxt);
        if constexpr (GATHER) { if (ui == 0) { unsigned tv_[2][2]; if (has_next) PG8_GOFF(tv_, nxt); else { tv_[0][0] = cvA[0][0]; tv_[0][1] = cvA[0][1]; tv_[1][0] = cvA[1][0]; tv_[1][1] = cvA[1][1]; }
            { int t_ = threadIdx.x; asm volatile("" : "+v"(t_)); *(PG8_LAS u32x4*)(S.park + t_ * 4) = (u32x4){tv_[0][0], tv_[0][1], tv_[1][0], tv_[1][1]}; } } }
        const unsigned nA = (has_next && !GATHER) ? oA0 + (unsigned)nxt.pm * tstep : cA; const unsigned nB = has_next ? oB0 + (unsigned)nxt.pb * tstep : cB;
#pragma unroll 1
        for (int t = 0; t < nt; t += 2) {
            const bool last = (t == nt - 2);
            const unsigned a1 = cA + (unsigned)(t + 1) * kstep;
            const unsigned a2 = last ? nA : cA + (unsigned)(t + 2) * kstep; const unsigned b2 = last ? nB : cB + (unsigned)(t + 2) * kstep;
            const unsigned a3 = a2 + kstep; const unsigned b3 = b2 + kstep;
            if (last && has_next) S.a_ready(nxt);
            if constexpr (epi_has_mid<Epi>::v) { if (t == (nt >> 1)) { int t_ = threadIdx.x; asm volatile("" : "+v"(t_)); const int l_ = t_ & 63, w_ = __builtin_amdgcn_readfirstlane(t_ >> 6); E.mid(acc, cur, w_ >> 2, w_ & 3, l_ & 15, l_ >> 4); } }
            unsigned svA[2][2] = {{cvA[0][0], cvA[0][1]}, {cvA[1][0], cvA[1][1]}};
            if constexpr (GATHER) { if (last) { int t_ = threadIdx.x; asm volatile("" : "+v"(t_)); const u32x4 pv_ = *(const PG8_LAS u32x4*)(S.park + t_ * 4); svA[0][0] = pv_.x; svA[0][1] = pv_.y; svA[1][0] = pv_.z; svA[1][1] = pv_.w; } }
            if constexpr (SP2) {
            PG8_LDB(B0, 0, 0); PG8_LDB(B1, 0, 1); PG8_SCHED; PG8_LDA(At, 0, 0); PG8_STAGE_A(PG8_SA(1, 1), a1, 1, false);
            PG8_WAIT_V(8); PG8_WAIT_L(0); PG8_BAR; PG8_MMA(0, 0, At, B0); PG8_MMA(0, 1, At, B1); PG8_BAR; PG8_SCHED;
            PG8_LDA(At, 0, 1); PG8_STAGE1(PG8_SB(0, 0), b2, voffB[0]); PG8_STAGE1(PG8_SB(0, 1), b2 + hstep, voffB[0]); PG8_STAGE_A(PG8_SA(0, 0), a2, 0, last);
            PG8_WAIT_V(8); PG8_WAIT_L(0); PG8_BAR; PG8_MMA(1, 0, At, B0); PG8_MMA(1, 1, At, B1); PG8_BAR; PG8_SCHED;
            PG8_LDB(B0, 1, 0); PG8_LDB(B1, 1, 1); PG8_SCHED; PG8_LDA(At, 1, 0); PG8_STAGE_A(PG8_SA(0, 1), a2, 1, last);
            PG8_WAIT_V(8); PG8_WAIT_L(0); PG8_BAR; PG8_MMA(0, 0, At, B0); PG8_MMA(0, 1, At, B1); PG8_BAR; PG8_SCHED;
            PG8_LDA(At, 1, 1); PG8_STAGE1(PG8_SB(1, 0), b3, voffB[0]); PG8_STAGE1(PG8_SB(1, 1), b3 + hstep, voffB[0]); PG8_STAGE_A(PG8_SA(1, 0), a3, 0, last);
            PG8_WAIT_V(8); PG8_WAIT_L(0); PG8_BAR; PG8_MMA(1, 0, At, B0); PG8_MMA(1, 1, At, B1); PG8_BAR; PG8_SCHED;
            } else {
            PG8_LDB(B0, 0, 0); PG8_SCHED; PG8_LDA(At, 0, 0); PG8_STAGE(PG8_SA(1, 1), a1 + hstep, voffA);
            PG8_WAIT_L(8); PG8_BAR; PG8_WAIT_L(0); PG8_MMA(0, 0, At, B0); PG8_BAR; PG8_SCHED;
            PG8_LDB(B1, 0, 1); PG8_STAGE1(PG8_SB(0, 0), b2, voffB[0]);
            PG8_BAR; PG8_WAIT_L(0); PG8_MMA(0, 1, At, B1); PG8_BAR;
            PG8_LDA(At, 0, 1); PG8_STAGE(PG8_SA(0, 0), a2, voffA);
            PG8_BAR; PG8_WAIT_L(0); PG8_MMA(1, 0, At, B0); PG8_BAR; PG8_SCHED;
            PG8_STAGE1(PG8_SB(0, 1), b2 + hstep, voffB[0]);
            PG8_WAIT_V(6); PG8_BAR; PG8_MMA(1, 1, At, B1); PG8_BAR;
            PG8_LDB(B0, 1, 0); PG8_SCHED; PG8_LDA(At, 1, 0); PG8_STAGE(PG8_SA(0, 1), a2 + hstep, voffA);
            PG8_WAIT_L(8); PG8_BAR; PG8_WAIT_L(0); PG8_MMA(0, 0, At, B0); PG8_BAR; PG8_SCHED;
            PG8_LDB(B1, 1, 1); PG8_STAGE1(PG8_SB(1, 0), b3, voffB[0]);
            PG8_BAR; PG8_WAIT_L(0); PG8_MMA(0, 1, At, B1); PG8_BAR;
            PG8_LDA(At, 1, 1); PG8_STAGE(PG8_SA(1, 0), a3, voffA);
            PG8_BAR; PG8_WAIT_L(0); PG8_MMA(1, 0, At, B0); PG8_BAR; PG8_SCHED;
            PG8_STAGE1(PG8_SB(1, 1), b3 + hstep, voffB[0]);
            PG8_WAIT_V(6); PG8_BAR; PG8_MMA(1, 1, At, B1); PG8_BAR;
            }
        }
        Unit nn2; bool has_nn = false; unsigned tv2[2][2] = {{0u, 0u}, {0u, 0u}};
        if constexpr (GATHER) { has_nn = has_next && S.next(ui + 2, nn2); if (has_nn) PG8_GOFF(tv2, nn2); }
        if constexpr (ALIGN_EPI) { if (wr == 0) PG8_BAR; }
        if constexpr (!Epi::AFTER_DRAIN) { int t_ = threadIdx.x; asm volatile("" : "+v"(t_));
            const int l_ = t_ & 63, w_ = __builtin_amdgcn_readfirstlane(t_ >> 6); E(acc, cur, w_ >> 2, w_ & 3, l_ & 15, l_ >> 4); S.done(cur); }
        if (!has_next) break;
#pragma unroll
        for (int a = 0; a < 2; ++a)
#pragma unroll
            for (int b = 0; b < 2; ++b)
#pragma unroll
                for (int m = 0; m < 4; ++m)
#pragma unroll
                    for (int n = 0; n < 2; ++n) acc[a][b][m][n] = (f32x4){0.f, 0.f, 0.f, 0.f};
        cur = nxt; cA = nA; cB = nB; ++ui;
        if constexpr (GATHER) { int t_ = threadIdx.x; asm volatile("" : "+v"(t_)); const u32x4 pv_ = *(const PG8_LAS u32x4*)(S.park + t_ * 4); cvA[0][0] = pv_.x; cvA[0][1] = pv_.y; cvA[1][0] = pv_.z; cvA[1][1] = pv_.w;
            *(PG8_LAS u32x4*)(S.park + t_ * 4) = has_nn ? (u32x4){tv2[0][0], tv2[0][1], tv2[1][0], tv2[1][1]} : pv_; }
        if constexpr (ALIGN_EPI) { if (wr == 1) PG8_BAR; }
    }
    PG8_WAIT_V(0);
    if constexpr (!ALIGN_EPI) { if (wr == 0) PG8_BAR; }
    PG8_BAR;
    if constexpr (Epi::AFTER_DRAIN) { E.fused(acc, cur, wr, wc, fr, fq, lds, wid, lane); S.done(cur); }
#undef PG8_SA
#undef PG8_SB
#undef PG8_STAGE
#undef PG8_STAGE_A
#undef PG8_GOFF
#undef PG8_LDA
#undef PG8_LDB
#undef PG8_MMA
#undef PG8_WAIT_V
#undef PG8_WAIT_L
#undef PG8_BAR
#undef PG8_SCHED
}
}

constexpr int NWAVES = 8;
constexpr int BATCH = 4, SEQ = 4096, DM = 2048, T = BATCH * SEQ;
constexpr int NCOLS = 11272, NPROJ = 11264, NPROJ16 = 1024 * PJ16.n, NPROJ8 = 4096 + 1024 * PJ8.n, GATE_COL0 = 7176;
constexpr int NH = 8, HD = 128, MW = NH * HD;
constexpr int NEXP = 32, NGRP = 4, EPG = 8, DFF = 1024;
constexpr int MAXBLK = 160, MAXROWS = MAXBLK * 256;
constexpr float EPS = 1e-6f;
constexpr float ATT_SCALE = 0.08838834764831845f;

constexpr size_t MiB = 1u << 20, KiB = 1u << 10;
constexpr size_t WS_CTL = 0, CTL_ZERO_BYTES = 128 * KiB;
constexpr size_t WS_RSTD1 = 1 * MiB, WS_LOGF = WS_RSTD1 + 64 * KiB, WS_CUM = WS_LOGF + 512 * KiB, WS_RSTD2 = WS_CUM + 512 * KiB,
                 WS_AE = WS_RSTD2 + 64 * KiB, WS_ASLOT = WS_AE + 128 * KiB, WS_AW = WS_ASLOT + 128 * KiB, WS_TOKROW = WS_AW + 128 * KiB, WS_ROWSCALE = WS_TOKROW + 128 * KiB;
static_assert(WS_ROWSCALE + MAXROWS * 4 <= 4 * MiB, "small arrays");
constexpr size_t WS_DEC = 5 * MiB;
constexpr size_t WS_TLIST = 6 * MiB, WS_SLOTRS = 8 * MiB;
constexpr size_t WS_WR = 4 * MiB;
constexpr size_t WS_WIN = 16 * MiB, WS_PAB = 60 * MiB, WS_WOUT = 68 * MiB, WS_W13 = 76 * MiB, WS_W2 = 204 * MiB, WS_ARENA = 268 * MiB;
constexpr size_t AR(size_t m) { return WS_ARENA + m * MiB; }
constexpr size_t WS_GT = AR(0);
constexpr size_t WS_HG = AR(128);
constexpr size_t WS_QKV = AR(256);
constexpr size_t WS_OAB = AR(512);
constexpr size_t WS_U = AR(384), WS_S = AR(448);
constexpr size_t WS_X8 = AR(448);
constexpr size_t WS_WIN8 = AR(480);
constexpr size_t WS_XB = AR(576);
constexpr size_t WS_OBF = AR(384);
constexpr size_t WS_MRG = AR(384);
constexpr size_t WS_X1B = AR(0);
constexpr size_t WS_X1F8 = AR(64);
constexpr size_t WS_XBUF = AR(64);
constexpr size_t WS_HBUF = AR(224);
constexpr size_t WS_YBUF = AR(304);
constexpr size_t WS_END = AR(640);
static_assert(WS_END <= 1024 * MiB, "d_ws map");
constexpr int CW_TMO = 0, CW_CODE = 1, CW_BAR = 4096, CW_CNT = 16384, CW_NRM = 16512, CW_QUEUE = 16832, CW_CONVQ = 16896, CW_P1STOP = 16960, CW_HB = 17408, CW_SCAN = 28672;

constexpr int RING_OFF = 0, RING_BYTES = 131072;
constexpr int LDSCTL_OFF = RING_BYTES, MISC_OFF = LDSCTL_OFF + 320;
constexpr int MOE_TAB_OFF = MISC_OFF + 128;
constexpr int PARK_OFF = MOE_TAB_OFF + 1024;
constexpr int LDS_BYTES = 147456;
static_assert(PARK_OFF % 16 == 0 && PARK_OFF + 8192 <= LDS_BYTES, "LDS map");
static_assert(MOE_TAB_OFF + (33 + 1 + 160 + 32) * 4 <= LDS_BYTES, "LDS map");

#define GAS __attribute__((address_space(1)))
#define LAS __attribute__((address_space(3)))
typedef unsigned short bf16;
#if P5_F8
typedef unsigned char OAB_t;
#else
typedef unsigned short OAB_t;
#endif
typedef unsigned v4u __attribute__((ext_vector_type(4)));
typedef unsigned v2u __attribute__((ext_vector_type(2)));
typedef float f32x4 __attribute__((ext_vector_type(4)));
typedef float f32x2v __attribute__((ext_vector_type(2)));
typedef short bf16x8 __attribute__((ext_vector_type(8)));
typedef GAS unsigned gu32;
#define RLX_AGENT __ATOMIC_RELAXED, __HIP_MEMORY_SCOPE_AGENT
#define LDS_WAIT() asm volatile("s_waitcnt lgkmcnt(0)" ::: "memory")
#define VM_WAIT() asm volatile("s_waitcnt vmcnt(0)" ::: "memory")
__device__ __forceinline__ float bflo(unsigned u) { return __uint_as_float(u << 16); }
__device__ __forceinline__ float bfhi(unsigned u) { return __uint_as_float(u & 0xffff0000u); }
__device__ __forceinline__ float bf1(bf16 h) { return __uint_as_float((unsigned)h << 16); }
__device__ __forceinline__ unsigned pk2(float lo, float hi) { unsigned r; asm volatile("v_cvt_pk_bf16_f32 %0, %1, %2" : "=v"(r) : "v"(lo), "v"(hi)); return r; }
__device__ __forceinline__ float sigm(float x) { return 1.0f / (1.0f + __expf(-x)); }
template <int CTRL> __device__ __forceinline__ float dpp_f(float v) { return __builtin_bit_cast(float, __builtin_amdgcn_update_dpp(0, __builtin_bit_cast(int, v), CTRL, 0xF, 0xF, true)); }
__device__ __forceinline__ float wave_sum(float v) {
    v += dpp_f<0xB1>(v); v += dpp_f<0x4E>(v); v += dpp_f<0x141>(v); v += dpp_f<0x140>(v);
    v += __shfl_xor(v, 16); v += __shfl_xor(v, 32);
    return v;
}
template <int CTRL> __device__ __forceinline__ int dpp_i(int v) { return __builtin_amdgcn_update_dpp(0, v, CTRL, 0xF, 0xF, true); }
__device__ __forceinline__ int wave_isum(int v) { v += dpp_i<0xB1>(v); v += dpp_i<0x4E>(v); v += dpp_i<0x141>(v); v += dpp_i<0x140>(v); v += __shfl_xor(v, 16); v += __shfl_xor(v, 32); return v; }
__device__ __forceinline__ float wave_fmax(float v) { v = fmaxf(v, dpp_f<0xB1>(v)); v = fmaxf(v, dpp_f<0x4E>(v)); v = fmaxf(v, dpp_f<0x141>(v)); v = fmaxf(v, dpp_f<0x140>(v)); v = fmaxf(v, __shfl_xor(v, 16)); v = fmaxf(v, __shfl_xor(v, 32)); return v; }
#define XB_TMO      128
#define XB_XCNT(j)  (256  + 64 * (j))
#define XB_XSUB(j)  (1280 + 64 * (j))
#define XB_XGEN(j)  (2304 + 64 * (j))
#define XB_TOP      3328
#define XB_TOPGEN   3392
#define XCD_BAR_WORDS 3456
#define XB_SPIN_CAP (1u << 18)

__device__ __forceinline__ unsigned xb_ld(unsigned* p)              { return __hip_atomic_load(p, __ATOMIC_RELAXED, __HIP_MEMORY_SCOPE_AGENT); }
__device__ __forceinline__ unsigned xb_add(unsigned* p, unsigned v) { return __hip_atomic_fetch_add(p, v, __ATOMIC_RELAXED, __HIP_MEMORY_SCOPE_AGENT); }
__device__ __forceinline__ unsigned xb_xcc_id() { return (unsigned)__builtin_amdgcn_s_getreg((3 << 11) | 20) & 0xFu; }
#define XB_SPIN(cond, bar) do { unsigned _sp = 0; while (cond) { __builtin_amdgcn_s_sleep(1); \
    if ((++_sp & 255u) == 0u) { if (xb_ld(&(bar)[XB_TMO])) break; if (_sp > XB_SPIN_CAP) { atomicAdd(&(bar)[XB_TMO], 1u); break; } } } } while (0)

struct XcdBarrier {
    unsigned* bar; unsigned x;
    volatile LAS unsigned* st;
};

__device__ __forceinline__ XcdBarrier xcd_barrier_post(unsigned* bar, volatile LAS unsigned* st) {
    XcdBarrier b; b.bar = bar; b.x = xb_xcc_id(); b.st = st;
    if (threadIdx.x == 0) (void)xb_add(&bar[XB_XCNT(b.x)], 1u);
    return b;
}
__device__ __forceinline__ void xcd_barrier_complete(unsigned* bar, unsigned x, unsigned& nloc, unsigned& nx) {
    const unsigned G = gridDim.x * gridDim.y * gridDim.z;
    unsigned sum, cnt, mine, sp = 0u;
    for (;;) {
        sum = 0u; cnt = 0u; mine = 0u;
#pragma unroll
        for (unsigned j = 0; j < 16; ++j) { const unsigned c = xb_ld(&bar[XB_XCNT(j)]); sum += c; cnt += (c > 0u) ? 1u : 0u; mine = (j == x) ? c : mine; }
        if (sum == G) break;
        __builtin_amdgcn_s_sleep(1);
        if ((++sp & 255u) == 0u) { if (xb_ld(&bar[XB_TMO])) break; if (sp > XB_SPIN_CAP) { atomicAdd(&bar[XB_TMO], 1u); break; } }
    }
    nloc = mine > 0u ? mine : 1u; nx = cnt > 0u ? cnt : 1u;
}

__device__ __forceinline__ void xcd_barrier(const XcdBarrier& b) {
    asm volatile("s_waitcnt vmcnt(0)" ::: "memory");
    __syncthreads();
    if (threadIdx.x == 0) {
        unsigned* bar = b.bar;
        __builtin_amdgcn_s_waitcnt(0);
        unsigned nloc = b.st[0], nx = b.st[1];
        if (nloc == 0u) { xcd_barrier_complete(bar, b.x, nloc, nx); b.st[0] = nloc; b.st[1] = nx; }
        const unsigned old = xb_add(&bar[XB_XSUB(b.x)], 1u);
        const unsigned gen = old / nloc;
        if (old + 1u == (gen + 1u) * nloc) {
            __builtin_amdgcn_fence(__ATOMIC_RELEASE, "agent");
            asm volatile("s_waitcnt vmcnt(0)" ::: "memory");
            const unsigned og = xb_add(&bar[XB_TOP], 1u);
            const unsigned tg = og / nx;
            if (og + 1u == (tg + 1u) * nx) xb_add(&bar[XB_TOPGEN], 1u);
            else XB_SPIN(xb_ld(&bar[XB_TOPGEN]) == tg, bar);
            __builtin_amdgcn_fence(__ATOMIC_ACQUIRE, "agent");
            xb_add(&bar[XB_XGEN(b.x)], 1u);
            asm volatile("s_waitcnt vmcnt(0)" ::: "memory");
        } else {
            XB_SPIN(xb_ld(&bar[XB_XGEN(b.x)]) == gen, bar);
            __builtin_amdgcn_fence(__ATOMIC_ACQUIRE, "agent");
            asm volatile("s_waitcnt vmcnt(0)" ::: "memory");
        }
    }
    __syncthreads();
}

#include <hip/hip_bf16.h>
namespace fox {
constexpr int D = 128, OSTRIDE = 2048;
constexpr float THR = 8.f;
constexpr bool WSKIP = false;
constexpr float SCALE = 0.08838834764831845f;
constexpr int NW = 8, QBLK = 32, KVBLK = 64, QB = NW * QBLK;
constexpr int SHM_V = KVBLK * D * 2, SHM_K = KVBLK * D * 2;
constexpr int ATT_LDS = 2 * SHM_V + 2 * SHM_K + NW * 64 * 4;
constexpr int LDS_CUM = ATT_LDS, LDS_KB = ATT_LDS + 16384, ATT_LDS_TOTAL = ATT_LDS + 32768;

using bf16 = __hip_bfloat16;
typedef short bf16x8 __attribute__((ext_vector_type(8)));
typedef short s16x4 __attribute__((ext_vector_type(4)));
typedef float f32x16 __attribute__((ext_vector_type(16)));
typedef float f32x4 __attribute__((ext_vector_type(4)));
typedef unsigned u32x4 __attribute__((ext_vector_type(4)));
template <class A, class Bt> struct same_t { static constexpr bool v = false; };
template <class A> struct same_t<A, A> { static constexpr bool v = true; };

#define KSWZ(row, colB) ((row) * 256 + ((colB) ^ (((row) & 7) << 4)))
#define SBAR() __builtin_amdgcn_sched_barrier(0)
__device__ __forceinline__ int v_st(int k, int c) { const int kk = (k & ~0xC) | ((k & 4) << 1) | ((k & 8) >> 1); return ((kk >> 3) * 4 + (c >> 5)) * 512 + ((kk & 7) * 32 + (c & 31)) * 2; }
__device__ __forceinline__ int v_rd_base(int lane) { return ((lane & 3) << 3) | (((lane >> 2) & 3) << 6) | (((lane >> 4) & 1) << 5) | (((lane >> 5) & 1) << 8); }
constexpr int v_rd_off(int d0, int ks, int half) { return d0 * 512 + ks * 4096 + half * 2048; }
__device__ __forceinline__ int crow(int r, int hi) { return (r & 3) + 8 * (r >> 2) + 4 * hi; }
__device__ __forceinline__ unsigned cvtpk(float lo, float hi) {
    typedef float f2_t __attribute__((ext_vector_type(2))); typedef __bf16 b2_t __attribute__((ext_vector_type(2)));
    const f2_t v = {lo, hi}; const b2_t b = __builtin_convertvector(v, b2_t); return __builtin_bit_cast(unsigned, b);
}
__device__ __forceinline__ bf16x8 pack8(f32x4 a, f32x4 b) {
    u32x4 w = {cvtpk(a[0], a[1]), cvtpk(a[2], a[3]), cvtpk(b[0], b[1]), cvtpk(b[2], b[3])};
    return *reinterpret_cast<bf16x8*>(&w);
}
template <class T> __device__ __forceinline__ bf16x8 load8(const T* p) {
    if constexpr (same_t<T, float>::v) { return pack8(*(const f32x4*)p, *(const f32x4*)(p + 4)); }
    else { return *reinterpret_cast<const bf16x8*>(p); }
}
__device__ __forceinline__ void mask_tile(f32x16& p0, f32x16& p1, int dq, unsigned W) {
    const float NEG = -__builtin_inff();
#pragma unroll
    for (int r = 0; r < 16; ++r) {
        const int c = (r & 3) + 8 * (r >> 2);
        if ((unsigned)(dq - c) >= W) p0[r] = NEG;
        if ((unsigned)(dq - c - 32) >= W) p1[r] = NEG;
    }
}
__device__ __forceinline__ void partialSM(f32x16& p0, f32x16& p1, float& m_reg, float& mn, float& alpha) {
    float pmax = p0[0]; for (int r = 1; r < 16; ++r) pmax = fmaxf(pmax, p0[r]); for (int r = 0; r < 16; ++r) pmax = fmaxf(pmax, p1[r]);
    { auto rr = __builtin_amdgcn_permlane32_swap(__float_as_uint(pmax), __float_as_uint(pmax), false, false);
      pmax = fmaxf(__uint_as_float(rr[0]), __uint_as_float(rr[1])); }
    constexpr float C2 = 1.4426950408889634f * SCALE;
    if (__builtin_expect(__all((pmax - m_reg) * SCALE <= THR), 1)) { mn = m_reg; alpha = 1.f; }
    else { mn = fmaxf(m_reg, pmax); alpha = __builtin_amdgcn_exp2f((m_reg - mn) * C2); m_reg = mn; }
    const float mnL = -mn * C2;
    for (int r = 0; r < 16; ++r) p0[r] = fmaf(p0[r], C2, mnL); for (int r = 0; r < 16; ++r) p1[r] = fmaf(p1[r], C2, mnL);
    for (int r = 0; r < 16; ++r) p0[r] = __builtin_amdgcn_exp2f(p0[r]);
}
__device__ __forceinline__ void finishSM(f32x16& p0, f32x16& p1, float alpha, float& l_reg, bf16x8& pa0, bf16x8& pa1, bf16x8& pa2, bf16x8& pa3) {
    for (int r = 0; r < 16; ++r) p1[r] = __builtin_amdgcn_exp2f(p1[r]);
    float ps = 0; for (int r = 0; r < 16; ++r) ps += p0[r]; for (int r = 0; r < 16; ++r) ps += p1[r];
    { auto rr = __builtin_amdgcn_permlane32_swap(__float_as_uint(ps), __float_as_uint(ps), false, false);
      ps = __uint_as_float(rr[0]) + __uint_as_float(rr[1]); }
    l_reg = l_reg * alpha + ps;
#define PK4(P, B_, OUT) do { unsigned a0 = cvtpk(P[B_+0], P[B_+1]), a1 = cvtpk(P[B_+2], P[B_+3]);                          \
        unsigned b0 = cvtpk(P[B_+4], P[B_+5]), b1 = cvtpk(P[B_+6], P[B_+7]);                                             \
        auto r0 = __builtin_amdgcn_permlane32_swap(a0, b0, false, false); auto r1 = __builtin_amdgcn_permlane32_swap(a1, b1, false, false); \
        u32x4 w = {r0[0], r1[0], r0[1], r1[1]}; OUT = *reinterpret_cast<bf16x8*>(&w); } while (0)
    PK4(p0, 0, pa0); PK4(p0, 8, pa1); PK4(p1, 0, pa2); PK4(p1, 8, pa3);
#undef PK4
}
template <int KB, bool SK>
__device__ __forceinline__ void qkt(f32x16& p0, f32x16& p1, const char* K_lds, int r32, int hi, const bf16x8* qr, bool act, const float* kbt  ) {
    if (SK && !act) { const float NEG = -__builtin_inff();
#pragma unroll
        for (int r = 0; r < 16; ++r) { p0[r] = NEG; p1[r] = NEG; } return; }
#pragma unroll
    for (int g = 0; g < 4; ++g) { const f32x4 a = *(const f32x4*)(kbt + 8 * g), b = *(const f32x4*)(kbt + 32 + 8 * g);
        p0[4 * g] = a[0]; p0[4 * g + 1] = a[1]; p0[4 * g + 2] = a[2]; p0[4 * g + 3] = a[3]; p1[4 * g] = b[0]; p1[4 * g + 1] = b[1]; p1[4 * g + 2] = b[2]; p1[4 * g + 3] = b[3]; }
    const char* kb[4];
#pragma unroll
    for (int dd = 0; dd < 4; ++dd) kb[dd] = K_lds + KB * SHM_K + KSWZ(r32, (dd * 16 + hi * 8) * 2);
#pragma unroll
    for (int d0 = 0; d0 < 8; ++d0) { const char* a = kb[d0 & 3] + (d0 >> 2) * 128;
        bf16x8 b0 = *reinterpret_cast<const bf16x8*>(a);
        bf16x8 b1 = *reinterpret_cast<const bf16x8*>(a + 32 * 256);
        p0 = __builtin_amdgcn_mfma_f32_32x32x16_bf16(b0, qr[d0], p0, 0, 0, 0);
        p1 = __builtin_amdgcn_mfma_f32_32x32x16_bf16(b1, qr[d0], p1, 0, 0, 0); }
}
template <int VB, bool SK>
__device__ __forceinline__ void pv_tile(f32x16* o, int vb0, bf16x8 pa0, bf16x8 pa1, bf16x8 pa2, bf16x8 pa3, bool act) {
    if (SK && !act) return;
#define TRRD(dst, off) asm volatile("ds_read_b64_tr_b16 %0, %1 offset:%2" : "=&v"(dst) : "v"(vb0), "i"(off) : "memory")
#define PV_D0(d0) do { s16x4 l0, l1, l2, l3, h0, h1, h2, h3; constexpr int b_ = VB * SHM_V + v_rd_off(d0, 0, 0);     \
        TRRD(l0, b_); TRRD(h0, b_ + 2048); TRRD(l1, b_ + 4096); TRRD(h1, b_ + 6144); TRRD(l2, b_ + 8192); TRRD(h2, b_ + 10240); TRRD(l3, b_ + 12288); TRRD(h3, b_ + 14336); \
        asm volatile("s_waitcnt lgkmcnt(0)" ::: "memory"); SBAR();                 \
        o[d0] = __builtin_amdgcn_mfma_f32_32x32x16_bf16(pa0, (bf16x8){l0[0], l0[1], l0[2], l0[3], h0[0], h0[1], h0[2], h0[3]}, o[d0], 0, 0, 0);   \
        o[d0] = __builtin_amdgcn_mfma_f32_32x32x16_bf16(pa1, (bf16x8){l1[0], l1[1], l1[2], l1[3], h1[0], h1[1], h1[2], h1[3]}, o[d0], 0, 0, 0);   \
        o[d0] = __builtin_amdgcn_mfma_f32_32x32x16_bf16(pa2, (bf16x8){l2[0], l2[1], l2[2], l2[3], h2[0], h2[1], h2[2], h2[3]}, o[d0], 0, 0, 0);   \
        o[d0] = __builtin_amdgcn_mfma_f32_32x32x16_bf16(pa3, (bf16x8){l3[0], l3[1], l3[2], l3[3], h3[0], h3[1], h3[2], h3[3]}, o[d0], 0, 0, 0); } while (0)
    PV_D0(0); PV_D0(1); PV_D0(2); PV_D0(3);
#undef PV_D0
#undef TRRD
}

template <int CTRL> __device__ __forceinline__ float dppq(float v) { return __builtin_bit_cast(float, __builtin_amdgcn_update_dpp(0, __builtin_bit_cast(int, v), CTRL, 0xF, 0xF, true)); }
template <class TIn, class TOut> struct BlockRef { unsigned Q, K, V; TOut* O; int P0; int jlo; };
typedef __amdgpu_buffer_rsrc_t rsrc_t;
#define BL8(soff, voff) __builtin_bit_cast(bf16x8, __builtin_amdgcn_raw_buffer_load_b128(rs, (int)(voff), (int)(soff), 0))
template <class TIn> struct Seam {
    bf16x8 qr[8];
    bf16x8 st_v0, st_v1, st_k0, st_k1; f32x4 sf0, sf1, sf2, sf3;
    f32x4 tq[16];
};
__device__ __forceinline__ int swa_jlo(int P0, int W) { const int lowk = P0 - W + 1; return lowk > 0 ? lowk / KVBLK : 0; }
#define ROW(p, k0, rr) ((const TIn*)((const char*)((p) + (size_t)(k0) * D) + (unsigned)(((rr) * D + sc) * (int)sizeof(TIn))))
#define VMW() asm volatile("s_waitcnt vmcnt(0)" ::: "memory")
#define VMWN(n) asm volatile("s_waitcnt vmcnt(%0)" :: "i"(n) : "memory")
#define SLOAD_H(Kp, Vp, k0) do { S.st_v0 = BL8((Vp) + (unsigned)(k0) * 256u, vo); S.st_v1 = BL8((Vp) + (unsigned)(k0) * 256u + 8192u, vo);              \
                         S.st_k0 = BL8((Kp) + (unsigned)(k0) * 256u, vo); S.st_k1 = BL8((Kp) + (unsigned)(k0) * 256u + 8192u, vo); } while (0)
#define SWRITE_HK(bf) do { *(bf16x8*)(K_lds + (bf) * SHM_K + kws) = S.st_k0; *(bf16x8*)(K_lds + (bf) * SHM_K + kws + 32 * 256) = S.st_k1; } while (0)
#define SWRITE_HV(bf) do { *(bf16x8*)(V_lds + (bf) * SHM_V + vst0) = S.st_v0; *(bf16x8*)(V_lds + (bf) * SHM_V + vst1) = S.st_v1; } while (0)
#define SWRITE_H(bf) do { SWRITE_HV(bf); SWRITE_HK(bf); } while (0)
#define SLOAD_F(p, k0) do { S.sf0 = *(const f32x4*)ROW(p, k0, sr); S.sf1 = *(const f32x4*)(ROW(p, k0, sr) + 4);                \
                            S.sf2 = *(const f32x4*)ROW(p, k0, 32 + sr); S.sf3 = *(const f32x4*)(ROW(p, k0, 32 + sr) + 4); } while (0)
#define SWRITE_KF(bf) do { *(bf16x8*)(K_lds + (bf) * SHM_K + kws) = pack8(S.sf0, S.sf1); *(bf16x8*)(K_lds + (bf) * SHM_K + kws + 32 * 256) = pack8(S.sf2, S.sf3); } while (0)
#define SWRITE_VF(bf) do { *(bf16x8*)(V_lds + (bf) * SHM_V + vst0) = pack8(S.sf0, S.sf1); *(bf16x8*)(V_lds + (bf) * SHM_V + vst1) = pack8(S.sf2, S.sf3); } while (0)
template <class TIn, class TOut>
__device__ __forceinline__ void causal_swa_prime(const rsrc_t rs, const BlockRef<TIn, TOut>& cur, int W, char* lds, Seam<TIn>& S) {
    constexpr bool F32 = false; static_assert(!same_t<TIn, float>::v, "bf16 q/k/v only in this build");
    int tid = threadIdx.x; asm volatile("" : "+v"(tid));
    const int wid = __builtin_amdgcn_readfirstlane(tid >> 6), lane = tid & 63, r32 = lane & 31, hi = lane >> 5;
    const int sr = tid >> 4, sc = (tid & 15) * 8, kws = KSWZ(sr, sc * 2), vo = (sr * D + sc) * 2; char* K_lds = lds + 2 * SHM_V;
    const int kb0 = cur.jlo * KVBLK;
    for (int d0 = 0; d0 < 8; ++d0) S.qr[d0] = BL8(cur.Q + (unsigned)(wid * QBLK * 256 + d0 * 32), (r32 * D + hi * 8) * 2);
    if constexpr (F32) { SLOAD_F((const float*)nullptr, kb0); VMW(); SWRITE_KF(0); SBAR(); SLOAD_F((const float*)nullptr, kb0); }
    else { SLOAD_H(cur.K, cur.V, kb0); VMW(); SWRITE_HK(0); }
    __syncthreads();
}
template <class TIn, class TOut>
__device__ __forceinline__ void causal_swa_block(const rsrc_t rs, const BlockRef<TIn, TOut>& cur, const BlockRef<TIn, TOut>& nxt, int skv, int W, char* lds, Seam<TIn>& S) {
    constexpr bool F32 = false; static_assert(!same_t<TIn, float>::v, "bf16 q/k/v only in this build");
    int tid = threadIdx.x; asm volatile("" : "+v"(tid));
    const int wid = __builtin_amdgcn_readfirstlane(tid >> 6), lane = tid & 63, r32 = lane & 31, hi = lane >> 5;
    const int j_lo = cur.jlo;
    int j_hi = (cur.P0 + QB - 1) / KVBLK + 1; if (j_hi > skv / KVBLK) j_hi = skv / KVBLK;
    const int NT = j_hi - j_lo;
    const int kbn = nxt.jlo * KVBLK;
    const int qlo = cur.P0 + wid * QBLK, qm = qlo + r32 - 4 * hi;
    char* V_lds = lds; char* K_lds = lds + 2 * SHM_V;
    float* ws = (float*)(lds + 2 * SHM_V + 2 * SHM_K) + wid * 64; float* li_l = ws, * al_l = ws + 32;
    const float* kbl = (const float*)(lds + LDS_KB) + 4 * hi;
    float m_reg = -1e30f, l_reg = 0; f32x16 o[4] = {};
    const int sr = tid >> 4, sc = (tid & 15) * 8, vst0 = v_st(sr, sc), vst1 = v_st(32 + sr, sc), kws = KSWZ(sr, sc * 2), vo = (sr * D + sc) * 2;
    const int vb0 = (int)(uintptr_t)V_lds + v_rd_base(lane);
    const unsigned Kh = cur.K, Vh = cur.V;
#define RESC(a) do { if (__any((a) < 1.f)) { if (hi == 0) al_l[r32] = (a); asm volatile("s_waitcnt lgkmcnt(0)" ::: "memory");              \
                     for (int d_ = 0; d_ < 4; ++d_) for (int r = 0; r < 16; ++r) o[d_][r] *= al_l[crow(r, hi)]; } } while (0)
#define KBASE(t) ((j_lo + (t)) * KVBLK)
#define ACT(t) (KBASE(t) <= qlo + QBLK - 1 && KBASE(t) + KVBLK - 1 >= qlo - W + 1)
#define MASKT(P0_, P1_, t) do { const int kb_ = KBASE(t); if ((!SK || ACT(t)) && (kb_ + KVBLK - 1 > qlo || kb_ <= qlo + QBLK - 1 - W)) mask_tile(P0_, P1_, qm - kb_, (unsigned)W); } while (0)
    constexpr int NQL = F32 ? 16 : 8;
    constexpr bool SK = WSKIP && !F32;
#define SEAM_K0() do { VMWN(NQL); if constexpr (F32) { SWRITE_KF(0); SBAR(); SLOAD_F((const float*)nullptr, kbn); } else { SWRITE_HK(0); } SBAR(); } while (0)
    f32x16 pA0, pA1, pB0, pB1; float mnA, mnB, alA, alB; bf16x8 pa0, pa1, pa2, pa3;
    if constexpr (F32) { VMW(); SWRITE_VF(0); SBAR(); } else { SWRITE_HV(0); SBAR(); }
    if (NT > 1) { if constexpr (F32) SLOAD_F((const float*)nullptr, KBASE(1)); else SLOAD_H(Kh, Vh, KBASE(1)); }
    SBAR(); qkt<0, SK>(pA0, pA1, K_lds, r32, hi, S.qr, ACT(0), kbl + KBASE(0));
    if constexpr (F32) { if (NT > 1) { VMW(); SWRITE_KF(1); SBAR(); SLOAD_F((const float*)nullptr, KBASE(1)); } }
    MASKT(pA0, pA1, 0); partialSM(pA0, pA1, m_reg, mnA, alA);
    if (NT > 1) { VMW(); if constexpr (F32) { SWRITE_VF(1); SBAR(); if (NT > 2) SLOAD_F((const float*)nullptr, KBASE(2)); } else SWRITE_H(1); }
    __syncthreads();
#define HALF_STEP(PX0, PX1, mnX, alX, PY0, PY1, alY, t, KB, VB, SB) do {                                                      \
        SBAR(); qkt<KB, SK>(PX0, PX1, K_lds, r32, hi, S.qr, ACT(t), kbl + KBASE(t));                                             \
        finishSM(PY0, PY1, alY, l_reg, pa0, pa1, pa2, pa3); SBAR();                                                           \
        if ((t) + 1 < NT) { if constexpr (F32) { VMW(); SWRITE_KF(SB); SBAR(); SLOAD_F((const float*)nullptr, KBASE((t) + 1)); }  \
                            else { SLOAD_H(Kh, Vh, KBASE((t) + 1)); } SBAR(); }                                               \
        pv_tile<VB, SK>(o, vb0, pa0, pa1, pa2, pa3, ACT((t) - 1)); MASKT(PX0, PX1, (t)); partialSM(PX0, PX1, m_reg, mnX, alX);                                        \
        __syncthreads();                                                                                                      \
        if ((t) + 1 < NT) { VMW(); if constexpr (F32) { SWRITE_VF(SB); SBAR(); if ((t) + 2 < NT) SLOAD_F((const float*)nullptr, KBASE((t) + 2)); } \
                            else { SWRITE_H(SB); } }                                                                          \
        RESC(alX); __syncthreads(); } while (0)
    for (int t = 1; t + 1 < NT; t += 2) {
        HALF_STEP(pB0, pB1, mnB, alB, pA0, pA1, alA, t, 1, 0, 0);
        HALF_STEP(pA0, pA1, mnA, alA, pB0, pB1, alB, t + 1, 0, 1, 1);
    }
    const bool even = (NT & 1) == 0;
    if (even) { SBAR(); qkt<1, SK>(pB0, pB1, K_lds, r32, hi, S.qr, ACT(NT - 1), kbl + KBASE(NT - 1)); SBAR(); }
#define QROW(e) ((const float*)nullptr + (size_t)(wid * QBLK + r32) * D + ((e) >> 1) * 16 + hi * 8 + ((e) & 1) * 4)
    if constexpr (F32) { SLOAD_F((const float*)nullptr, kbn); SBAR();
#pragma unroll
        for (int e = 0; e < 8; ++e) S.tq[e] = *(const f32x4*)QROW(e); }
    else { SLOAD_H(nxt.K, nxt.V, kbn); SBAR();
#pragma unroll
        for (int d0 = 0; d0 < 8; ++d0) S.qr[d0] = BL8(nxt.Q + (unsigned)(wid * QBLK * 256 + d0 * 32), (r32 * D + hi * 8) * 2); }
    SBAR();
    finishSM(pA0, pA1, alA, l_reg, pa0, pa1, pa2, pa3); SBAR();
    if constexpr (F32) {
#pragma unroll
        for (int e = 8; e < 16; ++e) S.tq[e] = *(const f32x4*)QROW(e); SBAR(); }
#undef QROW
    pv_tile<0, SK>(o, vb0, pa0, pa1, pa2, pa3, ACT(even ? NT - 2 : NT - 1));
    if (even) { MASKT(pB0, pB1, NT - 1); partialSM(pB0, pB1, m_reg, mnB, alB); __syncthreads(); RESC(alB);
        finishSM(pB0, pB1, alB, l_reg, pa0, pa1, pa2, pa3); SBAR(); pv_tile<1, SK>(o, vb0, pa0, pa1, pa2, pa3, ACT(NT - 1)); }
    SBAR(); SEAM_K0();
    if (hi == 0) li_l[r32] = l_reg; asm volatile("s_waitcnt lgkmcnt(0)" ::: "memory");
    float rli[16];
#pragma unroll
    for (int r = 0; r < 16; ++r) rli[r] = __builtin_amdgcn_rcpf(li_l[crow(r, hi)]);
    TOut* Ow = cur.O + (size_t)(wid * QBLK) * OSTRIDE;
#pragma unroll
    for (int r = 0; r < 16; ++r) { const int orow = crow(r, hi);
#pragma unroll
        for (int d0 = 0; d0 < 4; ++d0) { const float v = o[d0][r] * rli[r];
            if constexpr (same_t<TOut, float>::v) { Ow[(size_t)orow * OSTRIDE + d0 * 32 + r32] = v; }
            else if constexpr (same_t<TOut, unsigned char>::v) { const float v16 = 16.f * v, v1 = dppq<0xB1>(v16), v2 = dppq<0x4E>(v16), v3 = dppq<0x1B>(v16);
                   if ((r32 & 3) == 0) *(unsigned*)(Ow + (size_t)orow * OSTRIDE + d0 * 32 + r32) = pg8::pk4_fp8(v16, v1, v2, v3); }
            else { const float vn = dppq<0xB1>(v);
                   if ((r32 & 1) == 0) *(unsigned*)(Ow + (size_t)orow * OSTRIDE + d0 * 32 + r32) = cvtpk(v, vn); } } }
    if constexpr (F32) {
#pragma unroll
        for (int d0 = 0; d0 < 8; ++d0) S.qr[d0] = pack8(S.tq[2 * d0], S.tq[2 * d0 + 1]); }
    __syncthreads();
#undef RESC
#undef KBASE
#undef ACT
#undef MASKT
#undef SEAM_K0
#undef HALF_STEP
}
#undef ROW
#undef VMW
#undef VMWN
#undef SLOAD_H
#undef SWRITE_HK
#undef SWRITE_HV
#undef SWRITE_H
#undef SLOAD_F
#undef SWRITE_KF
#undef SWRITE_VF

}

struct Frame {
    LAS unsigned char* lds;
    volatile LAS unsigned* MISC;
    gu32* ctl;
    unsigned char* ws;
    int tid, lane, wave;
    int vcu, G;
    const float* const* in;
    float* out;
};

__device__ __forceinline__ void cvt_load(f32x4 (&v)[16], const float* src  , size_t ld, int rq, int nq) {
#pragma unroll
    for (int i = 0; i < 8; ++i) { const float* p = src + (size_t)(8 * i + 2 * rq) * ld + 4 * nq; v[2 * i] = __builtin_nontemporal_load((const f32x4*)p); v[2 * i + 1] = __builtin_nontemporal_load((const f32x4*)(p + ld)); }
}
__device__ __forceinline__ void cvt_store(const f32x4 (&v)[16], const f32x2v (&sc)[8], bool scaled, LAS unsigned* tile, bf16* dst  , int K, int lane, int rq, int nq) {
#pragma unroll
    for (int i = 0; i < 8; ++i) { f32x4 a = v[2 * i], b = v[2 * i + 1]; if (scaled) { a = a * sc[i].x; b = b * sc[i].y; }
#pragma unroll
        for (int j = 0; j < 4; ++j) tile[(4 * nq + j) * 33 + 4 * i + rq] = pk2(a[j], b[j]); }
    LDS_WAIT(); asm volatile("" ::: "memory");
    const int nr = lane >> 3, ch = lane & 7;
#pragma unroll
    for (int q = 0; q < 8; ++q) { const LAS unsigned* s = tile + (8 * q + nr) * 33 + 4 * ch; v4u o; o.x = s[0]; o.y = s[1]; o.z = s[2]; o.w = s[3];
        *(v4u*)(dst + (size_t)(8 * q + nr) * K + 8 * ch) = o; }
    LDS_WAIT(); asm volatile("" ::: "memory");
}
__device__ __forceinline__ void cvt_item(const float* src0, const float* src1, size_t ld_src, bf16* dst, int K, const float* scale  , LAS unsigned* tile, int lane) {
    const int rq = lane >> 4, nq = lane & 15;
    f32x2v sc[8];
    if (scale) {
#pragma unroll
        for (int i = 0; i < 8; ++i) sc[i] = *(const f32x2v*)(scale + 8 * i + 2 * rq);
    }
    f32x4 va[16], vb[16];
    cvt_load(va, src0, ld_src, rq, nq);
    cvt_load(vb, src0 + 64, ld_src, rq, nq);
    cvt_store(va, sc, scale != nullptr, tile, dst, K, lane, rq, nq);
    cvt_load(va, src1, ld_src, rq, nq);
    cvt_store(vb, sc, scale != nullptr, tile, dst + (size_t)64 * K, K, lane, rq, nq);
    cvt_load(vb, src1 + 64, ld_src, rq, nq);
    cvt_store(va, sc, scale != nullptr, tile, dst + (size_t)128 * K, K, lane, rq, nq);
    cvt_store(vb, sc, scale != nullptr, tile, dst + (size_t)192 * K, K, lane, rq, nq);
}
__device__ __forceinline__ void cvt8_load(f32x4 (&v)[16], const float* src  , size_t ld, int rq, int nq) {
#pragma unroll
    for (int i = 0; i < 4; ++i)
#pragma unroll
        for (int r = 0; r < 4; ++r) v[4 * i + r] = __builtin_nontemporal_load((const f32x4*)(src + (size_t)(16 * i + 4 * rq + r) * ld + 4 * nq));
}
__device__ __forceinline__ void cvt8_pack(const f32x4 (&v)[16], const LAS float* scl  , LAS unsigned* tile, int hh, int rq, int nq) {
#pragma unroll
    for (int i = 0; i < 4; ++i) { const f32x4 s4 = *(const LAS f32x4*)(scl + 64 * hh + 16 * i + 4 * rq);
#pragma unroll
        for (int j = 0; j < 4; ++j) tile[(4 * nq + j) * 33 + 16 * hh + 4 * i + rq] = pg8::pk4_fp8(v[4 * i][j] * s4.x, v[4 * i + 1][j] * s4.y, v[4 * i + 2][j] * s4.z, v[4 * i + 3][j] * s4.w); }
}
__device__ __forceinline__ void cvt8_flush(LAS unsigned* tile, unsigned char* dst  , int Kb, int lane) {
    LDS_WAIT(); asm volatile("" ::: "memory");
    const int nr = lane >> 3, ch = lane & 7;
#pragma unroll
    for (int q = 0; q < 8; ++q) { const LAS unsigned* s = tile + (8 * q + nr) * 33 + 4 * ch; v4u o; o.x = s[0]; o.y = s[1]; o.z = s[2]; o.w = s[3];
        *(v4u*)(dst + (size_t)(8 * q + nr) * Kb + 16 * ch) = o; }
    LDS_WAIT(); asm volatile("" ::: "memory");
}
__device__ __forceinline__ void cvt8_item(const float* src0, const float* src1, size_t ld_src, unsigned char* dst, int Kb, const float* scale, LAS unsigned* tile, LAS float* scl  , int lane, int nsub  ) {
    const int rq = lane >> 4, nq = lane & 15;
    if (lane < 32) { f32x4 s4 = {256.f, 256.f, 256.f, 256.f}; if (scale) s4 = *(const f32x4*)(scale + 4 * lane) * 256.f; *(LAS f32x4*)(scl + 4 * lane) = s4; }
    LDS_WAIT(); asm volatile("" ::: "memory");
    f32x4 va[16], vb[16];
    cvt8_load(va, src0, ld_src, rq, nq); cvt8_load(vb, src0 + 64 * ld_src, ld_src, rq, nq);
#pragma unroll 1
    for (int s = 0; s + 1 < nsub; ++s) {
        const float* nsrc = (s + 1 < 2 ? src0 : src1) + 64 * ((s + 1) & 1);
        cvt8_pack(va, scl, tile, 0, rq, nq); __builtin_amdgcn_sched_barrier(0);
        cvt8_load(va, nsrc, ld_src, rq, nq); __builtin_amdgcn_sched_barrier(0);
        cvt8_pack(vb, scl, tile, 1, rq, nq); __builtin_amdgcn_sched_barrier(0);
        cvt8_load(vb, nsrc + 64 * ld_src, ld_src, rq, nq); __builtin_amdgcn_sched_barrier(0);
        cvt8_flush(tile, dst + (size_t)(64 * s) * Kb, Kb, lane);
    }
    cvt8_pack(va, scl, tile, 0, rq, nq);
    cvt8_pack(vb, scl, tile, 1, rq, nq);
    cvt8_flush(tile, dst + (size_t)(64 * (nsub - 1)) * Kb, Kb, lane);
}
constexpr int I_W13 = NEXP * 16 * 8, I_W2 = NEXP * 8 * 8;
__device__ __forceinline__ void cvt8_moe_item(const float* const* in, unsigned char* ws, int r, LAS unsigned* tile, LAS float* scl, int lane) {
    const float* s0; const float* s1; size_t ld; unsigned char* dst8; int K; const float* scale;
    if (r < I_W13) { const int e = r / 128, q = r % 128, kb = q / 8, nb = q % 8, k0 = 128 * kb;
        const size_t so = (size_t)e * DM * DFF + (size_t)k0 * DFF + 128 * nb;
        s0 = in[14] + so; s1 = in[15] + so; ld = DFF; dst8 = ws + WS_W13 + ((size_t)e * 2048 + 256 * nb) * DM + k0; K = DM; scale = in[9] + k0; }
    else { r -= I_W13; const int e = r / 64, q = r % 64, kb = q / 8, nb = q % 8, k0 = 128 * kb, n = 256 * nb;
        s0 = in[16] + (size_t)e * DFF * DM + (size_t)k0 * DM + n; s1 = s0 + 128; ld = DM; dst8 = ws + WS_W2 + ((size_t)e * 2048 + n) * DFF + k0; K = DFF; scale = nullptr; }
    cvt8_item(s0, s1, ld, dst8, K, scale, tile, scl, lane, 4);
}
__device__ __forceinline__ void p0_prologue(Frame& F) {
    const int gw = F.vcu * NWAVES + F.wave, NGW = F.G * NWAVES, lane = F.lane;
    const float* x = F.in[0]; const float* g1 = F.in[1]; const float* w_in = F.in[2]; const float* b_fg = F.in[3];
    LAS float* tb = (LAS float*)(F.lds + RING_OFF);
    for (int k = F.tid; k < DM; k += NWAVES * 64) { const int j = k >> 8, l = (k & 255) >> 2, i = k & 3; const float g = g1[k];
        const f32x4 a = *(const f32x4*)(w_in + (size_t)k * NCOLS + 3072), b = *(const f32x4*)(w_in + (size_t)k * NCOLS + 3076);
        LAS f32x4* d = (LAS f32x4*)(tb + ((j * 4 + i) * 64 + l) * 8); d[0] = a * g; d[1] = b * g; }
    __syncthreads();
    bf16* xb = (bf16*)(F.ws + WS_XB); float* rstd1 = (float*)(F.ws + WS_RSTD1); float* logf = (float*)(F.ws + WS_LOGF);
    for (int m = gw; m < T; m += NGW) {
        const GAS f32x4* xr = (const GAS f32x4*)(x + (size_t)m * DM) + lane;
        f32x4 v[8]; float ss = 0.f;
#pragma unroll
        for (int j = 0; j < 8; ++j) { v[j] = xr[64 * j]; ss += (v[j].x * v[j].x + v[j].y * v[j].y) + (v[j].z * v[j].z + v[j].w * v[j].w); }
        const float rstd = __builtin_amdgcn_rsqf(wave_sum(ss) * (1.0f / DM) + EPS);
        float fa[8];
#pragma unroll
        for (int h = 0; h < 8; ++h) fa[h] = 0.f;
#pragma unroll
        for (int j = 0; j < 8; ++j)
#pragma unroll
            for (int i = 0; i < 4; ++i) { const LAS f32x4* d = (const LAS f32x4*)(tb + ((j * 4 + i) * 64 + lane) * 8); const f32x4 a = d[0], b = d[1]; const float xv = v[j][i];
                fa[0] += xv * a.x; fa[1] += xv * a.y; fa[2] += xv * a.z; fa[3] += xv * a.w; fa[4] += xv * b.x; fa[5] += xv * b.y; fa[6] += xv * b.z; fa[7] += xv * b.w; }
        GAS v2u* o8 = (GAS v2u*)(xb + (size_t)m * DM) + lane; GAS unsigned* o4 = (GAS unsigned*)(F.ws + WS_X8 + (size_t)m * DM) + lane;
#pragma unroll
        for (int j = 0; j < 8; ++j) { v2u w; w.x = pk2(v[j].x, v[j].y); w.y = pk2(v[j].z, v[j].w); o8[64 * j] = w; o4[64 * j] = pg8::pk4_fp8(16.f * v[j].x, 16.f * v[j].y, 16.f * v[j].z, 16.f * v[j].w); }
        float mine = 0.f;
#pragma unroll
        for (int h = 0; h < 8; ++h) { const float s = wave_sum(fa[h]); if (lane == h) mine = s; }
        if (lane == 0) rstd1[m] = rstd;
        if (lane < 8) { const float z = mine * rstd + b_fg[lane];
            const float ez = __expf(-fabsf(z)); const float ls = fminf(z, 0.f) - (ez < 1e-4f ? ez * (1.0f - 0.5f * ez) : __logf(1.0f + ez));
            const int b = m >> 12, s = m & 4095; logf[(size_t)(b * 8 + lane) * SEQ + s] = ls; }
    }
    { bf16* wr = (bf16*)(F.ws + WS_WR); const float* g2 = F.in[9]; const float* wg = F.in[10]; const float* we = F.in[12];
      for (int idx = (F.vcu * NWAVES * 64 + F.tid); idx < 64 * DM; idx += F.G * NWAVES * 64) { const int r = idx >> 11, k = idx & 2047;
          float v = 0.f; if (r < 4) v = wg[k * 4 + r] * g2[k]; else if (r < 36) v = we[k * 32 + (r - 4)] * g2[k];
          wr[idx] = (bf16)(pk2(v, 0.f) & 0xffffu); } }
    __syncthreads();
    LAS unsigned* tile = (LAS unsigned*)(F.lds + RING_OFF) + F.wave * (64 * 33);
    constexpr int NT16 = 4 * PJ16.n, I_WIN = 32 * NT16, I_WIN8 = 16 * 16, H_X8 = 16 * 8 * PJ8.n, I_PA = P5_F8 ? 0 : 16 * 8, I_PB = P5_F8 ? 0 : 16 * 8, I_WOUT = P6_F8 ? 0 : 32 * 8;
    constexpr int H_PAB = P5_F8 ? 16 * 16 : 0, H_WOUT = P6_F8 ? 16 * 16 : 0;
    constexpr int NITEMS16 = I_WIN + I_PA + I_PB + I_WOUT;
#pragma unroll 1
    for (int it = gw; it < NITEMS16; it += NGW) {
        int r = it; const float* s0; size_t ld; bf16* dst; int K; const float* scale;
        if (r < I_WIN) { const int kb = r / NT16, nb = r % NT16, k0 = 64 * kb, n = 256 * nb, nsrc = pj_srccol(pj_kind16(nb >> 2)) + 256 * (nb & 3);
            s0 = w_in + (size_t)k0 * NCOLS + nsrc; ld = NCOLS; dst = (bf16*)(F.ws + WS_WIN) + (size_t)n * DM + k0; K = DM; scale = g1 + k0; }
        else if ((r -= I_WIN) < I_PA) { const int kb = r / 8, nb = r % 8, k0 = 64 * kb, n = 256 * nb;
            s0 = F.in[6] + (size_t)k0 * DM + n; ld = DM; dst = (bf16*)(F.ws + WS_PAB) + (size_t)n * DM + k0; K = DM; scale = nullptr; }
        else if ((r -= I_PA) < I_PB) { const int kb = r / 8, nb = r % 8, k0 = 64 * kb, n = 256 * nb;
            s0 = F.in[7] + (size_t)k0 * DM + n; ld = DM; dst = (bf16*)(F.ws + WS_PAB) + (size_t)n * DM + MW + k0; K = DM; scale = F.in[5] + k0; }
        else { r -= I_PB; const int kb = r / 8, nb = r % 8, k0 = 64 * kb, n = 256 * nb;
            s0 = F.in[8] + (size_t)k0 * DM + n; ld = DM; dst = (bf16*)(F.ws + WS_WOUT) + (size_t)n * DM + k0; K = DM; scale = nullptr; }
        cvt_item(s0, s0 + 128, ld, dst, K, scale, tile, lane);
    }
#pragma unroll 1
    for (int hi = (gw + NGW - NITEMS16 % NGW) % NGW; hi < 2 * I_WIN8 + H_X8 + H_PAB + H_WOUT; hi += NGW) {
        const float* s0; size_t ld; unsigned char* dst; const float* scale;
        if (hi < 2 * I_WIN8 + H_X8) { int kb, n, scol;
            if (hi < 2 * I_WIN8) { kb = hi / 32; const int nh = hi % 32; n = 128 * nh; scol = GATE_COL0 + (nh & 1) * DM + 128 * (nh >> 1); }
            else { const int r = hi - 2 * I_WIN8, per = 8 * PJ8.n; kb = r / (per > 0 ? per : 1); const int nh = r % (per > 0 ? per : 1); n = 4096 + 128 * nh; scol = pj_srccol(pj_kind8(nh >> 3)) + 128 * (nh & 7); }
            const int k0 = 128 * kb; s0 = w_in + (size_t)k0 * NCOLS + scol; ld = NCOLS; dst = F.ws + WS_WIN8 + (size_t)n * DM + k0; scale = g1 + k0; }
        else if (hi < 2 * I_WIN8 + H_X8 + H_PAB) { const int r = hi - (2 * I_WIN8 + H_X8), kb = r >> 4, n = 128 * (r & 15), k0 = 128 * kb;
            s0 = (kb < 8 ? F.in[6] + (size_t)k0 * DM : F.in[7] + (size_t)(k0 - MW) * DM) + n; ld = DM; dst = F.ws + WS_PAB + (size_t)n * DM + k0; scale = kb < 8 ? nullptr : F.in[5] + (k0 - MW); }
        else { const int r = hi - (2 * I_WIN8 + H_X8 + H_PAB), kb = r >> 4, n = 128 * (r & 15), k0 = 128 * kb;
            s0 = F.in[8] + (size_t)k0 * DM + n; ld = DM; dst = F.ws + WS_WOUT + (size_t)n * DM + k0; scale = nullptr; }
        cvt8_item(s0, s0, ld, dst, DM, scale, tile, (LAS float*)(F.lds + PARK_OFF) + F.wave * 128, lane, 2);
    }
}

__device__ __forceinline__ void naive_cumsum(Frame& F) {
    const float* logf = (const float*)(F.ws + WS_LOGF); float* cum = (float*)(F.ws + WS_CUM);
    LAS float* part = (LAS float*)(F.lds + RING_OFF);
    for (int bh = blockIdx.x; bh < BATCH * NH; bh += F.G) {
        const float* src = logf + (size_t)bh * SEQ + F.tid * 8; float v[8]; float s = 0.f;
#pragma unroll
        for (int i = 0; i < 8; ++i) { v[i] = src[i]; s += v[i]; v[i] = s; }
        part[F.tid] = s; __syncthreads();
        float pre = 0.f; for (int i = 0; i < F.tid; ++i) pre += part[i];
#pragma unroll
        for (int i = 0; i < 8; ++i) cum[(size_t)bh * SEQ + F.tid * 8 + i] = v[i] + pre;
        __syncthreads();
    }
}
__device__ __forceinline__ void naive_attention(Frame& F) {
    const bf16* Q = (const bf16*)(F.ws + WS_QKV); const bf16* Kt = Q + (size_t)T * MW; const bf16* V = Kt + (size_t)T * MW;
    const float* cum = (const float*)(F.ws + WS_CUM); bf16* oa = (bf16*)(F.ws + WS_OAB);
    const int qi = F.tid >> 4, part = F.tid & 15;
    for (int u = blockIdx.x; u < BATCH * NH * (SEQ / 32); u += F.G) {
        const int bh = u / (SEQ / 32), qb = u % (SEQ / 32), row = qb * 32 + qi;
        const bf16* kb = Kt + (size_t)bh * SEQ * HD + part * 8; const bf16* vb = V + (size_t)bh * SEQ * HD + part * 8;
        float q[8], o[8]; { const v4u w = *(const v4u*)(Q + ((size_t)bh * SEQ + row) * HD + part * 8);
            q[0] = bflo(w.x); q[1] = bfhi(w.x); q[2] = bflo(w.y); q[3] = bfhi(w.y); q[4] = bflo(w.z); q[5] = bfhi(w.z); q[6] = bflo(w.w); q[7] = bfhi(w.w); }
#pragma unroll
        for (int d = 0; d < 8; ++d) o[d] = 0.f;
        float m = -1e30f, l = 0.f; const float ci = cum[(size_t)bh * SEQ + row]; const float* cj = cum + (size_t)bh * SEQ;
        const int jend = qb * 32 + 32;
        for (int j0 = 0; j0 < jend; j0 += 4) {
            v4u kw[4], vw[4]; float cjv[4];
#pragma unroll
            for (int e = 0; e < 4; ++e) { kw[e] = *(const v4u*)(kb + (size_t)(j0 + e) * HD); vw[e] = *(const v4u*)(vb + (size_t)(j0 + e) * HD); cjv[e] = cj[j0 + e]; }
#pragma unroll
            for (int e = 0; e < 4; ++e) {
                float s = q[0] * bflo(kw[e].x) + q[1] * bfhi(kw[e].x) + q[2] * bflo(kw[e].y) + q[3] * bfhi(kw[e].y) + q[4] * bflo(kw[e].z) + q[5] * bfhi(kw[e].z) + q[6] * bflo(kw[e].w) + q[7] * bfhi(kw[e].w);
                s += __shfl_xor(s, 1); s += __shfl_xor(s, 2); s += __shfl_xor(s, 4); s += __shfl_xor(s, 8);
                s = s * ATT_SCALE + (ci - cjv[e]);
                if (j0 + e <= row) { const float mn = fmaxf(m, s), al = __expf(m - mn), p = __expf(s - mn); l = l * al + p; m = mn;
                    o[0] = o[0] * al + p * bflo(vw[e].x); o[1] = o[1] * al + p * bfhi(vw[e].x); o[2] = o[2] * al + p * bflo(vw[e].y); o[3] = o[3] * al + p * bfhi(vw[e].y);
                    o[4] = o[4] * al + p * bflo(vw[e].z); o[5] = o[5] * al + p * bfhi(vw[e].z); o[6] = o[6] * al + p * bflo(vw[e].w); o[7] = o[7] * al + p * bfhi(vw[e].w); }
            }
        }
        const float il = 1.0f / l; const int b = bh >> 3, h = bh & 7;
        v4u w; w.x = pk2(o[0] * il, o[1] * il); w.y = pk2(o[2] * il, o[3] * il); w.z = pk2(o[4] * il, o[5] * il); w.w = pk2(o[6] * il, o[7] * il);
        *(v4u*)(oa + ((size_t)(b * SEQ + row)) * (2 * MW) + h * HD + part * 8) = w;
    }
}
__device__ __forceinline__ void naive_hgrn(Frame& F) {
    const bf16* QB = (const bf16*)(F.ws + WS_HG); const bf16* FB = QB + (size_t)T * MW; const bf16* IB = FB + (size_t)T * MW;
    float* obf = (float*)(F.ws + WS_OBF); const float* lbl = F.in[4];
    const int gw = F.vcu * NWAVES + F.wave, NGW = F.G * NWAVES, lane = F.lane, vc = lane & 31, kh = lane >> 5;
    LAS f32x4* fq = (LAS f32x4*)(F.lds + RING_OFF + 65536) + F.wave * 64;
    for (int u = gw; u < BATCH * NH * 4; u += NGW) {
        const int bh = u >> 2, vg = u & 3, b = bh >> 3, h = bh & 7, vcol = vg * 32 + vc;
        const float lb0 = sigm(lbl[h * HD + 2 * lane] - lbl[MW + h * HD + 2 * lane]), lb1 = sigm(lbl[h * HD + 2 * lane + 1] - lbl[MW + h * HD + 2 * lane + 1]);
        float S[64];
#pragma unroll
        for (int k = 0; k < 64; ++k) S[k] = 0.f;
        const size_t base = (size_t)b * SEQ * MW + h * HD;
        unsigned fw = *(const unsigned*)(FB + base + 2 * lane), qw = *(const unsigned*)(QB + base + 2 * lane); bf16 vw = IB[base + vcol];
#pragma unroll 1
        for (int t = 0; t < SEQ; ++t) {
            const unsigned fc = fw, qc = qw; const float v = bf1(vw);
            if (t + 1 < SEQ) { const size_t nb_ = base + (size_t)(t + 1) * MW; fw = *(const unsigned*)(FB + nb_ + 2 * lane); qw = *(const unsigned*)(QB + nb_ + 2 * lane); vw = IB[nb_ + vcol]; }
            const float f0 = lb0 + (1.f - lb0) * sigm(bflo(fc)), f1 = lb1 + (1.f - lb1) * sigm(bfhi(fc));
            fq[lane] = (f32x4){f0, bflo(qc), f1, bfhi(qc)};
            LDS_WAIT(); asm volatile("" ::: "memory");
            float o = 0.f;
#pragma unroll
            for (int i = 0; i < 32; ++i) { const f32x4 w = fq[kh * 32 + i];
                S[2 * i] = w.x * S[2 * i] + (1.f - w.x) * v; o += S[2 * i] * w.y;
                S[2 * i + 1] = w.z * S[2 * i + 1] + (1.f - w.z) * v; o += S[2 * i + 1] * w.w; }
            o += __shfl_xor(o, 32);
            if (kh == 0) obf[base + (size_t)t * MW + vcol] = o;
            LDS_WAIT(); asm volatile("" ::: "memory");
        }
    }
}
__device__ __forceinline__ void naive_hgrn_norm(Frame& F) {
    const float* obf = (const float*)(F.ws + WS_OBF); const bf16* GB = (const bf16*)(F.ws + WS_HG) + (size_t)3 * T * MW; bf16* obn = (bf16*)(F.ws + WS_OAB) + MW;
    const int gw = F.vcu * NWAVES + F.wave, NGW = F.G * NWAVES, lane = F.lane;
    for (int u = gw; u < T * NH; u += NGW) {
        const size_t off = (size_t)u * HD + 2 * lane;
        const float a = obf[off], b = obf[off + 1]; const float ss = wave_sum(a * a + b * b);
        const float rs = 1.0f / sqrtf(ss * (1.0f / HD) + EPS); const unsigned gw_ = *(const unsigned*)(GB + off); const float g0 = bflo(gw_), g1 = bfhi(gw_);
        *(unsigned*)(obn + (size_t)(u >> 3) * (2 * MW) + (u & 7) * HD + 2 * lane) = pk2(a * rs * g0 * sigm(g0), b * rs * g1 * sigm(g1));
    }
}

__device__ __forceinline__ void router_phase(Frame& F) {
    const bf16* x1b = (const bf16*)(F.ws + WS_X1B); const bf16* wr = (const bf16*)(F.ws + WS_WR);
    int* tlist = (int*)(F.ws + WS_TLIST); float* slot_rs = (float*)(F.ws + WS_SLOTRS);
    float* rstd2 = (float*)(F.ws + WS_RSTD2); int* a_e = (int*)(F.ws + WS_AE); int* a_slot = (int*)(F.ws + WS_ASLOT); float* a_w = (float*)(F.ws + WS_AW);
    const float* bgp = F.in[11]; const float* bex = F.in[13];
    const int lane = F.lane, fr = lane & 15, fq = lane >> 4, sub = F.wave & 3, half = F.wave >> 2;
    LAS float* Lg = (LAS float*)(F.lds + RING_OFF) + (sub * 2 + half) * (16 * 48 + 16);
    for (int base = F.vcu * 4; base < T / 16; base += F.G * 4) {
        const int g = base + sub;
        const bf16* arow = x1b + (size_t)(g * 16 + fr) * DM + half * (DM / 2) + 8 * fq; const bf16* brow = wr + (size_t)fr * DM + half * (DM / 2) + 8 * fq;
        pg8::f32x4 acc[3]; for (int n = 0; n < 3; ++n) acc[n] = (pg8::f32x4){0.f, 0.f, 0.f, 0.f};
        float ss = 0.f;
#pragma unroll 8
        for (int k0 = 0; k0 < DM / 2; k0 += 32) {
            const v4u aw = *(const v4u*)(arow + k0);
            ss += bflo(aw.x) * bflo(aw.x) + bfhi(aw.x) * bfhi(aw.x) + bflo(aw.y) * bflo(aw.y) + bfhi(aw.y) * bfhi(aw.y) + bflo(aw.z) * bflo(aw.z) + bfhi(aw.z) * bfhi(aw.z) + bflo(aw.w) * bflo(aw.w) + bfhi(aw.w) * bfhi(aw.w);
            const bf16x8 a = __builtin_bit_cast(bf16x8, aw);
#pragma unroll
            for (int n = 0; n < 3; ++n) { const bf16x8 bfrag = *(const bf16x8*)(brow + (size_t)(n * 16) * DM + k0);
                acc[n] = __builtin_amdgcn_mfma_f32_16x16x32_bf16(a, bfrag, acc[n], 0, 0, 0); }
        }
        ss += __shfl_xor(ss, 16); ss += __shfl_xor(ss, 32);
#pragma unroll
        for (int n = 0; n < 3; ++n)
#pragma unroll
            for (int j = 0; j < 4; ++j) Lg[(4 * fq + j) * 48 + n * 16 + fr] = acc[n][j];
        if (fq == 0) Lg[16 * 48 + fr] = ss;
        __syncthreads();
        if (half == 0 && lane < 16) {
            const LAS float* l0 = Lg + lane * 48; const LAS float* l1 = l0 + (16 * 48 + 16);
            const int t = g * 16 + lane; const float r = __builtin_amdgcn_rsqf((Lg[16 * 48 + lane] + Lg[(16 * 48 + 16) + 16 * 48 + lane]) * (1.0f / DM) + EPS);
            float lg[4]; int gi = 0; float gm = -3.0e38f;
#pragma unroll
            for (int i = 0; i < 4; ++i) { lg[i] = (l0[i] + l1[i]) * r + bgp[i]; if (lg[i] > gm) { gm = lg[i]; gi = i; } }
            float gs = 0.f;
#pragma unroll
            for (int i = 0; i < 4; ++i) gs += __expf(lg[i] - gm);
            const float g_w = __builtin_amdgcn_rcpf(gs);
            float le[8]; int i1 = 0; float m1 = -3.0e38f;
#pragma unroll
            for (int i = 0; i < 8; ++i) { le[i] = (l0[4 + gi * 8 + i] + l1[4 + gi * 8 + i]) * r + bex[gi * 8 + i]; if (le[i] > m1) { m1 = le[i]; i1 = i; } }
            int i2 = 0; float m2 = -3.0e38f;
#pragma unroll
            for (int i = 0; i < 8; ++i) if (i != i1 && le[i] > m2) { m2 = le[i]; i2 = i; }
            const float p2 = __expf(m2 - m1), w1 = __builtin_amdgcn_rcpf(1.0f + p2), w2 = p2 * w1;
            const int e1 = gi * 8 + i1, e2 = gi * 8 + i2;
            const int s1 = (int)__hip_atomic_fetch_add(F.ctl + CW_CNT + e1, 1u, RLX_AGENT), s2 = (int)__hip_atomic_fetch_add(F.ctl + CW_CNT + e2, 1u, RLX_AGENT);
            a_e[2 * t] = e1; a_e[2 * t + 1] = e2; a_slot[2 * t] = s1; a_slot[2 * t + 1] = s2; a_w[2 * t] = g_w * w1; a_w[2 * t + 1] = g_w * w2; rstd2[t] = r;
            tlist[(size_t)e1 * 16384 + s1] = t; tlist[(size_t)e2 * 16384 + s2] = t; slot_rs[(size_t)e1 * 16384 + s1] = r; slot_rs[(size_t)e2 * 16384 + s2] = r;
        }
        __syncthreads();
    }
}
__device__ __forceinline__ void moe_tables(Frame& F) {
    LAS int* tab = (LAS int*)(F.lds + MOE_TAB_OFF);
    if (F.wave == 0) { const int lane = F.lane; const int e = lane & 31;
        const int c = (int)__hip_atomic_load(F.ctl + CW_CNT + e, RLX_AGENT); const int nb = (c + 255) >> 8; int incl = nb;
#pragma unroll
        for (int off = 1; off < 32; off <<= 1) { const int n = __shfl_up(incl, off, 32); if (e >= off) incl += n; }
        const int sb = incl - nb;
        if (lane < 32) { tab[e] = sb * 256; tab[194 + e] = c; for (int b = 0; b < nb; ++b) tab[34 + sb + b] = e; if (e == 31) { tab[32] = incl * 256; tab[33] = incl; } }
    }
    __syncthreads();
}
__device__ __forceinline__ void gather_phase(Frame& F) {
    LAS int* tab = (LAS int*)(F.lds + MOE_TAB_OFF);
    const bf16* x1b = (const bf16*)(F.ws + WS_X1B); bf16* xbuf = (bf16*)(F.ws + WS_XBUF);
    const float* rstd2 = (const float*)(F.ws + WS_RSTD2); const int* a_e = (const int*)(F.ws + WS_AE); const int* a_slot = (const int*)(F.ws + WS_ASLOT);
    int* tokrow = (int*)(F.ws + WS_TOKROW); float* rowscale = (float*)(F.ws + WS_ROWSCALE);
    const int gw = F.vcu * NWAVES + F.wave, NGW = F.G * NWAVES, lane = F.lane;
    for (int a = gw; a < 2 * T; a += NGW) {
        const int t = a >> 1, e = a_e[a], row = tab[e] + a_slot[a];
        const GAS v4u* src = (const GAS v4u*)(x1b + (size_t)t * DM) + lane; GAS v4u* dst = (GAS v4u*)(xbuf + (size_t)row * DM) + lane;
#pragma unroll
        for (int j = 0; j < 4; ++j) dst[64 * j] = src[64 * j];
        if (lane == 0) { tokrow[a] = row; rowscale[row] = rstd2[t]; }
    }
    for (int e = gw; e < NEXP; e += NGW) { const int c = tab[34 + 160 + e], r0 = tab[e] + c, r1 = tab[e] + ((c + 255) & ~255);
        for (int row = r0; row < r1; ++row) { GAS v4u* dst = (GAS v4u*)(xbuf + (size_t)row * DM) + lane;
#pragma unroll
            for (int j = 0; j < 4; ++j) dst[64 * j] = (v4u){0u, 0u, 0u, 0u};
            if (lane == 0) rowscale[row] = 0.f; } }
}
__device__ __forceinline__ void final_rows(const bf16* x1b, const unsigned char* ybuf, int t, int r0, int r1, int lane, v4u (&a)[4], v2u (&b)[4], v2u (&c)[4]) {
    const GAS v4u* xs = (const GAS v4u*)(x1b + (size_t)t * DM) + lane; const GAS v2u* y0 = (const GAS v2u*)(ybuf + (size_t)r0 * DM) + lane; const GAS v2u* y1 = (const GAS v2u*)(ybuf + (size_t)r1 * DM) + lane;
#pragma unroll
    for (int j = 0; j < 4; ++j) { a[j] = xs[64 * j]; b[j] = __builtin_nontemporal_load(y0 + 64 * j); c[j] = __builtin_nontemporal_load(y1 + 64 * j); }
}
typedef float f32x2q __attribute__((ext_vector_type(2)));
__device__ __forceinline__ void fp8x4_to_f32(unsigned w, float (&o)[4]) { const f32x2q lo = __builtin_amdgcn_cvt_pk_f32_fp8((int)w, false), hi = __builtin_amdgcn_cvt_pk_f32_fp8((int)w, true); o[0] = lo.x; o[1] = lo.y; o[2] = hi.x; o[3] = hi.y; }
__device__ __forceinline__ void final_token(float* out, const float* gF, int t, float w0, float w1, int lane, const v4u (&a)[4], const v2u (&b)[4], const v2u (&c)[4]) {
    float v[4][8]; float ss = 0.f;
#pragma unroll
    for (int j = 0; j < 4; ++j) {
        float y0[8], y1[8]; fp8x4_to_f32(b[j].x, *(float(*)[4])&y0[0]); fp8x4_to_f32(b[j].y, *(float(*)[4])&y0[4]); fp8x4_to_f32(c[j].x, *(float(*)[4])&y1[0]); fp8x4_to_f32(c[j].y, *(float(*)[4])&y1[4]);
        const float xx[8] = {bflo(a[j].x), bfhi(a[j].x), bflo(a[j].y), bfhi(a[j].y), bflo(a[j].z), bfhi(a[j].z), bflo(a[j].w), bfhi(a[j].w)};
#pragma unroll
        for (int i = 0; i < 8; ++i) { v[j][i] = xx[i] + w0 * y0[i] + w1 * y1[i]; ss += v[j][i] * v[j][i]; } }
    const float rs = __builtin_amdgcn_rsqf(wave_sum(ss) * (1.0f / DM) + EPS);
#pragma unroll
    for (int j = 0; j < 4; ++j) { const int c0 = 512 * j + 8 * lane; const f32x4 ga = *(const f32x4*)(gF + c0), gb = *(const f32x4*)(gF + c0 + 4);
        f32x4 o0 = {v[j][0] * rs * ga.x, v[j][1] * rs * ga.y, v[j][2] * rs * ga.z, v[j][3] * rs * ga.w}, o1 = {v[j][4] * rs * gb.x, v[j][5] * rs * gb.y, v[j][6] * rs * gb.z, v[j][7] * rs * gb.w};
        __builtin_nontemporal_store(o0, (f32x4*)(out + (size_t)t * DM + c0)); __builtin_nontemporal_store(o1, (f32x4*)(out + (size_t)t * DM + c0 + 4)); }
}
__device__ __forceinline__ void final_phase(Frame& F) {
    const bf16* x1b = (const bf16*)(F.ws + WS_X1B); const unsigned char* ybuf = F.ws + WS_YBUF;
    const int* a_e = (const int*)(F.ws + WS_AE); const int* a_slot = (const int*)(F.ws + WS_ASLOT); const LAS int* tab = (const LAS int*)(F.lds + MOE_TAB_OFF); const float* a_w = (const float*)(F.ws + WS_AW); const float* gF = F.in[17];
    const int gw = F.vcu * NWAVES + F.wave, NGW = F.G * NWAVES, lane = F.lane;
#pragma unroll 1
    for (int t = gw; t < T; t += 2 * NGW) {
        const int t2 = t + NGW; const bool has2 = t2 < T; const int tb = has2 ? t2 : t;
        const int ra0 = tab[a_e[2 * t]] + a_slot[2 * t], ra1 = tab[a_e[2 * t + 1]] + a_slot[2 * t + 1], rb0 = tab[a_e[2 * tb]] + a_slot[2 * tb], rb1 = tab[a_e[2 * tb + 1]] + a_slot[2 * tb + 1];
        const float wa0 = a_w[2 * t] * (1.0f / 32.0f), wa1 = a_w[2 * t + 1] * (1.0f / 32.0f), wb0 = a_w[2 * tb] * (1.0f / 32.0f), wb1 = a_w[2 * tb + 1] * (1.0f / 32.0f);
        v4u a[4], a2[4]; v2u b[4], c[4], b2[4], c2[4];
        final_rows(x1b, ybuf, t, ra0, ra1, lane, a, b, c); final_rows(x1b, ybuf, tb, rb0, rb1, lane, a2, b2, c2);
        final_token(F.out, gF, t, wa0, wa1, lane, a, b, c);
        if (has2) final_token(F.out, gF, t2, wb0, wb1, lane, a2, b2, c2);
    }
}
constexpr int HG_VT_STRIDE = 144, HG_QK_STRIDE = 272, HG_OL_STRIDE = 132;
typedef float f32x16 __attribute__((ext_vector_type(16)));
typedef __bf16 bf16m_t;
__device__ __forceinline__ bf16 f2bf_m(float x) { const bf16m_t b = (bf16m_t)x; return __builtin_bit_cast(bf16, b); }
__device__ __forceinline__ int crow32(int r, int hi) { return (r & 3) + 8 * (r >> 2) + 4 * hi; }
__device__ __forceinline__ float ex2(float x) { return __builtin_amdgcn_exp2f(x); }
__device__ __forceinline__ float sig2(float x) { return __builtin_amdgcn_rcpf(1.0f + __builtin_amdgcn_exp2f(-1.4426950408889634f * x)); }
__device__ __forceinline__ void hg_pre(const unsigned (&fw)[8], float lb0, float lb1, LAS float* tot, int wave, int lane, float (&bl)[8][2], float (&kk)[8][2], float (&blast)[2], float (&bmid)[2]) {
    float r0 = 0.f, r1 = 0.f;
#pragma unroll
    for (int i = 0; i < 8; ++i) { const float f0 = lb0 + (1.f - lb0) * sig2(bflo(fw[i])), f1 = lb1 + (1.f - lb1) * sig2(bfhi(fw[i]));
        kk[i][0] = 1.f - f0; kk[i][1] = 1.f - f1; r0 += __builtin_amdgcn_logf(f0); r1 += __builtin_amdgcn_logf(f1); bl[i][0] = r0; bl[i][1] = r1; }
    *(LAS f32x2v*)(tot + wave * 128 + 2 * lane) = (f32x2v){r0, r1};
    __syncthreads();
    float p0 = 0.f, p1 = 0.f, m0 = 0.f, m1 = 0.f, a0 = 0.f, a1 = 0.f;
#pragma unroll
    for (int w = 0; w < 8; ++w) { const f32x2v tv = *(const LAS f32x2v*)(tot + w * 128 + 2 * lane); if (w < wave) { p0 += tv.x; p1 += tv.y; } if (w < 4) { m0 += tv.x; m1 += tv.y; } a0 += tv.x; a1 += tv.y; }
#pragma unroll
    for (int i = 0; i < 8; ++i) { bl[i][0] += p0; bl[i][1] += p1; }
    blast[0] = a0; blast[1] = a1; bmid[0] = m0; bmid[1] = m1;
}
__device__ __forceinline__ v4u pack8col(const float (&x)[8][2], int j) { v4u o; o.x = pk2(x[0][j], x[1][j]); o.y = pk2(x[2][j], x[3][j]); o.z = pk2(x[4][j], x[5][j]); o.w = pk2(x[6][j], x[7][j]); return o; }
__device__ __forceinline__ float lb_of(const float* lbl, int idx) { return sig2(lbl[idx] - lbl[MW + idx]); }

__device__ __forceinline__ void hgrn_a1(Frame& F) {
    const bf16* FB = (const bf16*)(F.ws + WS_HG) + (size_t)T * MW; const bf16* IB = FB + (size_t)T * MW;
    bf16* UT = (bf16*)(F.ws + WS_U); float* dec = (float*)(F.ws + WS_DEC);
    LAS unsigned char* VT = F.lds + RING_OFF; LAS unsigned char* KET = VT + 128 * HG_VT_STRIDE; LAS float* tot = (LAS float*)(KET + 128 * HG_VT_STRIDE);
    const int wave = F.wave, lane = F.lane, c32 = lane & 31, hi = lane >> 5;
    unsigned fwn[8], vwn[8]; f32x2v lbn[2];
#define HG_A1_LOAD(uu) do { const int bh_ = (uu) >> 6, c_ = (uu) & 63; const size_t rb_ = ((size_t)(bh_ >> 3) * SEQ + 64 * c_) * MW + (bh_ & 7) * HD + (size_t)(8 * wave) * MW + 2 * lane; \
        lbn[0] = *(const f32x2v*)(F.in[4] + (bh_ & 7) * HD + 2 * lane); lbn[1] = *(const f32x2v*)(F.in[4] + MW + (bh_ & 7) * HD + 2 * lane); \
        _Pragma("unroll") for (int i = 0; i < 8; ++i) { fwn[i] = *(const unsigned*)(FB + rb_ + (size_t)i * MW); vwn[i] = *(const unsigned*)(IB + rb_ + (size_t)i * MW); } } while (0)
    if (F.vcu < BATCH * NH * 64) HG_A1_LOAD(F.vcu);
    for (int u = F.vcu; u < BATCH * NH * 64; u += F.G) {
        const int bh = u >> 6, c = u & 63, b = bh >> 3, h = bh & 7;
        const float lb0 = sig2(lbn[0].x - lbn[1].x), lb1 = sig2(lbn[0].y - lbn[1].y);
        unsigned vw[8], fw[8];
#pragma unroll
        for (int i = 0; i < 8; ++i) { vw[i] = vwn[i]; fw[i] = fwn[i]; }
        if (u + F.G < BATCH * NH * 64) HG_A1_LOAD(u + F.G);
        float bl[8][2], kk[8][2], blast[2], bmid[2];
        hg_pre(fw, lb0, lb1, tot, wave, lane, bl, kk, blast, bmid);
        float ke[8][2], vv[8][2];
#pragma unroll
        for (int i = 0; i < 8; ++i) { ke[i][0] = kk[i][0] * ex2(blast[0] - bl[i][0]); ke[i][1] = kk[i][1] * ex2(blast[1] - bl[i][1]); vv[i][0] = bflo(vw[i]); vv[i][1] = bfhi(vw[i]); }
#pragma unroll
        for (int j = 0; j < 2; ++j) { *(LAS v4u*)(KET + (2 * lane + j) * HG_VT_STRIDE + 16 * wave) = pack8col(ke, j); *(LAS v4u*)(VT + (2 * lane + j) * HG_VT_STRIDE + 16 * wave) = pack8col(vv, j); }
        if (wave == 0) *(f32x2v*)(dec + (size_t)u * 128 + 2 * lane) = (f32x2v){ex2(blast[0]), ex2(blast[1])};
        __syncthreads();
        const int vt = wave >> 1, kt0 = 2 * (wave & 1);
        bf16x8 a[4];
#pragma unroll
        for (int ks = 0; ks < 4; ++ks) a[ks] = *(const LAS bf16x8*)(VT + (32 * vt + c32) * HG_VT_STRIDE + (16 * ks + 8 * hi) * 2);
        LAS bf16* stg = (LAS bf16*)(F.lds + RING_OFF + 40960 + wave * 4608);
#pragma unroll
        for (int kq = 0; kq < 2; ++kq) { const int kt = kt0 + kq; f32x16 acc = {};
#pragma unroll
            for (int ks = 0; ks < 4; ++ks) { const bf16x8 bq = *(const LAS bf16x8*)(KET + (32 * kt + c32) * HG_VT_STRIDE + (16 * ks + 8 * hi) * 2); acc = __builtin_amdgcn_mfma_f32_32x32x16_bf16(a[ks], bq, acc, 0, 0, 0); }
#pragma unroll
            for (int r = 0; r < 16; ++r) stg[crow32(r, hi) * 72 + 32 * kq + c32] = f2bf_m(acc[r]); }
        LDS_WAIT(); asm volatile("" ::: "memory");
        { bf16* dst = UT + (size_t)u * 16384 + (size_t)(32 * vt) * 128 + 64 * (wave & 1); const int row = lane >> 3, ch = lane & 7;
#pragma unroll
          for (int q = 0; q < 4; ++q) { const v4u o = *(const LAS v4u*)((LAS unsigned char*)stg + (8 * q + row) * 144 + 16 * ch); *(v4u*)(dst + (size_t)(8 * q + row) * 128 + 8 * ch) = o; } }
        __syncthreads();
    }
}
__device__ __forceinline__ void hgrn_scan(Frame& F) {
    const bf16* UT = (const bf16*)(F.ws + WS_U); bf16* ST = (bf16*)(F.ws + WS_S); const float* dec = (const float*)(F.ws + WS_DEC);
    for (int g = F.vcu * NWAVES * 64 + F.tid; g < BATCH * NH * 4096; g += F.G * NWAVES * 64) {
        const int bh = g >> 12, e = g & 4095, k0 = (e * 4) & 127;
        const bf16* up = UT + (size_t)bh * 64 * 16384 + e * 4; bf16* sp = ST + (size_t)bh * 64 * 16384 + e * 4; const float* dp = dec + (size_t)bh * 64 * 128 + k0;
        float s0 = 0.f, s1 = 0.f, s2 = 0.f, s3 = 0.f;
#pragma unroll 1
        for (int c0 = 0; c0 < 64; c0 += 16) {
            v2u uw[16]; f32x4 d[16];
#pragma unroll
            for (int j = 0; j < 16; ++j) { uw[j] = *(const v2u*)(up + (size_t)(c0 + j) * 16384); d[j] = *(const f32x4*)(dp + (c0 + j) * 128); }
            __builtin_amdgcn_sched_barrier(0);
#pragma unroll
            for (int j = 0; j < 16; ++j) {
                v2u sw; sw.x = pk2(s0, s1); sw.y = pk2(s2, s3); *(v2u*)(sp + (size_t)(c0 + j) * 16384) = sw;
                s0 = d[j].x * s0 + bflo(uw[j].x); s1 = d[j].y * s1 + bfhi(uw[j].x); s2 = d[j].z * s2 + bflo(uw[j].y); s3 = d[j].w * s3 + bfhi(uw[j].y); }
        }
    }
}
__device__ __forceinline__ void hgrn_scan_item(Frame& F, int it, unsigned* cnt) {
    const bf16* UT = (const bf16*)(F.ws + WS_U); const float* dec = (const float*)(F.ws + WS_DEC);
    const __amdgpu_buffer_rsrc_t rsS = __builtin_amdgcn_make_buffer_rsrc((void*)(F.ws + WS_S), 0, 64 * 1024 * 1024, 0x00020000);
    int tid = F.tid; asm volatile("" : "+v"(tid));
    const int g = it * (NWAVES * 64) + tid, bh = g >> 12, e = g & 4095, k0 = (e * 4) & 127;
    const bf16* up = UT + (size_t)bh * 64 * 16384 + e * 4; const float* dp = dec + (size_t)bh * 64 * 128 + k0; const int sbyte = (bh * 64 * 16384 + e * 4) * 2;
    float s0 = 0.f, s1 = 0.f, s2 = 0.f, s3 = 0.f;
#pragma unroll 1
    for (int c0 = 0; c0 < 64; c0 += 16) {
        v2u uw[16]; f32x4 d[16];
#pragma unroll
        for (int j = 0; j < 16; ++j) { uw[j] = *(const v2u*)(up + (size_t)(c0 + j) * 16384); d[j] = *(const f32x4*)(dp + (c0 + j) * 128); }
        __builtin_amdgcn_sched_barrier(0);
#pragma unroll
        for (int j = 0; j < 16; ++j) {
            v2u sw; sw.x = pk2(s0, s1); sw.y = pk2(s2, s3); __builtin_amdgcn_raw_buffer_store_b64(sw, rsS, sbyte + (c0 + j) * 32768, 0, 16);
            s0 = d[j].x * s0 + bflo(uw[j].x); s1 = d[j].y * s1 + bfhi(uw[j].x); s2 = d[j].z * s2 + bflo(uw[j].y); s3 = d[j].w * s3 + bfhi(uw[j].y); }
    }
    asm volatile("s_waitcnt vmcnt(0)" ::: "memory");
    if ((tid & 63) == 0) __hip_atomic_fetch_add(cnt + 64 * bh, 1u, __ATOMIC_RELAXED, __HIP_MEMORY_SCOPE_AGENT);
}
__device__ __forceinline__ void hgrn_a2(Frame& F, int u0, int ustep, int uend) {
    const bf16* QB = (const bf16*)(F.ws + WS_HG); const bf16* FB = QB + (size_t)T * MW; const bf16* IB = FB + (size_t)T * MW; const bf16* GB = IB + (size_t)T * MW;
    const bf16* ST = (const bf16*)(F.ws + WS_S); OAB_t* obn = (OAB_t*)(F.ws + WS_OAB) + MW;
    LAS unsigned char* QE = F.lds + RING_OFF; LAS unsigned char* KD = QE + 64 * HG_QK_STRIDE; LAS unsigned char* QBL = KD + 64 * HG_QK_STRIDE; LAS unsigned char* VT = QBL + 64 * HG_QK_STRIDE;
    LAS unsigned char* AL = VT + 128 * HG_VT_STRIDE; LAS float* OL = (LAS float*)(AL + 64 * HG_VT_STRIDE); LAS float* tot = OL + 64 * HG_OL_STRIDE;
    const int wave = F.wave;
#pragma unroll 1
    for (int u = u0; u < uend; u += ustep) {
        int tid_ = F.tid; asm volatile("" : "+v"(tid_)); const int lane = tid_ & 63, c32 = lane & 31, hi = lane >> 5;
        const int bh = u >> 6, c = u & 63, b = bh >> 3, h = bh & 7; const size_t rowbase = ((size_t)b * SEQ + 64 * c) * MW + h * HD;
        const float lb0 = lb_of(F.in[4], h * HD + 2 * lane), lb1 = lb_of(F.in[4], h * HD + 2 * lane + 1);
        const int tt = wave >> 2, vt = wave & 3;
        bf16x8 st[8];
#pragma unroll
        for (int ks = 0; ks < 8; ++ks) st[ks] = *(const bf16x8*)(ST + (size_t)u * 16384 + (size_t)(32 * vt + c32) * 128 + 16 * ks + 8 * hi);
        unsigned qw[8], vw[8], gw[8], fw[8];
#pragma unroll
        for (int i = 0; i < 8; ++i) { const size_t o = rowbase + (size_t)(8 * wave + i) * MW + 2 * lane; fw[i] = *(const unsigned*)(FB + o); qw[i] = *(const unsigned*)(QB + o); vw[i] = *(const unsigned*)(IB + o); gw[i] = *(const unsigned*)(GB + o); }
        float bl[8][2], kk[8][2], blast[2], bmid[2];
        hg_pre(fw, lb0, lb1, tot, wave, lane, bl, kk, blast, bmid);
        { float vv[8][2];
#pragma unroll
          for (int i = 0; i < 8; ++i) { const int t = 8 * wave + i; const float q0 = bflo(qw[i]), q1 = bfhi(qw[i]);
              *(LAS unsigned*)(QE + t * HG_QK_STRIDE + 4 * lane) = pk2(q0 * ex2(bl[i][0] - bmid[0]), q1 * ex2(bl[i][1] - bmid[1]));
              *(LAS unsigned*)(KD + t * HG_QK_STRIDE + 4 * lane) = pk2(kk[i][0] * ex2(bmid[0] - bl[i][0]), kk[i][1] * ex2(bmid[1] - bl[i][1]));
              *(LAS unsigned*)(QBL + t * HG_QK_STRIDE + 4 * lane) = pk2(q0 * ex2(bl[i][0]), q1 * ex2(bl[i][1]));
              vv[i][0] = bflo(vw[i]); vv[i][1] = bfhi(vw[i]); }
#pragma unroll
          for (int j = 0; j < 2; ++j) *(LAS v4u*)(VT + (2 * lane + j) * HG_VT_STRIDE + 16 * wave) = pack8col(vv, j); }
        __syncthreads();
        if (wave < 3) { const int ta = wave >= 1, sa = wave == 2; f32x16 acc = {};
#pragma unroll
            for (int ks = 0; ks < 8; ++ks) { const bf16x8 a = *(const LAS bf16x8*)(QE + (32 * ta + c32) * HG_QK_STRIDE + (16 * ks + 8 * hi) * 2), bq = *(const LAS bf16x8*)(KD + (32 * sa + c32) * HG_QK_STRIDE + (16 * ks + 8 * hi) * 2);
                acc = __builtin_amdgcn_mfma_f32_32x32x16_bf16(a, bq, acc, 0, 0, 0); }
#pragma unroll
            for (int r = 0; r < 16; ++r) { const int tl = crow32(r, hi); float v = acc[r]; if (ta == sa && c32 > tl) v = 0.f;
                *(LAS bf16*)(AL + (32 * ta + tl) * HG_VT_STRIDE + (32 * sa + c32) * 2) = f2bf_m(v); }
        } else if (wave == 3) { const int row = lane >> 1, half = lane & 1; LAS v4u* p = (LAS v4u*)(AL + row * HG_VT_STRIDE + 64 + half * 32); p[0] = (v4u){0u, 0u, 0u, 0u}; p[1] = (v4u){0u, 0u, 0u, 0u}; }
        __syncthreads();
        { f32x16 acc = {};
#pragma unroll
          for (int ks = 0; ks < 4; ++ks) { const bf16x8 a = *(const LAS bf16x8*)(AL + (32 * tt + c32) * HG_VT_STRIDE + (16 * ks + 8 * hi) * 2), bq = *(const LAS bf16x8*)(VT + (32 * vt + c32) * HG_VT_STRIDE + (16 * ks + 8 * hi) * 2);
              acc = __builtin_amdgcn_mfma_f32_32x32x16_bf16(a, bq, acc, 0, 0, 0); }
#pragma unroll
          for (int ks = 0; ks < 8; ++ks) { const bf16x8 a = *(const LAS bf16x8*)(QBL + (32 * tt + c32) * HG_QK_STRIDE + (16 * ks + 8 * hi) * 2); acc = __builtin_amdgcn_mfma_f32_32x32x16_bf16(a, st[ks], acc, 0, 0, 0); }
#pragma unroll
          for (int r = 0; r < 16; ++r) OL[(32 * tt + crow32(r, hi)) * HG_OL_STRIDE + 32 * vt + c32] = acc[r]; }
        __syncthreads();
        f32x2v o2a[8]; float ssq[8];
#pragma unroll
        for (int i = 0; i < 8; ++i) { o2a[i] = *(const LAS f32x2v*)(OL + (8 * wave + i) * HG_OL_STRIDE + 2 * lane); ssq[i] = o2a[i].x * o2a[i].x + o2a[i].y * o2a[i].y; }
#pragma unroll
        for (int i = 0; i < 8; ++i) { ssq[i] += dpp_f<0xB1>(ssq[i]); ssq[i] += dpp_f<0x4E>(ssq[i]); ssq[i] += dpp_f<0x141>(ssq[i]); ssq[i] += dpp_f<0x140>(ssq[i]); }
#pragma unroll
        for (int i = 0; i < 8; ++i) ssq[i] += __shfl_xor(ssq[i], 16);
#pragma unroll
        for (int i = 0; i < 8; ++i) ssq[i] += __shfl_xor(ssq[i], 32);
#pragma unroll
        for (int i = 0; i < 8; ++i) { const int t = 8 * wave + i; const f32x2v o2 = o2a[i];
            const float rs = __builtin_amdgcn_rsqf(ssq[i] * (1.0f / HD) + EPS); const float g0 = bflo(gw[i]), g1 = bfhi(gw[i]);
            const float y0 = o2.x * rs * g0 * sig2(g0), y1 = o2.y * rs * g1 * sig2(g1);
#if P5_F8
            { const float z0 = 16.f * y0, z1 = 16.f * y1, n0 = dpp_f<0xB1>(z0), n1 = dpp_f<0xB1>(z1);
              if ((lane & 1) == 0) *(unsigned*)(obn + ((size_t)b * SEQ + 64 * c + t) * (2 * MW) + h * HD + 2 * lane) = pg8::pk4_fp8(z0, z1, n0, n1); }
#else
            *(unsigned*)(obn + ((size_t)b * SEQ + 64 * c + t) * (2 * MW) + h * HD + 2 * lane) = pk2(y0, y1);
#endif
            }
    }
}
__device__ __forceinline__ void attn_phase_fast(Frame& F, char* lds) {
    fox::bf16* O = (fox::bf16*)(F.ws + WS_OAB);
    const float* logf = (const float*)(F.ws + WS_LOGF);
    float* cumL = (float*)(lds + fox::LDS_CUM); float* kbL = (float*)(lds + fox::LDS_KB); float* wsum = (float*)(lds + 2 * fox::SHM_V + 2 * fox::SHM_K);
    const int wave = F.wave;
    fox::Seam<fox::bf16> S;
    const fox::rsrc_t rs = __builtin_amdgcn_make_buffer_rsrc((void*)(F.ws + WS_QKV), 0, (int)(3u * (unsigned)T * MW * 2u), 0x00020000);
    for (int L = F.vcu; L < BATCH * NH * 8; L += F.G) {
        const int bh = L >> 3, y = L & 7, b = bh >> 3, h = bh & 7;
        {
            int tid = F.tid; asm volatile("" : "+v"(tid)); const int lane = tid & 63;
            const float* src = logf + (size_t)bh * SEQ + tid * 8; const f32x4 a = *(const f32x4*)src, c = *(const f32x4*)(src + 4);
            float v[8] = {a.x, a.y, a.z, a.w, c.x, c.y, c.z, c.w};
#pragma unroll
            for (int i = 1; i < 8; ++i) v[i] += v[i - 1];
            const float tot = v[7]; float inc = tot;
#pragma unroll
            for (int off = 1; off < 64; off <<= 1) { const float n = __shfl_up(inc, off); if (lane >= off) inc += n; }
            if (lane == 63) wsum[wave] = inc;
            __syncthreads();
            float pre = 0.f; for (int w = 0; w < wave; ++w) pre += wsum[w];
            const float excl = inc - tot + pre;
#pragma unroll
            for (int i = 0; i < 8; ++i) cumL[tid * 8 + i] = v[i] + excl;
            __syncthreads();
        }
        const unsigned TB = (unsigned)T * MW * 2u, hb = (unsigned)bh * SEQ * HD * 2u;
        int jlo0, jlo1;
        {   const float* nq = (const float*)(F.ctl + CW_NRM) + (size_t)bh * 4; const float* nk = nq + 32 * 4;
            const float q2 = (nq[0] + nq[1]) + (nq[2] + nq[3]), k2 = (nk[0] + nk[1]) + (nk[2] + nk[3]);
            const float thrsk = 30.0f + 2.0f * 1.02f * fox::SCALE * sqrtf(q2) * sqrtf(k2);
            int tid = F.tid; asm volatile("" : "+v"(tid)); const int lane = tid & 63;
            const int P0 = y * 256, P1 = (15 - y) * 256; const float c0 = cumL[P0], c1 = cumL[P1]; int n0 = 0, n1 = 0;
#pragma unroll
            for (int i = 0; i < 8; ++i) { const int j = tid * 8 + i; const float cj = cumL[j]; n0 += (j < P0 && cj - c0 >= thrsk) ? 1 : 0; n1 += (j < P1 && cj - c1 >= thrsk) ? 1 : 0; }
#pragma unroll
            for (int o = 1; o < 64; o <<= 1) { n0 += __shfl_xor(n0, o); n1 += __shfl_xor(n1, o); }
            int* wcnt = (int*)wsum + 8;
            if (lane == 0) { wcnt[2 * wave] = n0; wcnt[2 * wave + 1] = n1; }
            __syncthreads();
            int t0 = 0, t1 = 0;
#pragma unroll
            for (int w = 0; w < 8; ++w) { t0 += wcnt[2 * w]; t1 += wcnt[2 * w + 1]; }
            jlo0 = __builtin_amdgcn_readfirstlane(t0) >> 6; jlo1 = __builtin_amdgcn_readfirstlane(t1) >> 6;
        }
        fox::BlockRef<fox::bf16, fox::bf16> cur, nxt;
        { const int P0 = y * 256; cur.Q = hb + (unsigned)P0 * 256u; cur.K = TB + hb; cur.V = 2u * TB + hb; cur.O = O + ((size_t)(b * SEQ + P0)) * (2 * MW) + h * HD; cur.P0 = P0; cur.jlo = jlo0; }
        { const int P1 = (15 - y) * 256; nxt.Q = hb + (unsigned)P1 * 256u; nxt.K = TB + hb; nxt.V = 2u * TB + hb; nxt.O = O + ((size_t)(b * SEQ + P1)) * (2 * MW) + h * HD; nxt.P0 = P1; nxt.jlo = jlo1; }
        fox::causal_swa_prime<fox::bf16, fox::bf16>(rs, cur, SEQ, lds, S);
#pragma unroll 1
        for (int pass = 0; pass < 2; ++pass) {
            {
                int tid = F.tid; asm volatile("" : "+v"(tid));
                const float cref = cumL[cur.P0]; const int j0 = tid * 8;
                if (j0 < cur.P0 + 256) {
#pragma unroll
                    for (int i = 0; i < 8; ++i) kbL[j0 + i] = (cref - cumL[j0 + i]) * (1.0f / fox::SCALE);
                }
                __syncthreads();
            }
            fox::causal_swa_block<fox::bf16, fox::bf16>(rs, cur, nxt, SEQ, SEQ, lds, S);
            cur = nxt;
        }
    }
}

constexpr int QSLOT_OFF = MISC_OFF + 64;
__device__ __forceinline__ void mixer_queue_phase(Frame& F, char* lds) {
    constexpr int NATT = BATCH * NH * 16, NCONV = (I_W13 + I_W2) / NWAVES, NMIX = NATT + NCONV, NA2 = BATCH * NH * 32, NSCAN = BATCH * NH * 8, NQ = NMIX + NA2 + NSCAN + 256;
    static_assert(NCONV * 2 == NATT * 3 && NA2 == 2 * NATT && NATT == 2 * NSCAN, "the item interleave");
    gu32* qctr = F.ctl + CW_QUEUE; volatile LAS int* qslot = (volatile LAS int*)(F.lds + QSLOT_OFF);
    OAB_t* O = (OAB_t*)(F.ws + WS_OAB);
    const float* logf = (const float*)(F.ws + WS_LOGF);
    float* cumL = (float*)(lds + fox::LDS_CUM); float* kbL = (float*)(lds + fox::LDS_KB); float* wsum = (float*)(lds + 2 * fox::SHM_V + 2 * fox::SHM_K);
    const int wave = F.wave;
    fox::Seam<fox::bf16> S;
    const fox::rsrc_t rs = __builtin_amdgcn_make_buffer_rsrc((void*)(F.ws + WS_QKV), 0, (int)(3u * (unsigned)T * MW * 2u), 0x00020000);
    int cached_bh = -1; unsigned scan_mask = 0u; bool conv_done = false;
    unsigned mine = 0u;
    if (F.tid == 0) mine = __hip_atomic_fetch_add(qctr, 1u, RLX_AGENT);
#pragma unroll 1
    for (;;) {
        { int tid = F.tid; asm volatile("" : "+v"(tid)); if (tid == 0) qslot[0] = (int)mine; }
        __syncthreads();
        const int idx = __builtin_amdgcn_readfirstlane(qslot[0]);
        __syncthreads();
        if (idx >= NQ) break;
        { int tid = F.tid; asm volatile("" : "+v"(tid)); if (tid == 0) mine = __hip_atomic_fetch_add(qctr, 1u, RLX_AGENT); }
        int kind, sub, a2u0 = 0, a2u1 = 0;
        if (idx < 4 * NSCAN) { const int per = idx >> 2, sl = idx & 3; kind = sl == 0 ? 3 : (sl == 2 ? 1 : 0); sub = sl == 0 ? per : (sl == 1 ? 2 * per : 2 * per + 1); }
        else if (idx < 4 * NSCAN + 1152) { const int r = idx - 4 * NSCAN, per = r / 3, sl = r - 3 * per; kind = sl == 0 ? 1 : 2; sub = 2 * per + (sl - 1); a2u0 = 2 * sub; a2u1 = a2u0 + 2; }
        else { const int r = idx - (4 * NSCAN + 1152), per = r / 5, sl = r - 5 * per; kind = sl == 0 ? 1 : 2; a2u0 = 1536 + 4 * per + (sl - 1); a2u1 = a2u0 + 1; sub = a2u0 >> 1; }
        if (kind == 3) { hgrn_scan_item(F, sub, (unsigned*)(F.ctl + CW_SCAN)); continue; }
        if (kind == 2) {
            const int bh2 = sub >> 5;
            if (!((scan_mask >> bh2) & 1u)) {
                int tid = F.tid; asm volatile("" : "+v"(tid));
                if (tid < 64) { unsigned polls = 0, m;
                    for (;;) { const unsigned v = (tid < 32) ? __hip_atomic_load(F.ctl + CW_SCAN + 64 * tid, RLX_AGENT) : 0u; m = (unsigned)__ballot(tid < 32 && v >= 64u);
                        if (((m >> bh2) & 1u) || ++polls > (1u << 18)) break; __builtin_amdgcn_s_sleep(8); }
                    __builtin_amdgcn_fence(__ATOMIC_ACQUIRE, "agent");
                    asm volatile("s_waitcnt vmcnt(0)" ::: "memory");
                    if (tid == 0) qslot[2] = (int)m; }
                __syncthreads(); scan_mask |= (unsigned)__builtin_amdgcn_readfirstlane(qslot[2]) | (1u << bh2); __syncthreads();
            }
            hgrn_a2(F, a2u0, 1, a2u1); cached_bh = -1; continue; }
        if (kind == 1) {
            if (conv_done) continue;
            int tid = F.tid; asm volatile("" : "+v"(tid));
            if (tid == 0) qslot[1] = (int)__hip_atomic_fetch_add(F.ctl + CW_CONVQ, 1u, RLX_AGENT);
            __syncthreads(); const int ci = __builtin_amdgcn_readfirstlane(qslot[1]); __syncthreads();
            conv_done = ci >= NCONV;
            if (ci < NCONV) cvt8_moe_item(F.in, F.ws, ci * NWAVES + wave, (LAS unsigned*)(F.lds + RING_OFF) + wave * (64 * 33), (LAS float*)(F.lds + PARK_OFF) + wave * 128, tid & 63);
            continue; }
        const int ai = sub;
        const int bh = ai & 31, qb = 15 - (ai >> 5), b = bh >> 3, h = bh & 7, P0 = qb * 256;
        if (bh != cached_bh) {
            cached_bh = bh;
            int tid = F.tid; asm volatile("" : "+v"(tid)); const int lane = tid & 63;
            const float* src = logf + (size_t)bh * SEQ + tid * 8; const f32x4 a = *(const f32x4*)src, c = *(const f32x4*)(src + 4);
            float v[8] = {a.x, a.y, a.z, a.w, c.x, c.y, c.z, c.w};
#pragma unroll
            for (int i = 1; i < 8; ++i) v[i] += v[i - 1];
            const float tot = v[7]; float inc = tot;
#pragma unroll
            for (int off = 1; off < 64; off <<= 1) { const float n = __shfl_up(inc, off); if (lane >= off) inc += n; }
            if (lane == 63) wsum[wave] = inc;
            __syncthreads();
            float pre = 0.f; for (int w = 0; w < wave; ++w) pre += wsum[w];
            const float excl = inc - tot + pre;
#pragma unroll
            for (int i = 0; i < 8; ++i) cumL[tid * 8 + i] = v[i] + excl;
            __syncthreads();
        }
        const unsigned TB = (unsigned)T * MW * 2u, hb = (unsigned)bh * SEQ * HD * 2u;
        int jlo0;
        {
            const float* nk = (const float*)(F.ctl + CW_NRM) + (size_t)(32 + bh) * 4; const float k2 = (nk[0] + nk[1]) + (nk[2] + nk[3]);
            int tid = F.tid; asm volatile("" : "+v"(tid)); const int lane = tid & 63;
            const float c0 = cumL[P0];
            float amax;
            {   const int row = tid >> 1, half = tid & 1;
                const v4u* qp = (const v4u*)(F.ws + WS_QKV + hb + (size_t)(P0 + row) * 256 + half * 128); const v4u* kp = (const v4u*)((const unsigned char*)qp + TB);
                float qq = 0.f, qk = 0.f;
#pragma unroll
                for (int i = 0; i < 8; ++i) { const v4u a = qp[i], k = kp[i];
                    qq += (bflo(a.x) * bflo(a.x) + bfhi(a.x) * bfhi(a.x)) + (bflo(a.y) * bflo(a.y) + bfhi(a.y) * bfhi(a.y)) + (bflo(a.z) * bflo(a.z) + bfhi(a.z) * bfhi(a.z)) + (bflo(a.w) * bflo(a.w) + bfhi(a.w) * bfhi(a.w));
                    qk += (bflo(a.x) * bflo(k.x) + bfhi(a.x) * bfhi(k.x)) + (bflo(a.y) * bflo(k.y) + bfhi(a.y) * bfhi(k.y)) + (bflo(a.z) * bflo(k.z) + bfhi(a.z) * bfhi(k.z)) + (bflo(a.w) * bflo(k.w) + bfhi(a.w) * bfhi(k.w)); }
                qq += dpp_f<0xB1>(qq); qk += dpp_f<0xB1>(qk);
                float a = 1.02f * fox::SCALE * __builtin_amdgcn_sqrtf(qq) * __builtin_amdgcn_sqrtf(k2) - fox::SCALE * qk + (cumL[P0 + row] - c0);
                a = wave_fmax(a);
                if (lane == 0) wsum[16 + wave] = a;
                __syncthreads();
                amax = wsum[16];
#pragma unroll
                for (int w = 1; w < 8; ++w) amax = fmaxf(amax, wsum[16 + w]);
            }
            const float thrsk = SKIP_T0 + amax;
            int n0 = 0;
#pragma unroll
            for (int i = 0; i < 8; ++i) { const int j = tid * 8 + i; n0 += (j < P0 && cumL[j] - c0 >= thrsk) ? 1 : 0; }
            n0 = wave_isum(n0);
            int* wcnt = (int*)wsum + 8;
            if (lane == 0) wcnt[wave] = n0;
            __syncthreads();
            int t0 = 0;
#pragma unroll
            for (int w = 0; w < 8; ++w) t0 += wcnt[w];
            jlo0 = __builtin_amdgcn_readfirstlane(t0) >> 6;
        }
        fox::BlockRef<fox::bf16, OAB_t> cur;
        cur.Q = hb + (unsigned)P0 * 256u; cur.K = TB + hb; cur.V = 2u * TB + hb; cur.O = O + ((size_t)(b * SEQ + P0)) * (2 * MW) + h * HD; cur.P0 = P0; cur.jlo = jlo0;
        fox::causal_swa_prime<fox::bf16, OAB_t>(rs, cur, SEQ, lds, S);
        {
            int tid = F.tid; asm volatile("" : "+v"(tid));
            const float cref = cumL[P0]; const int j0 = tid * 8;
            if (j0 < P0 + 256) {
#pragma unroll
                for (int i = 0; i < 8; ++i) kbL[j0 + i] = (cref - cumL[j0 + i]) * (1.0f / fox::SCALE);
            }
            __syncthreads();
        }
        fox::causal_swa_block<fox::bf16, OAB_t>(rs, cur, cur, SEQ, SEQ, lds, S);
    }
}

__device__ __forceinline__ void p1_converter(Frame& F) {
    constexpr int NCONV = (I_W13 + I_W2) / NWAVES; volatile LAS int* qslot = (volatile LAS int*)(F.lds + MISC_OFF + 64);
#pragma unroll 1
    for (;;) {
        int tid = F.tid; asm volatile("" : "+v"(tid));
        if (tid == 0) { const unsigned stop = __hip_atomic_load(F.ctl + CW_P1STOP, RLX_AGENT); qslot[1] = stop ? NCONV : (int)__hip_atomic_fetch_add(F.ctl + CW_CONVQ, 1u, RLX_AGENT); }
        __syncthreads(); const int ci = __builtin_amdgcn_readfirstlane(qslot[1]); __syncthreads();
        if (ci >= NCONV) break;
        cvt8_moe_item(F.in, F.ws, ci * NWAVES + F.wave, (LAS unsigned*)(F.lds + RING_OFF) + F.wave * (64 * 33), (LAS float*)(F.lds + PARK_OFF) + F.wave * 128, tid & 63);
    }
}

#ifndef MK_N_LAUNCHES
#define MK_N_LAUNCHES 1
#endif
constexpr int PER_PHASE = 12;
constexpr int N_LAUNCHES = MK_N_LAUNCHES;
static_assert(N_LAUNCHES == 1 || N_LAUNCHES == PER_PHASE, "MK_N_LAUNCHES is 1 or 12");
__device__ __forceinline__ bool fresh(Frame& F) { int t_ = threadIdx.x; asm volatile("" : "+v"(t_)); F.tid = t_; F.lane = t_ & 63; return true; }
struct Args { const float* in[18]; float* out; unsigned char* ws; int ph_lo, ph_hi, li, pad; };
__global__ void __launch_bounds__(NWAVES * 64, 2) fwd_kernel(Args args) {
    extern __shared__ __attribute__((aligned(16))) unsigned char lds[];
    Frame F;
    F.lds = (LAS unsigned char*)lds;
    F.MISC = (volatile LAS unsigned*)(F.lds + MISC_OFF);
    F.tid = threadIdx.x; F.lane = F.tid & 63; F.wave = __builtin_amdgcn_readfirstlane(F.tid >> 6);
    F.G = gridDim.x; { const int bx = blockIdx.x; F.vcu = (F.G % 8 == 0) ? (bx % 8) * (F.G / 8) + bx / 8 : bx; }
    F.ws = args.ws; F.ctl = (gu32*)(args.ws + WS_CTL); F.out = args.out;
    F.in = args.in;
    for (int u = F.tid; u < (LDS_BYTES - LDSCTL_OFF) / 4; u += NWAVES * 64) ((LAS unsigned*)(F.lds + LDSCTL_OFF))[u] = 0u;
    __syncthreads();
    XcdBarrier bar; bar.bar = (unsigned*)(F.ctl + CW_BAR); bar.x = 0; bar.st = nullptr;
    if (N_LAUNCHES != PER_PHASE) bar = xcd_barrier_post((unsigned*)(F.ctl + CW_BAR), F.MISC + 8);
#define GRID_BAR() do { if (N_LAUNCHES != PER_PHASE) xcd_barrier(bar); } while (0)
    const int lo = args.ph_lo, hi = args.ph_hi;
#ifndef PHASE_MASK
#define PHASE_MASK 0xfff
#endif
#define IN(k) (((PHASE_MASK >> (k)) & 1) && lo <= (k) && (k) < hi && fresh(F))
#ifndef DUP_MASK
#define DUP_MASK 0
#endif
#define REP(k) for (int rep_ = 0; rep_ < (((DUP_MASK >> (k)) & 1) ? 2 : 1); ++rep_)
    unsigned char* ws = args.ws;
    bf16* const HG = (bf16*)(ws + WS_HG); bf16* const GT = (bf16*)(ws + WS_GT);

    if (IN(0)) REP(0) { p0_prologue(F); GRID_BAR(); }
    if (IN(1)) REP(1) {
        const int GC = (F.G >= 128 && F.G % 8 == 0) ? P1_CONV_WGS : 0, Gg = F.G - GC;
        if ((int)blockIdx.x < Gg) {
            { pg8::Gemm g{(const bf16*)(ws + WS_XB), (const bf16*)(ws + WS_WIN), T, NPROJ16, DM, ws}; pg8::StaticOrder S; S.init(T, NPROJ16, Gg, (int)blockIdx.x);
              pg8::EpiProj E{(bf16*)(ws + WS_QKV), HG, GT, (const float*)(ws + WS_RSTD1), (unsigned*)(F.ctl + CW_NRM)};
              pg8::gemm_phase<pg8::EpiProj, pg8::StaticOrder, true, true>(F.lds + RING_OFF, g, S, E); }
            { pg8::Gemm g{(const bf16*)(ws + WS_X8), (const bf16*)(ws + WS_WIN8), T, NPROJ8, DM / 2, ws}; pg8::StaticOrderSig S; S.init_sig(T, NPROJ8, Gg, (int)blockIdx.x, (unsigned*)(F.ctl + CW_P1STOP));
              pg8::EpiProjG8 E{GT, (const float*)(ws + WS_RSTD1), (bf16*)(ws + WS_QKV), HG};
              pg8::gemm_phase<pg8::EpiProjG8, pg8::StaticOrderSig, true, true, false, true>(F.lds + RING_OFF, g, S, E); }
        } else p1_converter(F);
        GRID_BAR();
    }
    if (IN(2)) REP(2) { hgrn_a1(F); GRID_BAR(); }
    if (IN(4)) { mixer_queue_phase(F, (char*)lds); GRID_BAR(); }
    if (IN(5)) REP(5) {
        pg8::Gemm g{(const bf16*)(ws + WS_OAB), (const bf16*)(ws + WS_PAB), T, DM, P5_F8 ? DM / 2 : DM, ws}; pg8::StaticOrder S; S.init(T, DM, F.G, (int)blockIdx.x);
        typedef pg8::EpiGate2T<P5_F8 != 0, P6_F8 != 0> EG; EG E{(bf16*)(ws + WS_MRG), GT, GT + (size_t)T * DM};
        pg8::gemm_phase<EG, pg8::StaticOrder, true, true, false, P5_F8 != 0>(F.lds + RING_OFF, g, S, E);
        GRID_BAR();
    }
    if (IN(6)) REP(6) {
        pg8::Gemm g{(const bf16*)(ws + WS_MRG), (const bf16*)(ws + WS_WOUT), T, DM, P6_F8 ? DM / 2 : DM, ws}; pg8::StaticOrder S; S.init(T, DM, F.G, (int)blockIdx.x);
        typedef pg8::EpiResid8T<P6_F8 != 0> ER; ER E{(bf16*)(ws + WS_X1B), (const bf16*)(ws + WS_XB), ws + WS_X1F8};
        pg8::gemm_phase<ER, pg8::StaticOrder, true, true, false, P6_F8 != 0>(F.lds + RING_OFF, g, S, E);
        GRID_BAR();
    }
    if (IN(7)) { router_phase(F); GRID_BAR(); }
#ifdef MOE_XBUF
    if (IN(8)) REP(8) { moe_tables(F); gather_phase(F); GRID_BAR(); }
#endif
    if (IN(9)) REP(9) {
        moe_tables(F);
        const LAS int* tab = (const LAS int*)(F.lds + MOE_TAB_OFF);
#ifdef MOE_XBUF
        pg8::Gemm g{(const bf16*)(ws + WS_XBUF), (const bf16*)(ws + WS_W13), MAXROWS, 2048, DM, ws};
        pg8::MoeOrder S{tab[33], F.G, (int)blockIdx.x, 8, tab + 34};
        pg8::EpiMoe1 E{(bf16*)(ws + WS_HBUF), (const float*)(ws + WS_ROWSCALE)};
        pg8::gemm_phase<pg8::EpiMoe1, pg8::MoeOrder, true, true>(F.lds + RING_OFF, g, S, E);
#else
        pg8::Gemm g{(const bf16*)(ws + WS_X1F8), (const bf16*)(ws + WS_W13), T, 2048, DM / 2, ws};
        pg8::MoeGatherOrder S{tab[33], F.G, (int)blockIdx.x, 8, tab, (const int*)(ws + WS_TLIST), (LAS unsigned*)(F.lds + PARK_OFF), (unsigned*)(F.ctl + CW_HB), -1};
        pg8::EpiMoe1G8 E{ws + WS_HBUF, (const float*)(ws + WS_SLOTRS), tab};
        pg8::gemm_phase<pg8::EpiMoe1G8, pg8::MoeGatherOrder, true, true, true, true>(F.lds + RING_OFF, g, S, E);
        S.flush();
#endif
    }
    if (IN(10)) REP(10) {
        if (N_LAUNCHES == PER_PHASE) moe_tables(F);
        const LAS int* tab = (const LAS int*)(F.lds + MOE_TAB_OFF);
        pg8::Gemm g{(const bf16*)(ws + WS_HBUF), (const bf16*)(ws + WS_W2), MAXROWS, 2048, DFF / 2, ws};
        const int n1 = tab[33] * 8, cb = (int)blockIdx.x, i0 = cb < n1 ? (n1 - cb + F.G - 1) / F.G : 0;
        pg8::MoeCountedOrder S{tab[33], F.G, cb, i0, n1, 8, tab + 34, (const unsigned*)(F.ctl + CW_HB), (volatile LAS int*)(F.lds + QSLOT_OFF) + 3, 0u};
        pg8::EpiPlainS8 E{ws + WS_YBUF, DM, 32.0f / 2048.0f};
        pg8::gemm_phase<pg8::EpiPlainS8, pg8::MoeCountedOrder, true, true, false, true>(F.lds + RING_OFF, g, S, E);
        GRID_BAR();
    }
    if (IN(11)) REP(11) { if (N_LAUNCHES == PER_PHASE) moe_tables(F); final_phase(F); }
#undef IN
}

extern "C" void kernel_launch(void* const* d_in, const int* in_sizes, int n_in, void* d_out, int out_size, void* d_ws, size_t ws_size, hipStream_t stream) {
    static int grid = 0;
    if (grid == 0) {
        if (n_in != 18 || in_sizes[0] != T * DM || out_size != T * DM || ws_size < WS_END) { fprintf(stderr, "kernel_launch: unexpected shapes (n_in %d, in0 %d, out %d, ws %zu)\n", n_in, n_in > 0 ? in_sizes[0] : -1, out_size, ws_size); grid = -1; return; }
        int dev = 0, cus = 0, per_cu = 0;
        if (hipGetDevice(&dev) != hipSuccess || hipDeviceGetAttribute(&cus, hipDeviceAttributeMultiprocessorCount, dev) != hipSuccess) { grid = -1; return; }
        if (hipFuncSetAttribute((const void*)fwd_kernel, hipFuncAttributeMaxDynamicSharedMemorySize, LDS_BYTES) != hipSuccess) { fprintf(stderr, "kernel_launch: hipFuncSetAttribute failed\n"); grid = -1; return; }
        if (hipOccupancyMaxActiveBlocksPerMultiprocessor(&per_cu, (const void*)fwd_kernel, NWAVES * 64, LDS_BYTES) != hipSuccess || per_cu < 1) fprintf(stderr, "kernel_launch: occupancy query says %d\n", per_cu);
        (void)hipGetLastError();
        grid = cus - (cus % 8);
        if (grid <= 0) grid = 8;
    }
    if (grid < 0) return;
    if (hipMemsetAsync((char*)d_ws + WS_CTL, 0, CTL_ZERO_BYTES, stream) != hipSuccess) return;
    Args a{};
    for (int i = 0; i < 18; ++i) a.in[i] = (const float*)d_in[i];
    a.out = (float*)d_out; a.ws = (unsigned char*)d_ws;
    for (int li = 0; li < N_LAUNCHES; ++li) {
        a.ph_lo = (N_LAUNCHES == PER_PHASE) ? li : 0; a.ph_hi = (N_LAUNCHES == PER_PHASE) ? li + 1 : PER_PHASE; a.li = li; a.pad = 0;
        hipLaunchKernelGGL(fwd_kernel, dim3(grid), dim3(NWAVES * 64), LDS_BYTES, stream, a);
    }
}
```

```cpp
#include <hip/hip_runtime.h>
#include <cstdio>
#include <cstdint>
#ifndef PJ_V8
#define PJ_V8 1
#endif
#ifndef PJ_IB8
#define PJ_IB8 0
#endif
#ifndef PJ_GB8
#define PJ_GB8 0
#endif
#ifndef P5_F8
#define P5_F8 0
#endif
#ifndef P6_F8
#define P6_F8 1
#endif
#ifndef P1_CONV_WGS
#define P1_CONV_WGS 32
#endif
#ifndef SKIP_T0
#define SKIP_T0 20.0f
#endif
struct PjList { int k[7]; int n; };
constexpr PjList pj_make(bool f8) { PjList r{}; r.n = 0; for (int kind = 0; kind < 7; ++kind) { const bool is8 = (kind == 2 && PJ_V8) || (kind == 5 && PJ_IB8) || (kind == 6 && PJ_GB8); if (is8 == f8) r.k[r.n++] = kind; } return r; }
constexpr PjList PJ16 = pj_make(false), PJ8 = pj_make(true);
__host__ __device__ __forceinline__ int pj_kind16(int g) { int kind = 0;
#pragma unroll
    for (int i = 0; i < PJ16.n; ++i) if (g == i) kind = PJ16.k[i];
    return kind; }
__host__ __device__ __forceinline__ int pj_kind8(int g) { int kind = 0;
#pragma unroll
    for (int i = 0; i < PJ8.n; ++i) if (g == i) kind = PJ8.k[i];
    return kind; }
__host__ __device__ __forceinline__ int pj_srccol(int kind) { return kind < 3 ? 1024 * kind : 3080 + 1024 * (kind - 3); }
namespace pg8 {
#define PG8_LAS __attribute__((address_space(3)))
typedef unsigned short bf16_t;
typedef short bf16x8 __attribute__((ext_vector_type(8)));
typedef float f32x4 __attribute__((ext_vector_type(4)));
typedef unsigned u32x4 __attribute__((ext_vector_type(4)));
typedef int v4i_t __attribute__((ext_vector_type(4)));
typedef int v8i_t __attribute__((ext_vector_type(8)));
constexpr int BM = 256, BK = 64, HALF = 128, HTB = HALF * BK * 2  , STAGE_BYTES = 8 * HTB, NXCD = 8, WGM = 8;

__host__ __device__ __forceinline__ int lds_byte(int r, int c) { const int st = (r >> 4) * 2 + (c >> 5), rr = r & 15, cc = c & 31, ob = rr * 64 + cc * 2; return st * 1024 + (ob ^ (((ob >> 9) & 1) << 5)); }
__host__ __device__ __forceinline__ void stage_rc(int b, int& R, int& C) { const int st = b / 1024, sb = b % 1024, swz = sb ^ (((sb >> 9) & 1) << 5); R = (st >> 1) * 16 + swz / 64; C = (st & 1) * 32 + (swz % 64) / 2; }
__host__ __device__ __forceinline__ int perm32(int rho) { const int n = rho >> 4, i = rho & 15; return 8 * (i >> 2) + 4 * n + (i & 3); }

struct Unit { int pm, pn, pb; };
struct Gemm { const bf16_t* A; const bf16_t* Bt; int M, N, K; const void* base; };

struct StaticOrder {
    int nM, nN, nwg, G, c;
    __host__ __device__ void init(int M, int N, int G_, int c_) { nM = M / BM; nN = N / BM; nwg = nM * nN; G = G_; c = c_; }
    __host__ __device__ bool next(int i, Unit& u) const {
        const long L = (long)i * G + c; if (L >= nwg) return false;
        int wgid = (int)L; { const int q = nwg / NXCD, r = nwg % NXCD, xcd = wgid % NXCD, off = wgid / NXCD; wgid = (xcd < r ? xcd * (q + 1) : r * (q + 1) + (xcd - r) * q) + off; }
        const int nig = WGM * nN, gid = wgid / nig, fm = gid * WGM, gsz = (nM - fm) < WGM ? (nM - fm) : WGM;
        u.pm = fm + ((wgid % nig) % gsz); u.pn = (wgid % nig) / gsz; u.pb = u.pn; return true;
    }
    __device__ __forceinline__ void a_ready(const Unit&) const {}
    __device__ __forceinline__ void done(const Unit&) const {}
};

struct StaticOrderSig : StaticOrder {
    unsigned* flag; Unit lastu;
    __device__ void init_sig(int M, int N, int G_, int c_, unsigned* flag_) { init(M, N, G_, c_); flag = flag_; const int n = (nwg - c_ + G_ - 1) / G_, nmax = (nwg + G_ - 1) / G_; lastu.pm = -1; lastu.pn = -1; lastu.pb = -1; if (n > 0 && n == nmax) next(n - 1, lastu); }
    __device__ __forceinline__ void a_ready(const Unit& u) const { if (u.pm == lastu.pm && u.pn == lastu.pn && threadIdx.x == 0) __hip_atomic_store(flag, 1u, __ATOMIC_RELAXED, __HIP_MEMORY_SCOPE_AGENT); }
};
typedef float f32x2c_t __attribute__((ext_vector_type(2))); typedef __bf16 bf16x2c_t __attribute__((ext_vector_type(2)));
__device__ __forceinline__ unsigned cvt_pk_bf16(float lo, float hi) { const f32x2c_t v = {lo, hi}; const bf16x2c_t b = __builtin_convertvector(v, bf16x2c_t); return __builtin_bit_cast(unsigned, b); }
typedef float f32x2 __attribute__((ext_vector_type(2)));

__device__ __forceinline__ float bf_lo(unsigned u) { return __uint_as_float(u << 16); }
__device__ __forceinline__ float bf_hi(unsigned u) { return __uint_as_float(u & 0xffff0000u); }
__device__ __forceinline__ float sigmoidf_(float x) { return __builtin_amdgcn_rcpf(1.0f + __builtin_amdgcn_exp2f(-1.4426950408889634f * x)); }
__device__ __forceinline__ u32x4 pack8f(const f32x4 a, const f32x4 b) { u32x4 w; w.x = cvt_pk_bf16(a[0], a[1]); w.y = cvt_pk_bf16(a[2], a[3]); w.z = cvt_pk_bf16(b[0], b[1]); w.w = cvt_pk_bf16(b[2], b[3]); return w; }
__device__ __forceinline__ void unpack8f(const u32x4 w, f32x4& a, f32x4& b) { a = (f32x4){bf_lo(w.x), bf_hi(w.x), bf_lo(w.y), bf_hi(w.y)}; b = (f32x4){bf_lo(w.z), bf_hi(w.z), bf_lo(w.w), bf_hi(w.w)}; }

struct EpiProj {
    static constexpr bool PERM = true, AFTER_DRAIN = false;
    bf16_t* qkv;
    bf16_t* hg;
    bf16_t* gt;
    const float* rstd; unsigned* nrm;
    __device__ __forceinline__ void operator()(const f32x4 (&acc)[2][2][4][2], const Unit& u, int wr, int wc, int fr, int fq) const {
        const int row0 = u.pm * BM + wr * 64 + fr; const int lanecol = wc * 32 + 8 * fq; float mx0 = 0.f, mx1 = 0.f; float ssv[2][4][2];
        bf16_t* base; size_t ld, bjoff; size_t rowbase;
        const int kind = pj_kind16(u.pn >> 2), sub = u.pn & 3;
        if (kind < 3) { const int which = kind, hp = sub, b = u.pm >> 4; base = qkv + (size_t)which * ((size_t)16384 * 1024) + ((size_t)(b * 8 + 2 * hp) * 4096) * 128; ld = 128; bjoff = (size_t)4096 * 128; rowbase = (size_t)(row0 & 4095); }
        else { base = hg + (size_t)(kind - 3) * ((size_t)16384 * 1024) + sub * 256; ld = 1024; bjoff = 128; rowbase = (size_t)row0; }
        float rsv[2][4];
#pragma unroll
        for (int ai = 0; ai < 2; ++ai)
#pragma unroll
            for (int m = 0; m < 4; ++m) rsv[ai][m] = rstd[row0 + ai * HALF + m * 16];
        __builtin_amdgcn_sched_barrier(0);
#pragma unroll
        for (int ai = 0; ai < 2; ++ai)
#pragma unroll
            for (int m = 0; m < 4; ++m) { const int r = ai * HALF + m * 16; const float rs = rsv[ai][m]; bf16_t* rowp = base + (rowbase + r) * ld + lanecol;
#pragma unroll
                for (int bj = 0; bj < 2; ++bj) { const f32x4 v0 = acc[ai][bj][m][0] * rs, v1 = acc[ai][bj][m][1] * rs; *(u32x4*)(rowp + bj * bjoff) = pack8f(v0, v1);
                    ssv[ai][m][bj] = (v0[0] * v0[0] + v0[1] * v0[1]) + (v0[2] * v0[2] + v0[3] * v0[3]) + (v1[0] * v1[0] + v1[1] * v1[1]) + (v1[2] * v1[2] + v1[3] * v1[3]); } }
        if (kind < 2) {
#pragma unroll
            for (int ai = 0; ai < 2; ++ai)
#pragma unroll
                for (int m = 0; m < 4; ++m)
#pragma unroll
                    for (int bj = 0; bj < 2; ++bj) ssv[ai][m][bj] += __shfl_xor(ssv[ai][m][bj], 16);
#pragma unroll
            for (int ai = 0; ai < 2; ++ai)
#pragma unroll
                for (int m = 0; m < 4; ++m)
#pragma unroll
                    for (int bj = 0; bj < 2; ++bj) ssv[ai][m][bj] += __shfl_xor(ssv[ai][m][bj], 32);
#pragma unroll
            for (int ai = 0; ai < 2; ++ai)
#pragma unroll
                for (int m = 0; m < 4; ++m) { mx0 = fmaxf(mx0, ssv[ai][m][0]); mx1 = fmaxf(mx1, ssv[ai][m][1]); }
#pragma unroll
            for (int o = 1; o < 16; o <<= 1) { mx0 = fmaxf(mx0, __shfl_xor(mx0, o)); mx1 = fmaxf(mx1, __shfl_xor(mx1, o)); }
            if (fr == 0 && fq == 0) { const int which = kind, hp = sub, b = u.pm >> 4; unsigned* p = nrm + ((which * 32 + b * 8 + 2 * hp) * 4 + wc);
                atomicMax(p, __float_as_uint(mx0)); atomicMax(p + 4, __float_as_uint(mx1)); } }
    }
};
__device__ __forceinline__ float clamp448(float x) { return fminf(fmaxf(x, -448.f), 448.f); }
__device__ __forceinline__ unsigned pk4_fp8(float a, float b, float c, float d) { int w = 0; w = __builtin_amdgcn_cvt_pk_fp8_f32(clamp448(a), clamp448(b), w, false); w = __builtin_amdgcn_cvt_pk_fp8_f32(clamp448(c), clamp448(d), w, true); return (unsigned)w; }
typedef unsigned u32x2 __attribute__((ext_vector_type(2)));
__device__ __forceinline__ float cl43(float x) { return fminf(fmaxf(x, -43.f), 43.f); }
struct EpiProjG8 {
    static constexpr bool PERM = true, AFTER_DRAIN = false;
    bf16_t* gt; const float* rstd; bf16_t* qkv; bf16_t* hg;
    __device__ __forceinline__ void operator()(const f32x4 (&acc)[2][2][4][2], const Unit& u, int wr, int wc, int fr, int fq) const {
        if (u.pn >= 16) {
            const int row0 = u.pm * BM + wr * 64 + fr; const int lanecol = wc * 32 + 8 * fq; const int kind = pj_kind8((u.pn - 16) >> 2), sub = u.pn & 3;
            bf16_t* base; size_t ld, bjoff; size_t rowbase;
            if (kind < 3) { const int b = u.pm >> 4; base = qkv + (size_t)kind * ((size_t)16384 * 1024) + ((size_t)(b * 8 + 2 * sub) * 4096) * 128; ld = 128; bjoff = (size_t)4096 * 128; rowbase = (size_t)(row0 & 4095); }
            else { base = hg + (size_t)(kind - 3) * ((size_t)16384 * 1024) + sub * 256; ld = 1024; bjoff = 128; rowbase = (size_t)row0; }
            float rsv[2][4];
#pragma unroll
            for (int ai = 0; ai < 2; ++ai)
#pragma unroll
                for (int m = 0; m < 4; ++m) rsv[ai][m] = rstd[row0 + ai * HALF + m * 16];
            __builtin_amdgcn_sched_barrier(0);
#pragma unroll
            for (int ai = 0; ai < 2; ++ai)
#pragma unroll
                for (int m = 0; m < 4; ++m) { const int r = ai * HALF + m * 16; const float rs = rsv[ai][m] * (1.0f / 4096.0f); bf16_t* rowp = base + (rowbase + r) * ld + lanecol;
#pragma unroll
                    for (int bj = 0; bj < 2; ++bj) *(u32x4*)(rowp + bj * bjoff) = pack8f(acc[ai][bj][m][0] * rs, acc[ai][bj][m][1] * rs); }
            return;
        }
        const __amdgpu_buffer_rsrc_t rg = __builtin_amdgcn_make_buffer_rsrc((void*)gt, 0, 16384 * 2048 * 2, 0x00020000), rg2 = __builtin_amdgcn_make_buffer_rsrc((void*)(gt + (size_t)16384 * 2048), 0, 16384 * 2048 * 2, 0x00020000);
        const __amdgpu_buffer_rsrc_t rr = __builtin_amdgcn_make_buffer_rsrc((void*)rstd, 0, 16384 * 4, 0x00020000);
        const int row0 = u.pm * BM + wr * 64 + fr; const int colb = (u.pn * HALF + wc * 32 + 8 * fq) * 2;
        float rsv[2][4];
#pragma unroll
        for (int ai = 0; ai < 2; ++ai)
#pragma unroll
            for (int m = 0; m < 4; ++m) rsv[ai][m] = __builtin_bit_cast(float, __builtin_amdgcn_raw_buffer_load_b32(rr, (row0 + ai * HALF + m * 16) * 4, 0, 0));
        __builtin_amdgcn_sched_barrier(0);
#pragma unroll
        for (int ai = 0; ai < 2; ++ai)
#pragma unroll
            for (int m = 0; m < 4; ++m) { const int r = row0 + ai * HALF + m * 16; const float rs = rsv[ai][m] * (-1.4426950408889634f / 4096.0f);
                f32x4 q0, q1, s0, s1;
#pragma unroll
                for (int i = 0; i < 4; ++i) { const float ea0 = fminf(1.0f + __builtin_amdgcn_exp2f(acc[ai][0][m][0][i] * rs), 1e13f), eb0 = fminf(1.0f + __builtin_amdgcn_exp2f(acc[ai][1][m][0][i] * rs), 1e13f);
                    const float ea1 = fminf(1.0f + __builtin_amdgcn_exp2f(acc[ai][0][m][1][i] * rs), 1e13f), eb1 = fminf(1.0f + __builtin_amdgcn_exp2f(acc[ai][1][m][1][i] * rs), 1e13f);
                    q0[i] = eb0 * __builtin_amdgcn_rcpf(ea0); q1[i] = eb1 * __builtin_amdgcn_rcpf(ea1); s0[i] = __builtin_amdgcn_rcpf(eb0); s1[i] = __builtin_amdgcn_rcpf(eb1); }
                __builtin_amdgcn_raw_buffer_store_b128(pack8f(q0, q1), rg, r * 4096 + colb, 0, 0);
                __builtin_amdgcn_raw_buffer_store_b128(pack8f(s0, s1), rg2, r * 4096 + colb, 0, 0); }
    }
};
struct EpiPlain {
    static constexpr bool PERM = true, AFTER_DRAIN = false;
    bf16_t* O; int ldc;
    __device__ __forceinline__ void operator()(const f32x4 (&acc)[2][2][4][2], const Unit& u, int wr, int wc, int fr, int fq) const {
        const int row0 = u.pm * BM + wr * 64 + fr, col0 = u.pn * BM + wc * 32 + 8 * fq;
#pragma unroll
        for (int ai = 0; ai < 2; ++ai)
#pragma unroll
            for (int m = 0; m < 4; ++m) { bf16_t* rowp = O + (size_t)(row0 + ai * HALF + m * 16) * ldc + col0;
#pragma unroll
                for (int bj = 0; bj < 2; ++bj) *(u32x4*)(rowp + bj * HALF) = pack8f(acc[ai][bj][m][0], acc[ai][bj][m][1]); }
    }
};
struct EpiPlainS {
    static constexpr bool PERM = true, AFTER_DRAIN = false;
    bf16_t* O; int ldc; float s;
    __device__ __forceinline__ void operator()(const f32x4 (&acc)[2][2][4][2], const Unit& u, int wr, int wc, int fr, int fq) const {
        const int row0 = u.pm * BM + wr * 64 + fr, col0 = u.pn * BM + wc * 32 + 8 * fq;
#pragma unroll
        for (int ai = 0; ai < 2; ++ai)
#pragma unroll
            for (int m = 0; m < 4; ++m) { bf16_t* rowp = O + (size_t)(row0 + ai * HALF + m * 16) * ldc + col0;
#pragma unroll
                for (int bj = 0; bj < 2; ++bj) *(u32x4*)(rowp + bj * HALF) = pack8f(acc[ai][bj][m][0] * s, acc[ai][bj][m][1] * s); }
    }
};
struct EpiPlainS8 {
    static constexpr bool PERM = true, AFTER_DRAIN = false;
    unsigned char* O; int ldc; float s;
    __device__ __forceinline__ void operator()(const f32x4 (&acc)[2][2][4][2], const Unit& u, int wr, int wc, int fr, int fq) const {
        const int row0 = u.pm * BM + wr * 64 + fr, col0 = u.pn * BM + wc * 32 + 8 * fq;
#pragma unroll
        for (int ai = 0; ai < 2; ++ai)
#pragma unroll
            for (int m = 0; m < 4; ++m) { unsigned char* rowp = O + (size_t)(row0 + ai * HALF + m * 16) * ldc + col0;
#pragma unroll
                for (int bj = 0; bj < 2; ++bj) { const f32x4 v0 = acc[ai][bj][m][0] * s, v1 = acc[ai][bj][m][1] * s; u32x2 w; w.x = pk4_fp8(v0[0], v0[1], v0[2], v0[3]); w.y = pk4_fp8(v1[0], v1[1], v1[2], v1[3]); *(u32x2*)(rowp + bj * HALF) = w; } }
    }
};
template <bool ADD> struct EpiGate {
    static constexpr bool PERM = true, AFTER_DRAIN = false;
    bf16_t* O; const bf16_t* gate; const bf16_t* prev;
    __device__ __forceinline__ void operator()(const f32x4 (&acc)[2][2][4][2], const Unit& u, int wr, int wc, int fr, int fq) const {
        const int row0 = u.pm * BM + wr * 64 + fr, col0 = u.pn * BM + wc * 32 + 8 * fq;
#pragma unroll
        for (int ai = 0; ai < 2; ++ai)
#pragma unroll
            for (int m = 0; m < 4; ++m) { const size_t off = (size_t)(row0 + ai * HALF + m * 16) * 2048 + col0;
#pragma unroll
                for (int bj = 0; bj < 2; ++bj) { f32x4 g0, g1; unpack8f(*(const u32x4*)(gate + off + bj * HALF), g0, g1);
                    f32x4 v0, v1;
#pragma unroll
                    for (int i = 0; i < 4; ++i) { v0[i] = sigmoidf_(g0[i]) * acc[ai][bj][m][0][i]; v1[i] = sigmoidf_(g1[i]) * acc[ai][bj][m][1][i]; }
                    if (ADD) { f32x4 p0, p1; unpack8f(*(const u32x4*)(prev + off + bj * HALF), p0, p1); v0 += p0; v1 += p1; }
                    *(u32x4*)(O + off + bj * HALF) = pack8f(v0, v1); } }
    }
};
template <bool IN8, bool OUT8> struct EpiGate2T {
    static constexpr bool PERM = true, AFTER_DRAIN = false, MID = true;
    bf16_t* O; const bf16_t* rat; const bf16_t* sb;
    __device__ __forceinline__ void mid(f32x4 (&acc)[2][2][4][2], const Unit& u, int wr, int wc, int fr, int fq) const {
        const int row0 = u.pm * BM + wr * 64 + fr, col0 = u.pn * BM + wc * 32 + 8 * fq;
#pragma unroll
        for (int ai = 0; ai < 2; ++ai)
#pragma unroll
            for (int m = 0; m < 4; ++m) { const size_t off = (size_t)(row0 + ai * HALF + m * 16) * 2048 + col0;
#pragma unroll
                for (int bj = 0; bj < 2; ++bj) { f32x4 a0, a1; unpack8f(*(const u32x4*)(rat + off + bj * HALF), a0, a1); acc[ai][bj][m][0] *= a0; acc[ai][bj][m][1] *= a1; } }
    }
    __device__ __forceinline__ void operator()(const f32x4 (&acc)[2][2][4][2], const Unit& u, int wr, int wc, int fr, int fq) const {
        const int row0 = u.pm * BM + wr * 64 + fr, col0 = u.pn * BM + wc * 32 + 8 * fq;
        constexpr float sc = (IN8 ? 1.0f / 4096.0f : 1.0f) * (OUT8 ? 16.0f : 1.0f);
#pragma unroll
        for (int ai = 0; ai < 2; ++ai) {
            u32x4 gv[4][2];
#pragma unroll
            for (int m = 0; m < 4; ++m)
#pragma unroll
                for (int bj = 0; bj < 2; ++bj) gv[m][bj] = *(const u32x4*)(sb + (size_t)(row0 + ai * HALF + m * 16) * 2048 + col0 + bj * HALF);
            __builtin_amdgcn_sched_barrier(0);
#pragma unroll
            for (int m = 0; m < 4; ++m) { const size_t off = (size_t)(row0 + ai * HALF + m * 16) * 2048 + col0;
#pragma unroll
                for (int bj = 0; bj < 2; ++bj) { f32x4 g0, g1; unpack8f(gv[m][bj], g0, g1); const f32x4 v0 = acc[ai][bj][m][0] * g0 * sc, v1 = acc[ai][bj][m][1] * g1 * sc;
                    if constexpr (OUT8) { u32x2 w; w.x = pk4_fp8(v0[0], v0[1], v0[2], v0[3]); w.y = pk4_fp8(v1[0], v1[1], v1[2], v1[3]); *(u32x2*)((unsigned char*)O + off + bj * HALF) = w; }
                    else *(u32x4*)(O + off + bj * HALF) = pack8f(v0, v1); } } }
    }
};
struct EpiResid {
    static constexpr bool PERM = true, AFTER_DRAIN = false;
    bf16_t* O; const float* X;
    __device__ __forceinline__ void operator()(const f32x4 (&acc)[2][2][4][2], const Unit& u, int wr, int wc, int fr, int fq) const {
        const int row0 = u.pm * BM + wr * 64 + fr, col0 = u.pn * BM + wc * 32 + 8 * fq;
#pragma unroll
        for (int ai = 0; ai < 2; ++ai)
#pragma unroll
            for (int m = 0; m < 4; ++m) { const size_t off = (size_t)(row0 + ai * HALF + m * 16) * 2048 + col0;
#pragma unroll
                for (int bj = 0; bj < 2; ++bj) { const f32x4 x0 = *(const f32x4*)(X + off + bj * HALF), x1 = *(const f32x4*)(X + off + bj * HALF + 4);
                    *(u32x4*)(O + off + bj * HALF) = pack8f(acc[ai][bj][m][0] + x0, acc[ai][bj][m][1] + x1); } }
    }
};
template <bool IN8> struct EpiResid8T {
    static constexpr bool PERM = true, AFTER_DRAIN = false;
    bf16_t* O; const bf16_t* X; unsigned char* O8;
    __device__ __forceinline__ void operator()(const f32x4 (&acc)[2][2][4][2], const Unit& u, int wr, int wc, int fr, int fq) const {
        const int row0 = u.pm * BM + wr * 64 + fr, col0 = u.pn * BM + wc * 32 + 8 * fq;
#pragma unroll
        for (int ai = 0; ai < 2; ++ai) {
            u32x4 xv[4][2];
#pragma unroll
            for (int m = 0; m < 4; ++m)
#pragma unroll
                for (int bj = 0; bj < 2; ++bj) xv[m][bj] = *(const u32x4*)(X + (size_t)(row0 + ai * HALF + m * 16) * 2048 + col0 + bj * HALF);
            __builtin_amdgcn_sched_barrier(0);
#pragma unroll
            for (int m = 0; m < 4; ++m) { const size_t off = (size_t)(row0 + ai * HALF + m * 16) * 2048 + col0;
#pragma unroll
                for (int bj = 0; bj < 2; ++bj) { f32x4 x0, x1; unpack8f(xv[m][bj], x0, x1); const f32x4 v0 = acc[ai][bj][m][0] * (IN8 ? 1.0f / 4096.0f : 1.0f) + x0, v1 = acc[ai][bj][m][1] * (IN8 ? 1.0f / 4096.0f : 1.0f) + x1;
                    *(u32x4*)(O + off + bj * HALF) = pack8f(v0, v1);
                    u32x2 w; w.x = pk4_fp8(16.f * v0[0], 16.f * v0[1], 16.f * v0[2], 16.f * v0[3]); w.y = pk4_fp8(16.f * v1[0], 16.f * v1[1], 16.f * v1[2], 16.f * v1[3]); *(u32x2*)(O8 + off + bj * HALF) = w; } } }
    }
};
struct EpiMoe1 {
    static constexpr bool PERM = true, AFTER_DRAIN = false;
    bf16_t* Hb; const float* rowscale;
    __device__ __forceinline__ void operator()(const f32x4 (&acc)[2][2][4][2], const Unit& u, int wr, int wc, int fr, int fq) const {
        const int row0 = u.pm * BM + wr * 64 + fr, col0 = u.pn * HALF + wc * 32 + 8 * fq;
#pragma unroll
        for (int ai = 0; ai < 2; ++ai)
#pragma unroll
            for (int m = 0; m < 4; ++m) { const int row = row0 + ai * HALF + m * 16; const float rs = rowscale[row]; f32x4 v0, v1;
#pragma unroll
                for (int i = 0; i < 4; ++i) { const float a0 = acc[ai][0][m][0][i] * rs, b0 = acc[ai][1][m][0][i] * rs, a1 = acc[ai][0][m][1][i] * rs, b1 = acc[ai][1][m][1][i] * rs;
                    v0[i] = a0 * sigmoidf_(a0) * b0; v1[i] = a1 * sigmoidf_(a1) * b1; }
                *(u32x4*)(Hb + (size_t)row * 1024 + col0) = pack8f(v0, v1); }
    }
};
struct EpiMoe1G {
    static constexpr bool PERM = true, AFTER_DRAIN = false;
    bf16_t* Hb; const float* slot_rs; const PG8_LAS int* tab;
    __device__ __forceinline__ void operator()(const f32x4 (&acc)[2][2][4][2], const Unit& u, int wr, int wc, int fr, int fq) const {
        const int row0 = u.pm * BM + wr * 64 + fr, col0 = u.pn * HALF + wc * 32 + 8 * fq; const int e = tab[34 + u.pm], ps = tab[e], cn = tab[194 + e];
#pragma unroll
        for (int ai = 0; ai < 2; ++ai)
#pragma unroll
            for (int m = 0; m < 4; ++m) { const int row = row0 + ai * HALF + m * 16, slot = row - ps; const float rs = slot < cn ? slot_rs[(size_t)e * 16384 + slot] : 0.f; f32x4 v0, v1;
#pragma unroll
                for (int i = 0; i < 4; ++i) { const float a0 = acc[ai][0][m][0][i] * rs, b0 = acc[ai][1][m][0][i] * rs, a1 = acc[ai][0][m][1][i] * rs, b1 = acc[ai][1][m][1][i] * rs;
                    v0[i] = a0 * sigmoidf_(a0) * b0; v1[i] = a1 * sigmoidf_(a1) * b1; }
                *(u32x4*)(Hb + (size_t)row * 1024 + col0) = pack8f(v0, v1); }
    }
};
struct EpiMoe1G8 {
    static constexpr bool PERM = true, AFTER_DRAIN = false;
    unsigned char* Hb; const float* slot_rs; const PG8_LAS int* tab;
    __device__ __forceinline__ void operator()(const f32x4 (&acc)[2][2][4][2], const Unit& u, int wr, int wc, int fr, int fq) const {
        const int e = tab[34 + u.pm], ps = tab[e], cn = tab[194 + e];
        const int slot0 = u.pm * BM + wr * 64 + fr - ps; const float* rsp = slot_rs + (size_t)e * 16384 + slot0; const int hoff = (u.pm * BM + wr * 64 + fr) * 1024 + (u.pn * HALF + wc * 32 + 8 * fq);
        const __amdgpu_buffer_rsrc_t rh = __builtin_amdgcn_make_buffer_rsrc((void*)Hb, 0, 160 * 256 * 1024, 0x00020000);
#pragma unroll
        for (int ai = 0; ai < 2; ++ai) {
            float rsv[4];
#pragma unroll
            for (int m = 0; m < 4; ++m) { const int dr = ai * HALF + m * 16; rsv[m] = (slot0 + dr) < cn ? rsp[dr] : 0.f; }
            __builtin_amdgcn_sched_barrier(0);
#pragma unroll
            for (int m = 0; m < 4; ++m) { const int dr = ai * HALF + m * 16; const float rs = rsv[m] * (1.0f / 4096.0f); f32x4 v0, v1;
#pragma unroll
                for (int i = 0; i < 4; ++i) { const float a0 = acc[ai][0][m][0][i] * rs, b0 = acc[ai][1][m][0][i] * rs, a1 = acc[ai][0][m][1][i] * rs, b1 = acc[ai][1][m][1][i] * rs;
                    v0[i] = 8.f * a0 * sigmoidf_(a0) * b0; v1[i] = 8.f * a1 * sigmoidf_(a1) * b1; }
                u32x2 w; w.x = pk4_fp8(v0[0], v0[1], v0[2], v0[3]); w.y = pk4_fp8(v1[0], v1[1], v1[2], v1[3]); __builtin_amdgcn_raw_buffer_store_b64(w, rh, hoff + dr * 1024, 0, 16);
                }
            asm volatile("" ::: "memory"); }
    }
};
struct MoeGatherOrder {
    int nblk, G, c, tiles_per_e; const PG8_LAS int* tab; const int* tlist; PG8_LAS unsigned* park; unsigned* cnt; mutable int pend;
    __device__ __forceinline__ bool next(int i, Unit& u) const {
        const long L = (long)i * G + c; const int idx = (int)(L >> 3); if (idx >= nblk) return false;
        u.pm = idx; u.pn = (int)(L & 7); u.pb = tab[34 + idx] * tiles_per_e + u.pn; return true;
    }
    __device__ __forceinline__ int arow(const Unit& u, int r) const { const int e = tab[34 + u.pm], slot = u.pm * BM + r - tab[e], cm = tab[194 + e] - 1; return tlist[(size_t)e * 16384 + (slot < cm ? slot : cm)]; }
    __device__ __forceinline__ void a_ready(const Unit&) const {}
    __device__ __forceinline__ void publish(int blk) const { if ((threadIdx.x & 63) == 0) __hip_atomic_fetch_add(cnt + 64 * blk, 1u, __ATOMIC_RELAXED, __HIP_MEMORY_SCOPE_AGENT); }
    __device__ __forceinline__ void done(const Unit& u) const { if (pend >= 0) publish(pend); pend = u.pm; }
    __device__ __forceinline__ void flush() const { asm volatile("s_waitcnt vmcnt(0)" ::: "memory"); if (pend >= 0) publish(pend); pend = -1; }
};
struct MoeCountedOrder {
    int nblk, G, c, i0, n1, tiles_per_e; const PG8_LAS int* blk_e; const unsigned* cnt; volatile PG8_LAS int* bc; mutable unsigned ahead;
    __device__ __forceinline__ bool next(int i, Unit& u) const {
        const long L = (long)(i + i0) * G + c - n1; const int idx = (int)(L >> 3); if (idx >= nblk) return false;
        u.pm = idx; u.pn = (int)(L & 7); u.pb = blk_e[idx] * tiles_per_e + u.pn; return true;
    }
    __device__ __forceinline__ void a_ready(const Unit& u) const {
        if (ahead & 1u) { ahead >>= 1; return; }
        if (threadIdx.x < 64) { unsigned polls = 0, m;
            const int step = G >> 3, bj = u.pm + step * (int)threadIdx.x;
            for (;;) { const unsigned v = (threadIdx.x < 8 && bj < nblk) ? __hip_atomic_load(cnt + 64 * bj, __ATOMIC_RELAXED, __HIP_MEMORY_SCOPE_AGENT) : 64u;
                m = (unsigned)__ballot(v >= 64u) & 0xffu;
                if ((m & 1u) || ++polls > (1u << 20)) break; __builtin_amdgcn_s_sleep(2); }
            __builtin_amdgcn_fence(__ATOMIC_ACQUIRE, "agent");
            asm volatile("s_waitcnt vmcnt(0)" ::: "memory");
            if (threadIdx.x == 0) bc[0] = (int)m; asm volatile("s_waitcnt lgkmcnt(0)" ::: "memory"); }
        asm volatile("" ::: "memory"); __builtin_amdgcn_s_barrier(); asm volatile("" ::: "memory");
        ahead = ((unsigned)__builtin_amdgcn_readfirstlane(bc[0])) >> 1;
    }
    __device__ __forceinline__ void done(const Unit&) const {}
};
struct MoeOrder {
    int nblk, G, c, tiles_per_e; const PG8_LAS int* blk_e;
    __device__ __forceinline__ bool next(int i, Unit& u) const {
        const long L = (long)i * G + c; const int idx = (int)(L >> 3); if (idx >= nblk) return false;
        u.pm = idx; u.pn = (int)(L & 7); u.pb = blk_e[idx] * tiles_per_e + u.pn; return true;
    }
    __device__ __forceinline__ void a_ready(const Unit&) const {}
    __device__ __forceinline__ void done(const Unit&) const {}
};
template <class E_, class = void> struct epi_has_mid { static constexpr bool v = false; };
template <class E_> struct epi_has_mid<E_, decltype((void)E_::MID)> { static constexpr bool v = E_::MID; };
template <class Epi, class Sched, bool ALIGN_EPI = false, bool SP2 = false, bool GATHER = false, bool F8 = false>
__device__ __forceinline__ void gemm_phase(PG8_LAS unsigned char* lds, const Gemm g, const Sched& S, const Epi& E) {
    const int tid = threadIdx.x, wid = __builtin_amdgcn_readfirstlane(tid >> 6), lane = tid & 63, wr = wid >> 2, wc = wid & 3, fr = lane & 15, fq = lane >> 4;
    const int K = g.K, nt = K / BK;
    unsigned voffA[2], voffB[2];
#pragma unroll
    for (int i = 0; i < 2; ++i) { int R, C; stage_rc(tid * 16 + i * 8192, R, C); const int Rb = Epi::PERM ? ((R & ~31) + perm32(R & 31)) : R;
        voffA[i] = (unsigned)(R * K + C) * 2u; voffB[i] = (unsigned)(Rb * K + C) * 2u; }
    static_assert(!GATHER || SP2, "GATHER is implemented for the SP2 loop");
    unsigned cvA[2][2] = {{0u, 0u}, {0u, 0u}}; const unsigned svA[2][2] = {{0u, 0u}, {0u, 0u}};
    const unsigned kstep = (unsigned)(BK * 2);
    const unsigned hstep = (unsigned)HALF * (unsigned)K * 2u;
    const unsigned tstep = 2u * hstep;
    const unsigned qstep = 64u * (unsigned)K * 2u;
    const unsigned ldsw = (unsigned)wid * 1024u;
    const int aoff = F8 ? (lds_byte(wr * 64 + fr, fq * 16) + 16 * (fq & 1)) : lds_byte(wr * 64 + fr, fq * 8), boff = F8 ? (lds_byte(wc * 32 + fr, fq * 16) + 16 * (fq & 1)) : lds_byte(wc * 32 + fr, fq * 8);
    static_assert(!F8 || SP2, "F8 is implemented for the SP2 loop");
#define PG8_SA(b, h) (((b) * 2 + (h)) * HTB)
#define PG8_SB(b, h) ((4 + (b) * 2 + (h)) * HTB)
#define PG8_STAGE(bufoff, gbase, voff) do { _Pragma("unroll") for (int _i = 0; _i < 2; ++_i) \
        __builtin_amdgcn_raw_ptr_buffer_load_lds(rsw, (PG8_LAS void*)(lds + (bufoff) + ldsw + _i * 8192), 16, (int)(voff)[_i], (int)(gbase), 0, 0); } while (0)
#define PG8_STAGE1(bufoff, gbase, voff0) do { _Pragma("unroll") for (int _i = 0; _i < 2; ++_i) \
        __builtin_amdgcn_raw_ptr_buffer_load_lds(rsw, (PG8_LAS void*)(lds + (bufoff) + ldsw + _i * 8192), 16, (int)(voff0), (int)((gbase) + (unsigned)_i * qstep), 0, 0); } while (0)
#define PG8_STAGE_A(bufoff, ptr, h, nx) do { if constexpr (GATHER) { unsigned vo_[2]; vo_[0] = (nx) ? svA[h][0] : cvA[h][0]; vo_[1] = (nx) ? svA[h][1] : cvA[h][1]; PG8_STAGE(bufoff, ptr, vo_); } \
        else { PG8_STAGE1(bufoff, (ptr) + (h) * hstep, voffA[0]); } } while (0)
#define PG8_GOFF(dst, u) do { int t_ = threadIdx.x; asm volatile("" : "+v"(t_)); _Pragma("unroll") for (int i_ = 0; i_ < 2; ++i_) { int R_, C_; stage_rc(t_ * 16 + i_ * 8192, R_, C_); _Pragma("unroll") for (int h_ = 0; h_ < 2; ++h_) dst[h_][i_] = (unsigned)S.arow(u, h_ * HALF + R_) * (unsigned)(K * 2) + (unsigned)C_ * 2u; } } while (0)
#define PG8_LDA(dst, b, h) do { if constexpr (F8) { _Pragma("unroll") for (int m = 0; m < 4; ++m) { const v4i_t lo_ = *(const PG8_LAS v4i_t*)(lds + PG8_SA(b, h) + aoff + m * 2048), hi_ = *(const PG8_LAS v4i_t*)(lds + PG8_SA(b, h) + (aoff ^ 16) + m * 2048); \
            dst##8[m] = __builtin_shufflevector(lo_, hi_, 0, 1, 2, 3, 4, 5, 6, 7); } } \
        else { _Pragma("unroll") for (int m = 0; m < 4; ++m) _Pragma("unroll") for (int k = 0; k < 2; ++k) dst[m][k] = *(const PG8_LAS bf16x8*)(lds + PG8_SA(b, h) + aoff + m * 2048 + k * 1024); } } while (0)
#define PG8_LDB(dst, b, h) do { if constexpr (F8) { _Pragma("unroll") for (int n = 0; n < 2; ++n) { const v4i_t lo_ = *(const PG8_LAS v4i_t*)(lds + PG8_SB(b, h) + boff + n * 2048), hi_ = *(const PG8_LAS v4i_t*)(lds + PG8_SB(b, h) + (boff ^ 16) + n * 2048); \
            dst##8[n] = __builtin_shufflevector(lo_, hi_, 0, 1, 2, 3, 4, 5, 6, 7); } } \
        else { _Pragma("unroll") for (int n = 0; n < 2; ++n) _Pragma("unroll") for (int k = 0; k < 2; ++k) dst[n][k] = *(const PG8_LAS bf16x8*)(lds + PG8_SB(b, h) + boff + n * 2048 + k * 1024); } } while (0)
#define PG8_MMA(ai, bj, At, Bt) do { __builtin_amdgcn_s_setprio(1); if constexpr (F8) { _Pragma("unroll") for (int m = 0; m < 4; ++m) _Pragma("unroll") for (int n = 0; n < 2; ++n) \
            acc[ai][bj][m][n] = __builtin_amdgcn_mfma_scale_f32_16x16x128_f8f6f4(Bt##8[n], At##8[m], acc[ai][bj][m][n], 0, 0, 0, 0, 0, 0); } \
        else { _Pragma("unroll") for (int m = 0; m < 4; ++m) _Pragma("unroll") for (int n = 0; n < 2; ++n) _Pragma("unroll") for (int k = 0; k < 2; ++k) \
            acc[ai][bj][m][n] = __builtin_amdgcn_mfma_f32_16x16x32_bf16(Bt[n][k], At[m][k], acc[ai][bj][m][n], 0, 0, 0); } __builtin_amdgcn_s_setprio(0); } while (0)
#define PG8_WAIT_V(n) asm volatile("s_waitcnt vmcnt(" #n ")" ::: "memory")
#define PG8_WAIT_L(n) asm volatile("s_waitcnt lgkmcnt(" #n ")" ::: "memory")
#define PG8_BAR __builtin_amdgcn_s_barrier()
#define PG8_SCHED __builtin_amdgcn_sched_barrier(0)
    Unit cur, nxt; int ui = 0;
    if (!S.next(0, cur)) return;
    f32x4 acc[2][2][4][2];
#pragma unroll
    for (int a = 0; a < 2; ++a)
#pragma unroll
        for (int b = 0; b < 2; ++b)
#pragma unroll
            for (int m = 0; m < 4; ++m)
#pragma unroll
                for (int n = 0; n < 2; ++n) acc[a][b][m][n] = (f32x4){0.f, 0.f, 0.f, 0.f};
    bf16x8 At[4][2], B0[2][2], B1[2][2]; v8i_t At8[4], B08[2], B18[2];
    const __amdgpu_buffer_rsrc_t rsw = __builtin_amdgcn_make_buffer_rsrc((void*)g.base, 0, 0x7ffffff0, 0x00020000);
    const unsigned oA0 = (unsigned)((const char*)g.A - (const char*)g.base), oB0 = (unsigned)((const char*)g.Bt - (const char*)g.base);
    unsigned cA = oA0 + (GATHER ? 0u : (unsigned)cur.pm * tstep); unsigned cB = oB0 + (unsigned)cur.pb * tstep;
    if constexpr (GATHER) PG8_GOFF(cvA, cur);
    S.a_ready(cur);
    if constexpr (SP2) {
        PG8_STAGE1(PG8_SB(0, 0), cB, voffB[0]); PG8_STAGE1(PG8_SB(0, 1), cB + hstep, voffB[0]); PG8_STAGE_A(PG8_SA(0, 0), cA, 0, false); PG8_STAGE_A(PG8_SA(0, 1), cA, 1, false);
        if (wr == 1) PG8_BAR;
        PG8_WAIT_V(2); PG8_BAR;
        PG8_STAGE1(PG8_SB(1, 0), cB + kstep, voffB[0]); PG8_STAGE_A(PG8_SA(1, 0), cA + kstep, 0, false); PG8_STAGE1(PG8_SB(1, 1), cB + hstep + kstep, voffB[0]);
        PG8_WAIT_V(6); PG8_BAR;
    } else {
        PG8_STAGE1(PG8_SB(0, 0), cB, voffB[0]); PG8_STAGE(PG8_SA(0, 0), cA, voffA); PG8_STAGE1(PG8_SB(0, 1), cB + hstep, voffB[0]); PG8_STAGE(PG8_SA(0, 1), cA + hstep, voffA);
        if (wr == 1) PG8_BAR;
        PG8_WAIT_V(4); PG8_BAR;
        PG8_STAGE1(PG8_SB(1, 0), cB + kstep, voffB[0]); PG8_STAGE(PG8_SA(1, 0), cA + kstep, voffA); PG8_STAGE1(PG8_SB(1, 1), cB + hstep + kstep, voffB[0]);
        PG8_WAIT_V(6); PG8_BAR;
    }
    for (;;) {
        const bool has_next = S.next(ui + 1, nxt);
        if constexpr (GATHER) { if (ui == 0) { unsigned tv_[2][2]; if (has_next) PG8_GOFF(tv_, nxt); else { tv_[0][0] = cvA[0][0]; tv_[0][1] = cvA[0][1]; tv_[1][0] = cvA[1][0]; tv_[1][1] = cvA[1][1]; }
            { int t_ = threadIdx.x; asm volatile("" : "+v"(t_)); *(PG8_LAS u32x4*)(S.park + t_ * 4) = (u32x4){tv_[0][0], tv_[0][1], tv_[1][0], tv_[1][1]}; } } }
        const unsigned nA = (has_next && !GATHER) ? oA0 + (unsigned)nxt.pm * tstep : cA; const unsigned nB = has_next ? oB0 + (unsigned)nxt.pb * tstep : cB;
#pragma unroll 1
        for (int t = 0; t < nt; t += 2) {
            const bool last = (t == nt - 2);
            const unsigned a1 = cA + (unsigned)(t + 1) * kstep;
            const unsigned a2 = last ? nA : cA + (unsigned)(t + 2) * kstep; const unsigned b2 = last ? nB : cB + (unsigned)(t + 2) * kstep;
            const unsigned a3 = a2 + kstep; const unsigned b3 = b2 + kstep;
            if (last && has_next) S.a_ready(nxt);
            if constexpr (epi_has_mid<Epi>::v) { if (t == (nt >> 1)) { int t_ = threadIdx.x; asm volatile("" : "+v"(t_)); const int l_ = t_ & 63, w_ = __builtin_amdgcn_readfirstlane(t_ >> 6); E.mid(acc, cur, w_ >> 2, w_ & 3, l_ & 15, l_ >> 4); } }
            unsigned svA[2][2] = {{cvA[0][0], cvA[0][1]}, {cvA[1][0], cvA[1][1]}};
            if constexpr (GATHER) { if (last) { int t_ = threadIdx.x; asm volatile("" : "+v"(t_)); const u32x4 pv_ = *(const PG8_LAS u32x4*)(S.park + t_ * 4); svA[0][0] = pv_.x; svA[0][1] = pv_.y; svA[1][0] = pv_.z; svA[1][1] = pv_.w; } }
            if constexpr (SP2) {
            PG8_LDB(B0, 0, 0); PG8_LDB(B1, 0, 1); PG8_SCHED; PG8_LDA(At, 0, 0); PG8_STAGE_A(PG8_SA(1, 1), a1, 1, false);
            PG8_WAIT_V(8); PG8_WAIT_L(0); PG8_BAR; PG8_MMA(0, 0, At, B0); PG8_MMA(0, 1, At, B1); PG8_BAR; PG8_SCHED;
            PG8_LDA(At, 0, 1); PG8_STAGE1(PG8_SB(0, 0), b2, voffB[0]); PG8_STAGE1(PG8_SB(0, 1), b2 + hstep, voffB[0]); PG8_STAGE_A(PG8_SA(0, 0), a2, 0, last);
            PG8_WAIT_V(8); PG8_WAIT_L(0); PG8_BAR; PG8_MMA(1, 0, At, B0); PG8_MMA(1, 1, At, B1); PG8_BAR; PG8_SCHED;
            PG8_LDB(B0, 1, 0); PG8_LDB(B1, 1, 1); PG8_SCHED; PG8_LDA(At, 1, 0); PG8_STAGE_A(PG8_SA(0, 1), a2, 1, last);
            PG8_WAIT_V(8); PG8_WAIT_L(0); PG8_BAR; PG8_MMA(0, 0, At, B0); PG8_MMA(0, 1, At, B1); PG8_BAR; PG8_SCHED;
            PG8_LDA(At, 1, 1); PG8_STAGE1(PG8_SB(1, 0), b3, voffB[0]); PG8_STAGE1(PG8_SB(1, 1), b3 + hstep, voffB[0]); PG8_STAGE_A(PG8_SA(1, 0), a3, 0, last);
            PG8_WAIT_V(8); PG8_WAIT_L(0); PG8_BAR; PG8_MMA(1, 0, At, B0); PG8_MMA(1, 1, At, B1); PG8_BAR; PG8_SCHED;
            } else {
            PG8_LDB(B0, 0, 0); PG8_SCHED; PG8_LDA(At, 0, 0); PG8_STAGE(PG8_SA(1, 1), a1 + hstep, voffA);
            PG8_WAIT_L(8); PG8_BAR; PG8_WAIT_L(0); PG8_MMA(0, 0, At, B0); PG8_BAR; PG8_SCHED;
            PG8_LDB(B1, 0, 1); PG8_STAGE1(PG8_SB(0, 0), b2, voffB[0]);
            PG8_BAR; PG8_WAIT_L(0); PG8_MMA(0, 1, At, B1); PG8_BAR;
            PG8_LDA(At, 0, 1); PG8_STAGE(PG8_SA(0, 0), a2, voffA);
            PG8_BAR; PG8_WAIT_L(0); PG8_MMA(1, 0, At, B0); PG8_BAR; PG8_SCHED;
            PG8_STAGE1(PG8_SB(0, 1), b2 + hstep, voffB[0]);
            PG8_WAIT_V(6); PG8_BAR; PG8_MMA(1, 1, At, B1); PG8_BAR;
            PG8_LDB(B0, 1, 0); PG8_SCHED; PG8_LDA(At, 1, 0); PG8_STAGE(PG8_SA(0, 1), a2 + hstep, voffA);
            PG8_WAIT_L(8); PG8_BAR; PG8_WAIT_L(0); PG8_MMA(0, 0, At, B0); PG8_BAR; PG8_SCHED;
            PG8_LDB(B1, 1, 1); PG8_STAGE1(PG8_SB(1, 0), b3, voffB[0]);
            PG8_BAR; PG8_WAIT_L(0); PG8_MMA(0, 1, At, B1); PG8_BAR;
            PG8_LDA(At, 1, 1); PG8_STAGE(PG8_SA(1, 0), a3, voffA);
            PG8_BAR; PG8_WAIT_L(0); PG8_MMA(1, 0, At, B0); PG8_BAR; PG8_SCHED;
            PG8_STAGE1(PG8_SB(1, 1), b3 + hstep, voffB[0]);
            PG8_WAIT_V(6); PG8_BAR; PG8_MMA(1, 1, At, B1); PG8_BAR;
            }
        }
        Unit nn2; bool has_nn = false; unsigned tv2[2][2] = {{0u, 0u}, {0u, 0u}};
        if constexpr (GATHER) { has_nn = has_next && S.next(ui + 2, nn2); if (has_nn) PG8_GOFF(tv2, nn2); }
        if constexpr (ALIGN_EPI) { if (wr == 0) PG8_BAR; }
        if constexpr (!Epi::AFTER_DRAIN) { int t_ = threadIdx.x; asm volatile("" : "+v"(t_));
            const int l_ = t_ & 63, w_ = __builtin_amdgcn_readfirstlane(t_ >> 6); E(acc, cur, w_ >> 2, w_ & 3, l_ & 15, l_ >> 4); S.done(cur); }
        if (!has_next) break;
#pragma unroll
        for (int a = 0; a < 2; ++a)
#pragma unroll
            for (int b = 0; b < 2; ++b)
#pragma unroll
                for (int m = 0; m < 4; ++m)
#pragma unroll
                    for (int n = 0; n < 2; ++n) acc[a][b][m][n] = (f32x4){0.f, 0.f, 0.f, 0.f};
        cur = nxt; cA = nA; cB = nB; ++ui;
        if constexpr (GATHER) { int t_ = threadIdx.x; asm volatile("" : "+v"(t_)); const u32x4 pv_ = *(const PG8_LAS u32x4*)(S.park + t_ * 4); cvA[0][0] = pv_.x; cvA[0][1] = pv_.y; cvA[1][0] = pv_.z; cvA[1][1] = pv_.w;
            *(PG8_LAS u32x4*)(S.park + t_ * 4) = has_nn ? (u32x4){tv2[0][0], tv2[0][1], tv2[1][0], tv2[1][1]} : pv_; }
        if constexpr (ALIGN_EPI) { if (wr == 1) PG8_BAR; }
    }
    PG8_WAIT_V(0);
    if constexpr (!ALIGN_EPI) { if (wr == 0) PG8_BAR; }
    PG8_BAR;
    if constexpr (Epi::AFTER_DRAIN) { E.fused(acc, cur, wr, wc, fr, fq, lds, wid, lane); S.done(cur); }
#undef PG8_SA
#undef PG8_SB
#undef PG8_STAGE
#undef PG8_STAGE_A
#undef PG8_GOFF
#undef PG8_LDA
#undef PG8_LDB
#undef PG8_MMA
#undef PG8_WAIT_V
#undef PG8_WAIT_L
#undef PG8_BAR
#undef PG8_SCHED
}
}

constexpr int NWAVES = 8;
constexpr int BATCH = 4, SEQ = 4096, DM = 2048, T = BATCH * SEQ;
constexpr int NCOLS = 11272, NPROJ = 11264, NPROJ16 = 1024 * PJ16.n, NPROJ8 = 4096 + 1024 * PJ8.n, GATE_COL0 = 7176;
constexpr int NH = 8, HD = 128, MW = NH * HD;
constexpr int NEXP = 32, NGRP = 4, EPG = 8, DFF = 1024;
constexpr int MAXBLK = 160, MAXROWS = MAXBLK * 256;
constexpr float EPS = 1e-6f;
constexpr float ATT_SCALE = 0.08838834764831845f;

constexpr size_t MiB = 1u << 20, KiB = 1u << 10;
constexpr size_t WS_CTL = 0, CTL_ZERO_BYTES = 128 * KiB;
constexpr size_t WS_RSTD1 = 1 * MiB, WS_LOGF = WS_RSTD1 + 64 * KiB, WS_CUM = WS_LOGF + 512 * KiB, WS_RSTD2 = WS_CUM + 512 * KiB,
                 WS_AE = WS_RSTD2 + 64 * KiB, WS_ASLOT = WS_AE + 128 * KiB, WS_AW = WS_ASLOT + 128 * KiB, WS_TOKROW = WS_AW + 128 * KiB, WS_ROWSCALE = WS_TOKROW + 128 * KiB;
static_assert(WS_ROWSCALE + MAXROWS * 4 <= 4 * MiB, "small arrays");
constexpr size_t WS_DEC = 5 * MiB;
constexpr size_t WS_TLIST = 6 * MiB, WS_SLOTRS = 8 * MiB;
constexpr size_t WS_WR = 4 * MiB;
constexpr size_t WS_WIN = 16 * MiB, WS_PAB = 60 * MiB, WS_WOUT = 68 * MiB, WS_W13 = 76 * MiB, WS_W2 = 204 * MiB, WS_ARENA = 268 * MiB;
constexpr size_t AR(size_t m) { return WS_ARENA + m * MiB; }
constexpr size_t WS_GT = AR(0);
constexpr size_t WS_HG = AR(128);
constexpr size_t WS_QKV = AR(256);
constexpr size_t WS_OAB = AR(512);
constexpr size_t WS_U = AR(384), WS_S = AR(448);
constexpr size_t WS_X8 = AR(448);
constexpr size_t WS_WIN8 = AR(480);
constexpr size_t WS_XB = AR(576);
constexpr size_t WS_OBF = AR(384);
constexpr size_t WS_MRG = AR(384);
constexpr size_t WS_X1B = AR(0);
constexpr size_t WS_X1F8 = AR(64);
constexpr size_t WS_XBUF = AR(64);
constexpr size_t WS_HBUF = AR(224);
constexpr size_t WS_YBUF = AR(304);
constexpr size_t WS_END = AR(640);
static_assert(WS_END <= 1024 * MiB, "d_ws map");
constexpr int CW_TMO = 0, CW_CODE = 1, CW_BAR = 4096, CW_CNT = 16384, CW_NRM = 16512, CW_QUEUE = 16832, CW_CONVQ = 16896, CW_P1STOP = 16960, CW_HB = 17408, CW_SCAN = 28672;

constexpr int RING_OFF = 0, RING_BYTES = 131072;
constexpr int LDSCTL_OFF = RING_BYTES, MISC_OFF = LDSCTL_OFF + 320;
constexpr int MOE_TAB_OFF = MISC_OFF + 128;
constexpr int PARK_OFF = MOE_TAB_OFF + 1024;
constexpr int LDS_BYTES = 147456;
static_assert(PARK_OFF % 16 == 0 && PARK_OFF + 8192 <= LDS_BYTES, "LDS map");
static_assert(MOE_TAB_OFF + (33 + 1 + 160 + 32) * 4 <= LDS_BYTES, "LDS map");

#define GAS __attribute__((address_space(1)))
#define LAS __attribute__((address_space(3)))
typedef unsigned short bf16;
#if P5_F8
typedef unsigned char OAB_t;
#else
typedef unsigned short OAB_t;
#endif
typedef unsigned v4u __attribute__((ext_vector_type(4)));
typedef unsigned v2u __attribute__((ext_vector_type(2)));
typedef float f32x4 __attribute__((ext_vector_type(4)));
typedef float f32x2v __attribute__((ext_vector_type(2)));
typedef short bf16x8 __attribute__((ext_vector_type(8)));
typedef GAS unsigned gu32;
#define RLX_AGENT __ATOMIC_RELAXED, __HIP_MEMORY_SCOPE_AGENT
#define LDS_WAIT() asm volatile("s_waitcnt lgkmcnt(0)" ::: "memory")
#define VM_WAIT() asm volatile("s_waitcnt vmcnt(0)" ::: "memory")
__device__ __forceinline__ float bflo(unsigned u) { return __uint_as_float(u << 16); }
__device__ __forceinline__ float bfhi(unsigned u) { return __uint_as_float(u & 0xffff0000u); }
__device__ __forceinline__ float bf1(bf16 h) { return __uint_as_float((unsigned)h << 16); }
__device__ __forceinline__ unsigned pk2(float lo, float hi) { unsigned r; asm volatile("v_cvt_pk_bf16_f32 %0, %1, %2" : "=v"(r) : "v"(lo), "v"(hi)); return r; }
__device__ __forceinline__ float sigm(float x) { return 1.0f / (1.0f + __expf(-x)); }
template <int CTRL> __device__ __forceinline__ float dpp_f(float v) { return __builtin_bit_cast(float, __builtin_amdgcn_update_dpp(0, __builtin_bit_cast(int, v), CTRL, 0xF, 0xF, true)); }
__device__ __forceinline__ float wave_sum(float v) {
    v += dpp_f<0xB1>(v); v += dpp_f<0x4E>(v); v += dpp_f<0x141>(v); v += dpp_f<0x140>(v);
    v += __shfl_xor(v, 16); v += __shfl_xor(v, 32);
    return v;
}
template <int CTRL> __device__ __forceinline__ int dpp_i(int v) { return __builtin_amdgcn_update_dpp(0, v, CTRL, 0xF, 0xF, true); }
__device__ __forceinline__ int wave_isum(int v) { v += dpp_i<0xB1>(v); v += dpp_i<0x4E>(v); v += dpp_i<0x141>(v); v += dpp_i<0x140>(v); v += __shfl_xor(v, 16); v += __shfl_xor(v, 32); return v; }
__device__ __forceinline__ float wave_fmax(float v) { v = fmaxf(v, dpp_f<0xB1>(v)); v = fmaxf(v, dpp_f<0x4E>(v)); v = fmaxf(v, dpp_f<0x141>(v)); v = fmaxf(v, dpp_f<0x140>(v)); v = fmaxf(v, __shfl_xor(v, 16)); v = fmaxf(v, __shfl_xor(v, 32)); return v; }
#define XB_TMO      128
#define XB_XCNT(j)  (256  + 64 * (j))
#define XB_XSUB(j)  (1280 + 64 * (j))
#define XB_XGEN(j)  (2304 + 64 * (j))
#define XB_TOP      3328
#define XB_TOPGEN   3392
#define XCD_BAR_WORDS 3456
#define XB_SPIN_CAP (1u << 18)

__device__ __forceinline__ unsigned xb_ld(unsigned* p)              { return __hip_atomic_load(p, __ATOMIC_RELAXED, __HIP_MEMORY_SCOPE_AGENT); }
__device__ __forceinline__ unsigned xb_add(unsigned* p, unsigned v) { return __hip_atomic_fetch_add(p, v, __ATOMIC_RELAXED, __HIP_MEMORY_SCOPE_AGENT); }
__device__ __forceinline__ unsigned xb_xcc_id() { return (unsigned)__builtin_amdgcn_s_getreg((3 << 11) | 20) & 0xFu; }
#define XB_SPIN(cond, bar) do { unsigned _sp = 0; while (cond) { __builtin_amdgcn_s_sleep(1); \
    if ((++_sp & 255u) == 0u) { if (xb_ld(&(bar)[XB_TMO])) break; if (_sp > XB_SPIN_CAP) { atomicAdd(&(bar)[XB_TMO], 1u); break; } } } } while (0)

struct XcdBarrier {
    unsigned* bar; unsigned x;
    volatile LAS unsigned* st;
};

__device__ __forceinline__ XcdBarrier xcd_barrier_post(unsigned* bar, volatile LAS unsigned* st) {
    XcdBarrier b; b.bar = bar; b.x = xb_xcc_id(); b.st = st;
    if (threadIdx.x == 0) (void)xb_add(&bar[XB_XCNT(b.x)], 1u);
    return b;
}
__device__ __forceinline__ void xcd_barrier_complete(unsigned* bar, unsigned x, unsigned& nloc, unsigned& nx) {
    const unsigned G = gridDim.x * gridDim.y * gridDim.z;
    unsigned sum, cnt, mine, sp = 0u;
    for (;;) {
        sum = 0u; cnt = 0u; mine = 0u;
#pragma unroll
        for (unsigned j = 0; j < 16; ++j) { const unsigned c = xb_ld(&bar[XB_XCNT(j)]); sum += c; cnt += (c > 0u) ? 1u : 0u; mine = (j == x) ? c : mine; }
        if (sum == G) break;
        __builtin_amdgcn_s_sleep(1);
        if ((++sp & 255u) == 0u) { if (xb_ld(&bar[XB_TMO])) break; if (sp > XB_SPIN_CAP) { atomicAdd(&bar[XB_TMO], 1u); break; } }
    }
    nloc = mine > 0u ? mine : 1u; nx = cnt > 0u ? cnt : 1u;
}

__device__ __forceinline__ void xcd_barrier(const XcdBarrier& b) {
    asm volatile("s_waitcnt vmcnt(0)" ::: "memory");
    __syncthreads();
    if (threadIdx.x == 0) {
        unsigned* bar = b.bar;
        __builtin_amdgcn_s_waitcnt(0);
        unsigned nloc = b.st[0], nx = b.st[1];
        if (nloc == 0u) { xcd_barrier_complete(bar, b.x, nloc, nx); b.st[0] = nloc; b.st[1] = nx; }
        const unsigned old = xb_add(&bar[XB_XSUB(b.x)], 1u);
        const unsigned gen = old / nloc;
        if (old + 1u == (gen + 1u) * nloc) {
            __builtin_amdgcn_fence(__ATOMIC_RELEASE, "agent");
            asm volatile("s_waitcnt vmcnt(0)" ::: "memory");
            const unsigned og = xb_add(&bar[XB_TOP], 1u);
            const unsigned tg = og / nx;
            if (og + 1u == (tg + 1u) * nx) xb_add(&bar[XB_TOPGEN], 1u);
            else XB_SPIN(xb_ld(&bar[XB_TOPGEN]) == tg, bar);
            __builtin_amdgcn_fence(__ATOMIC_ACQUIRE, "agent");
            xb_add(&bar[XB_XGEN(b.x)], 1u);
            asm volatile("s_waitcnt vmcnt(0)" ::: "memory");
        } else {
            XB_SPIN(xb_ld(&bar[XB_XGEN(b.x)]) == gen, bar);
            __builtin_amdgcn_fence(__ATOMIC_ACQUIRE, "agent");
            asm volatile("s_waitcnt vmcnt(0)" ::: "memory");
        }
    }
    __syncthreads();
}

#include <hip/hip_bf16.h>
namespace fox {
constexpr int D = 128, OSTRIDE = 2048;
constexpr float THR = 8.f;
constexpr bool WSKIP = false;
constexpr float SCALE = 0.08838834764831845f;
constexpr int NW = 8, QBLK = 32, KVBLK = 64, QB = NW * QBLK;
constexpr int SHM_V = KVBLK * D * 2, SHM_K = KVBLK * D * 2;
constexpr int ATT_LDS = 2 * SHM_V + 2 * SHM_K + NW * 64 * 4;
constexpr int LDS_CUM = ATT_LDS, LDS_KB = ATT_LDS + 16384, ATT_LDS_TOTAL = ATT_LDS + 32768;

using bf16 = __hip_bfloat16;
typedef short bf16x8 __attribute__((ext_vector_type(8)));
typedef short s16x4 __attribute__((ext_vector_type(4)));
typedef float f32x16 __attribute__((ext_vector_type(16)));
typedef float f32x4 __attribute__((ext_vector_type(4)));
typedef unsigned u32x4 __attribute__((ext_vector_type(4)));
template <class A, class Bt> struct same_t { static constexpr bool v = false; };
template <class A> struct same_t<A, A> { static constexpr bool v = true; };

#define KSWZ(row, colB) ((row) * 256 + ((colB) ^ (((row) & 7) << 4)))
#define SBAR() __builtin_amdgcn_sched_barrier(0)
__device__ __forceinline__ int v_st(int k, int c) { const int kk = (k & ~0xC) | ((k & 4) << 1) | ((k & 8) >> 1); return ((kk >> 3) * 4 + (c >> 5)) * 512 + ((kk & 7) * 32 + (c & 31)) * 2; }
__device__ __forceinline__ int v_rd_base(int lane) { return ((lane & 3) << 3) | (((lane >> 2) & 3) << 6) | (((lane >> 4) & 1) << 5) | (((lane >> 5) & 1) << 8); }
constexpr int v_rd_off(int d0, int ks, int half) { return d0 * 512 + ks * 4096 + half * 2048; }
__device__ __forceinline__ int crow(int r, int hi) { return (r & 3) + 8 * (r >> 2) + 4 * hi; }
__device__ __forceinline__ unsigned cvtpk(float lo, float hi) {
    typedef float f2_t __attribute__((ext_vector_type(2))); typedef __bf16 b2_t __attribute__((ext_vector_type(2)));
    const f2_t v = {lo, hi}; const b2_t b = __builtin_convertvector(v, b2_t); return __builtin_bit_cast(unsigned, b);
}
__device__ __forceinline__ bf16x8 pack8(f32x4 a, f32x4 b) {
    u32x4 w = {cvtpk(a[0], a[1]), cvtpk(a[2], a[3]), cvtpk(b[0], b[1]), cvtpk(b[2], b[3])};
    return *reinterpret_cast<bf16x8*>(&w);
}
template <class T> __device__ __forceinline__ bf16x8 load8(const T* p) {
    if constexpr (same_t<T, float>::v) { return pack8(*(const f32x4*)p, *(const f32x4*)(p + 4)); }
    else { return *reinterpret_cast<const bf16x8*>(p); }
}
__device__ __forceinline__ void mask_tile(f32x16& p0, f32x16& p1, int dq, unsigned W) {
    const float NEG = -__builtin_inff();
#pragma unroll
    for (int r = 0; r < 16; ++r) {
        const int c = (r & 3) + 8 * (r >> 2);
        if ((unsigned)(dq - c) >= W) p0[r] = NEG;
        if ((unsigned)(dq - c - 32) >= W) p1[r] = NEG;
    }
}
__device__ __forceinline__ void partialSM(f32x16& p0, f32x16& p1, float& m_reg, float& mn, float& alpha) {
    float pmax = p0[0]; for (int r = 1; r < 16; ++r) pmax = fmaxf(pmax, p0[r]); for (int r = 0; r < 16; ++r) pmax = fmaxf(pmax, p1[r]);
    { auto rr = __builtin_amdgcn_permlane32_swap(__float_as_uint(pmax), __float_as_uint(pmax), false, false);
      pmax = fmaxf(__uint_as_float(rr[0]), __uint_as_float(rr[1])); }
    constexpr float C2 = 1.4426950408889634f * SCALE;
    if (__builtin_expect(__all((pmax - m_reg) * SCALE <= THR), 1)) { mn = m_reg; alpha = 1.f; }
    else { mn = fmaxf(m_reg, pmax); alpha = __builtin_amdgcn_exp2f((m_reg - mn) * C2); m_reg = mn; }
    const float mnL = -mn * C2;
    for (int r = 0; r < 16; ++r) p0[r] = fmaf(p0[r], C2, mnL); for (int r = 0; r < 16; ++r) p1[r] = fmaf(p1[r], C2, mnL);
    for (int r = 0; r < 16; ++r) p0[r] = __builtin_amdgcn_exp2f(p0[r]);
}
__device__ __forceinline__ void finishSM(f32x16& p0, f32x16& p1, float alpha, float& l_reg, bf16x8& pa0, bf16x8& pa1, bf16x8& pa2, bf16x8& pa3) {
    for (int r = 0; r < 16; ++r) p1[r] = __builtin_amdgcn_exp2f(p1[r]);
    float ps = 0; for (int r = 0; r < 16; ++r) ps += p0[r]; for (int r = 0; r < 16; ++r) ps += p1[r];
    { auto rr = __builtin_amdgcn_permlane32_swap(__float_as_uint(ps), __float_as_uint(ps), false, false);
      ps = __uint_as_float(rr[0]) + __uint_as_float(rr[1]); }
    l_reg = l_reg * alpha + ps;
#define PK4(P, B_, OUT) do { unsigned a0 = cvtpk(P[B_+0], P[B_+1]), a1 = cvtpk(P[B_+2], P[B_+3]);                          \
        unsigned b0 = cvtpk(P[B_+4], P[B_+5]), b1 = cvtpk(P[B_+6], P[B_+7]);                                             \
        auto r0 = __builtin_amdgcn_permlane32_swap(a0, b0, false, false); auto r1 = __builtin_amdgcn_permlane32_swap(a1, b1, false, false); \
        u32x4 w = {r0[0], r1[0], r0[1], r1[1]}; OUT = *reinterpret_cast<bf16x8*>(&w); } while (0)
    PK4(p0, 0, pa0); PK4(p0, 8, pa1); PK4(p1, 0, pa2); PK4(p1, 8, pa3);
#undef PK4
}
template <int KB, bool SK>
__device__ __forceinline__ void qkt(f32x16& p0, f32x16& p1, const char* K_lds, int r32, int hi, const bf16x8* qr, bool act, const float* kbt  ) {
    if (SK && !act) { const float NEG = -__builtin_inff();
#pragma unroll
        for (int r = 0; r < 16; ++r) { p0[r] = NEG; p1[r] = NEG; } return; }
#pragma unroll
    for (int g = 0; g < 4; ++g) { const f32x4 a = *(const f32x4*)(kbt + 8 * g), b = *(const f32x4*)(kbt + 32 + 8 * g);
        p0[4 * g] = a[0]; p0[4 * g + 1] = a[1]; p0[4 * g + 2] = a[2]; p0[4 * g + 3] = a[3]; p1[4 * g] = b[0]; p1[4 * g + 1] = b[1]; p1[4 * g + 2] = b[2]; p1[4 * g + 3] = b[3]; }
    const char* kb[4];
#pragma unroll
    for (int dd = 0; dd < 4; ++dd) kb[dd] = K_lds + KB * SHM_K + KSWZ(r32, (dd * 16 + hi * 8) * 2);
#pragma unroll
    for (int d0 = 0; d0 < 8; ++d0) { const char* a = kb[d0 & 3] + (d0 >> 2) * 128;
        bf16x8 b0 = *reinterpret_cast<const bf16x8*>(a);
        bf16x8 b1 = *reinterpret_cast<const bf16x8*>(a + 32 * 256);
        p0 = __builtin_amdgcn_mfma_f32_32x32x16_bf16(b0, qr[d0], p0, 0, 0, 0);
        p1 = __builtin_amdgcn_mfma_f32_32x32x16_bf16(b1, qr[d0], p1, 0, 0, 0); }
}
template <int VB, bool SK>
__device__ __forceinline__ void pv_tile(f32x16* o, int vb0, bf16x8 pa0, bf16x8 pa1, bf16x8 pa2, bf16x8 pa3, bool act) {
    if (SK && !act) return;
#define TRRD(dst, off) asm volatile("ds_read_b64_tr_b16 %0, %1 offset:%2" : "=&v"(dst) : "v"(vb0), "i"(off) : "memory")
#define PV_D0(d0) do { s16x4 l0, l1, l2, l3, h0, h1, h2, h3; constexpr int b_ = VB * SHM_V + v_rd_off(d0, 0, 0);     \
        TRRD(l0, b_); TRRD(h0, b_ + 2048); TRRD(l1, b_ + 4096); TRRD(h1, b_ + 6144); TRRD(l2, b_ + 8192); TRRD(h2, b_ + 10240); TRRD(l3, b_ + 12288); TRRD(h3, b_ + 14336); \
        asm volatile("s_waitcnt lgkmcnt(0)" ::: "memory"); SBAR();                 \
        o[d0] = __builtin_amdgcn_mfma_f32_32x32x16_bf16(pa0, (bf16x8){l0[0], l0[1], l0[2], l0[3], h0[0], h0[1], h0[2], h0[3]}, o[d0], 0, 0, 0);   \
        o[d0] = __builtin_amdgcn_mfma_f32_32x32x16_bf16(pa1, (bf16x8){l1[0], l1[1], l1[2], l1[3], h1[0], h1[1], h1[2], h1[3]}, o[d0], 0, 0, 0);   \
        o[d0] = __builtin_amdgcn_mfma_f32_32x32x16_bf16(pa2, (bf16x8){l2[0], l2[1], l2[2], l2[3], h2[0], h2[1], h2[2], h2[3]}, o[d0], 0, 0, 0);   \
        o[d0] = __builtin_amdgcn_mfma_f32_32x32x16_bf16(pa3, (bf16x8){l3[0], l3[1], l3[2], l3[3], h3[0], h3[1], h3[2], h3[3]}, o[d0], 0, 0, 0); } while (0)
    PV_D0(0); PV_D0(1); PV_D0(2); PV_D0(3);
#undef PV_D0
#undef TRRD
}

template <int CTRL> __device__ __forceinline__ float dppq(float v) { return __builtin_bit_cast(float, __builtin_amdgcn_update_dpp(0, __builtin_bit_cast(int, v), CTRL, 0xF, 0xF, true)); }
template <class TIn, class TOut> struct BlockRef { unsigned Q, K, V; TOut* O; int P0; int jlo; };
typedef __amdgpu_buffer_rsrc_t rsrc_t;
#define BL8(soff, voff) __builtin_bit_cast(bf16x8, __builtin_amdgcn_raw_buffer_load_b128(rs, (int)(voff), (int)(soff), 0))
template <class TIn> struct Seam {
    bf16x8 qr[8];
    bf16x8 st_v0, st_v1, st_k0, st_k1; f32x4 sf0, sf1, sf2, sf3;
    f32x4 tq[16];
};
__device__ __forceinline__ int swa_jlo(int P0, int W) { const int lowk = P0 - W + 1; return lowk > 0 ? lowk / KVBLK : 0; }
#define ROW(p, k0, rr) ((const TIn*)((const char*)((p) + (size_t)(k0) * D) + (unsigned)(((rr) * D + sc) * (int)sizeof(TIn))))
#define VMW() asm volatile("s_waitcnt vmcnt(0)" ::: "memory")
#define VMWN(n) asm volatile("s_waitcnt vmcnt(%0)" :: "i"(n) : "memory")
#define SLOAD_H(Kp, Vp, k0) do { S.st_v0 = BL8((Vp) + (unsigned)(k0) * 256u, vo); S.st_v1 = BL8((Vp) + (unsigned)(k0) * 256u + 8192u, vo);              \
                         S.st_k0 = BL8((Kp) + (unsigned)(k0) * 256u, vo); S.st_k1 = BL8((Kp) + (unsigned)(k0) * 256u + 8192u, vo); } while (0)
#define SWRITE_HK(bf) do { *(bf16x8*)(K_lds + (bf) * SHM_K + kws) = S.st_k0; *(bf16x8*)(K_lds + (bf) * SHM_K + kws + 32 * 256) = S.st_k1; } while (0)
#define SWRITE_HV(bf) do { *(bf16x8*)(V_lds + (bf) * SHM_V + vst0) = S.st_v0; *(bf16x8*)(V_lds + (bf) * SHM_V + vst1) = S.st_v1; } while (0)
#define SWRITE_H(bf) do { SWRITE_HV(bf); SWRITE_HK(bf); } while (0)
#define SLOAD_F(p, k0) do { S.sf0 = *(const f32x4*)ROW(p, k0, sr); S.sf1 = *(const f32x4*)(ROW(p, k0, sr) + 4);                \
                            S.sf2 = *(const f32x4*)ROW(p, k0, 32 + sr); S.sf3 = *(const f32x4*)(ROW(p, k0, 32 + sr) + 4); } while (0)
#define SWRITE_KF(bf) do { *(bf16x8*)(K_lds + (bf) * SHM_K + kws) = pack8(S.sf0, S.sf1); *(bf16x8*)(K_lds + (bf) * SHM_K + kws + 32 * 256) = pack8(S.sf2, S.sf3); } while (0)
#define SWRITE_VF(bf) do { *(bf16x8*)(V_lds + (bf) * SHM_V + vst0) = pack8(S.sf0, S.sf1); *(bf16x8*)(V_lds + (bf) * SHM_V + vst1) = pack8(S.sf2, S.sf3); } while (0)
template <class TIn, class TOut>
__device__ __forceinline__ void causal_swa_prime(const rsrc_t rs, const BlockRef<TIn, TOut>& cur, int W, char* lds, Seam<TIn>& S) {
    constexpr bool F32 = false; static_assert(!same_t<TIn, float>::v, "bf16 q/k/v only in this build");
    int tid = threadIdx.x; asm volatile("" : "+v"(tid));
    const int wid = __builtin_amdgcn_readfirstlane(tid >> 6), lane = tid & 63, r32 = lane & 31, hi = lane >> 5;
    const int sr = tid >> 4, sc = (tid & 15) * 8, kws = KSWZ(sr, sc * 2), vo = (sr * D + sc) * 2; char* K_lds = lds + 2 * SHM_V;
    const int kb0 = cur.jlo * KVBLK;
    for (int d0 = 0; d0 < 8; ++d0) S.qr[d0] = BL8(cur.Q + (unsigned)(wid * QBLK * 256 + d0 * 32), (r32 * D + hi * 8) * 2);
    if constexpr (F32) { SLOAD_F((const float*)nullptr, kb0); VMW(); SWRITE_KF(0); SBAR(); SLOAD_F((const float*)nullptr, kb0); }
    else { SLOAD_H(cur.K, cur.V, kb0); VMW(); SWRITE_HK(0); }
    __syncthreads();
}
template <class TIn, class TOut>
__device__ __forceinline__ void causal_swa_block(const rsrc_t rs, const BlockRef<TIn, TOut>& cur, const BlockRef<TIn, TOut>& nxt, int skv, int W, char* lds, Seam<TIn>& S) {
    constexpr bool F32 = false; static_assert(!same_t<TIn, float>::v, "bf16 q/k/v only in this build");
    int tid = threadIdx.x; asm volatile("" : "+v"(tid));
    const int wid = __builtin_amdgcn_readfirstlane(tid >> 6), lane = tid & 63, r32 = lane & 31, hi = lane >> 5;
    const int j_lo = cur.jlo;
    int j_hi = (cur.P0 + QB - 1) / KVBLK + 1; if (j_hi > skv / KVBLK) j_hi = skv / KVBLK;
    const int NT = j_hi - j_lo;
    const int kbn = nxt.jlo * KVBLK;
    const int qlo = cur.P0 + wid * QBLK, qm = qlo + r32 - 4 * hi;
    char* V_lds = lds; char* K_lds = lds + 2 * SHM_V;
    float* ws = (float*)(lds + 2 * SHM_V + 2 * SHM_K) + wid * 64; float* li_l = ws, * al_l = ws + 32;
    const float* kbl = (const float*)(lds + LDS_KB) + 4 * hi;
    float m_reg = -1e30f, l_reg = 0; f32x16 o[4] = {};
    const int sr = tid >> 4, sc = (tid & 15) * 8, vst0 = v_st(sr, sc), vst1 = v_st(32 + sr, sc), kws = KSWZ(sr, sc * 2), vo = (sr * D + sc) * 2;
    const int vb0 = (int)(uintptr_t)V_lds + v_rd_base(lane);
    const unsigned Kh = cur.K, Vh = cur.V;
#define RESC(a) do { if (__any((a) < 1.f)) { if (hi == 0) al_l[r32] = (a); asm volatile("s_waitcnt lgkmcnt(0)" ::: "memory");              \
                     for (int d_ = 0; d_ < 4; ++d_) for (int r = 0; r < 16; ++r) o[d_][r] *= al_l[crow(r, hi)]; } } while (0)
#define KBASE(t) ((j_lo + (t)) * KVBLK)
#define ACT(t) (KBASE(t) <= qlo + QBLK - 1 && KBASE(t) + KVBLK - 1 >= qlo - W + 1)
#define MASKT(P0_, P1_, t) do { const int kb_ = KBASE(t); if ((!SK || ACT(t)) && (kb_ + KVBLK - 1 > qlo || kb_ <= qlo + QBLK - 1 - W)) mask_tile(P0_, P1_, qm - kb_, (unsigned)W); } while (0)
    constexpr int NQL = F32 ? 16 : 8;
    constexpr bool SK = WSKIP && !F32;
#define SEAM_K0() do { VMWN(NQL); if constexpr (F32) { SWRITE_KF(0); SBAR(); SLOAD_F((const float*)nullptr, kbn); } else { SWRITE_HK(0); } SBAR(); } while (0)
    f32x16 pA0, pA1, pB0, pB1; float mnA, mnB, alA, alB; bf16x8 pa0, pa1, pa2, pa3;
    if constexpr (F32) { VMW(); SWRITE_VF(0); SBAR(); } else { SWRITE_HV(0); SBAR(); }
    if (NT > 1) { if constexpr (F32) SLOAD_F((const float*)nullptr, KBASE(1)); else SLOAD_H(Kh, Vh, KBASE(1)); }
    SBAR(); qkt<0, SK>(pA0, pA1, K_lds, r32, hi, S.qr, ACT(0), kbl + KBASE(0));
    if constexpr (F32) { if (NT > 1) { VMW(); SWRITE_KF(1); SBAR(); SLOAD_F((const float*)nullptr, KBASE(1)); } }
    MASKT(pA0, pA1, 0); partialSM(pA0, pA1, m_reg, mnA, alA);
    if (NT > 1) { VMW(); if constexpr (F32) { SWRITE_VF(1); SBAR(); if (NT > 2) SLOAD_F((const float*)nullptr, KBASE(2)); } else SWRITE_H(1); }
    __syncthreads();
#define HALF_STEP(PX0, PX1, mnX, alX, PY0, PY1, alY, t, KB, VB, SB) do {                                                      \
        SBAR(); qkt<KB, SK>(PX0, PX1, K_lds, r32, hi, S.qr, ACT(t), kbl + KBASE(t));                                             \
        finishSM(PY0, PY1, alY, l_reg, pa0, pa1, pa2, pa3); SBAR();                                                           \
        if ((t) + 1 < NT) { if constexpr (F32) { VMW(); SWRITE_KF(SB); SBAR(); SLOAD_F((const float*)nullptr, KBASE((t) + 1)); }  \
                            else { SLOAD_H(Kh, Vh, KBASE((t) + 1)); } SBAR(); }                                               \
        pv_tile<VB, SK>(o, vb0, pa0, pa1, pa2, pa3, ACT((t) - 1)); MASKT(PX0, PX1, (t)); partialSM(PX0, PX1, m_reg, mnX, alX);                                        \
        __syncthreads();                                                                                                      \
        if ((t) + 1 < NT) { VMW(); if constexpr (F32) { SWRITE_VF(SB); SBAR(); if ((t) + 2 < NT) SLOAD_F((const float*)nullptr, KBASE((t) + 2)); } \
                            else { SWRITE_H(SB); } }                                                                          \
        RESC(alX); __syncthreads(); } while (0)
    for (int t = 1; t + 1 < NT; t += 2) {
        HALF_STEP(pB0, pB1, mnB, alB, pA0, pA1, alA, t, 1, 0, 0);
        HALF_STEP(pA0, pA1, mnA, alA, pB0, pB1, alB, t + 1, 0, 1, 1);
    }
    const bool even = (NT & 1) == 0;
    if (even) { SBAR(); qkt<1, SK>(pB0, pB1, K_lds, r32, hi, S.qr, ACT(NT - 1), kbl + KBASE(NT - 1)); SBAR(); }
#define QROW(e) ((const float*)nullptr + (size_t)(wid * QBLK + r32) * D + ((e) >> 1) * 16 + hi * 8 + ((e) & 1) * 4)
    if constexpr (F32) { SLOAD_F((const float*)nullptr, kbn); SBAR();
#pragma unroll
        for (int e = 0; e < 8; ++e) S.tq[e] = *(const f32x4*)QROW(e); }
    else { SLOAD_H(nxt.K, nxt.V, kbn); SBAR();
#pragma unroll
        for (int d0 = 0; d0 < 8; ++d0) S.qr[d0] = BL8(nxt.Q + (unsigned)(wid * QBLK * 256 + d0 * 32), (r32 * D + hi * 8) * 2); }
    SBAR();
    finishSM(pA0, pA1, alA, l_reg, pa0, pa1, pa2, pa3); SBAR();
    if constexpr (F32) {
#pragma unroll
        for (int e = 8; e < 16; ++e) S.tq[e] = *(const f32x4*)QROW(e); SBAR(); }
#undef QROW
    pv_tile<0, SK>(o, vb0, pa0, pa1, pa2, pa3, ACT(even ? NT - 2 : NT - 1));
    if (even) { MASKT(pB0, pB1, NT - 1); partialSM(pB0, pB1, m_reg, mnB, alB); __syncthreads(); RESC(alB);
        finishSM(pB0, pB1, alB, l_reg, pa0, pa1, pa2, pa3); SBAR(); pv_tile<1, SK>(o, vb0, pa0, pa1, pa2, pa3, ACT(NT - 1)); }
    SBAR(); SEAM_K0();
    if (hi == 0) li_l[r32] = l_reg; asm volatile("s_waitcnt lgkmcnt(0)" ::: "memory");
    float rli[16];
#pragma unroll
    for (int r = 0; r < 16; ++r) rli[r] = __builtin_amdgcn_rcpf(li_l[crow(r, hi)]);
    TOut* Ow = cur.O + (size_t)(wid * QBLK) * OSTRIDE;
#pragma unroll
    for (int r = 0; r < 16; ++r) { const int orow = crow(r, hi);
#pragma unroll
        for (int d0 = 0; d0 < 4; ++d0) { const float v = o[d0][r] * rli[r];
            if constexpr (same_t<TOut, float>::v) { Ow[(size_t)orow * OSTRIDE + d0 * 32 + r32] = v; }
            else if constexpr (same_t<TOut, unsigned char>::v) { const float v16 = 16.f * v, v1 = dppq<0xB1>(v16), v2 = dppq<0x4E>(v16), v3 = dppq<0x1B>(v16);
                   if ((r32 & 3) == 0) *(unsigned*)(Ow + (size_t)orow * OSTRIDE + d0 * 32 + r32) = pg8::pk4_fp8(v16, v1, v2, v3); }
            else { const float vn = dppq<0xB1>(v);
                   if ((r32 & 1) == 0) *(unsigned*)(Ow + (size_t)orow * OSTRIDE + d0 * 32 + r32) = cvtpk(v, vn); } } }
    if constexpr (F32) {
#pragma unroll
        for (int d0 = 0; d0 < 8; ++d0) S.qr[d0] = pack8(S.tq[2 * d0], S.tq[2 * d0 + 1]); }
    __syncthreads();
#undef RESC
#undef KBASE
#undef ACT
#undef MASKT
#undef SEAM_K0
#undef HALF_STEP
}
#undef ROW
#undef VMW
#undef VMWN
#undef SLOAD_H
#undef SWRITE_HK
#undef SWRITE_HV
#undef SWRITE_H
#undef SLOAD_F
#undef SWRITE_KF
#undef SWRITE_VF

}

struct Frame {
    LAS unsigned char* lds;
    volatile LAS unsigned* MISC;
    gu32* ctl;
    unsigned char* ws;
    int tid, lane, wave;
    int vcu, G;
    const float* const* in;
    float* out;
};

__device__ __forceinline__ void cvt_load(f32x4 (&v)[16], const float* src  , size_t ld, int rq, int nq) {
#pragma unroll
    for (int i = 0; i < 8; ++i) { const float* p = src + (size_t)(8 * i + 2 * rq) * ld + 4 * nq; v[2 * i] = __builtin_nontemporal_load((const f32x4*)p); v[2 * i + 1] = __builtin_nontemporal_load((const f32x4*)(p + ld)); }
}
__device__ __forceinline__ void cvt_store(const f32x4 (&v)[16], const f32x2v (&sc)[8], bool scaled, LAS unsigned* tile, bf16* dst  , int K, int lane, int rq, int nq) {
#pragma unroll
    for (int i = 0; i < 8; ++i) { f32x4 a = v[2 * i], b = v[2 * i + 1]; if (scaled) { a = a * sc[i].x; b = b * sc[i].y; }
#pragma unroll
        for (int j = 0; j < 4; ++j) tile[(4 * nq + j) * 33 + 4 * i + rq] = pk2(a[j], b[j]); }
    LDS_WAIT(); asm volatile("" ::: "memory");
    const int nr = lane >> 3, ch = lane & 7;
#pragma unroll
    for (int q = 0; q < 8; ++q) { const LAS unsigned* s = tile + (8 * q + nr) * 33 + 4 * ch; v4u o; o.x = s[0]; o.y = s[1]; o.z = s[2]; o.w = s[3];
        *(v4u*)(dst + (size_t)(8 * q + nr) * K + 8 * ch) = o; }
    LDS_WAIT(); asm volatile("" ::: "memory");
}
__device__ __forceinline__ void cvt_item(const float* src0, const float* src1, size_t ld_src, bf16* dst, int K, const float* scale  , LAS unsigned* tile, int lane) {
    const int rq = lane >> 4, nq = lane & 15;
    f32x2v sc[8];
    if (scale) {
#pragma unroll
        for (int i = 0; i < 8; ++i) sc[i] = *(const f32x2v*)(scale + 8 * i + 2 * rq);
    }
    f32x4 va[16], vb[16];
    cvt_load(va, src0, ld_src, rq, nq);
    cvt_load(vb, src0 + 64, ld_src, rq, nq);
    cvt_store(va, sc, scale != nullptr, tile, dst, K, lane, rq, nq);
    cvt_load(va, src1, ld_src, rq, nq);
    cvt_store(vb, sc, scale != nullptr, tile, dst + (size_t)64 * K, K, lane, rq, nq);
    cvt_load(vb, src1 + 64, ld_src, rq, nq);
    cvt_store(va, sc, scale != nullptr, tile, dst + (size_t)128 * K, K, lane, rq, nq);
    cvt_store(vb, sc, scale != nullptr, tile, dst + (size_t)192 * K, K, lane, rq, nq);
}
__device__ __forceinline__ void cvt8_load(f32x4 (&v)[16], const float* src  , size_t ld, int rq, int nq) {
#pragma unroll
    for (int i = 0; i < 4; ++i)
#pragma unroll
        for (int r = 0; r < 4; ++r) v[4 * i + r] = __builtin_nontemporal_load((const f32x4*)(src + (size_t)(16 * i + 4 * rq + r) * ld + 4 * nq));
}
__device__ __forceinline__ void cvt8_pack(const f32x4 (&v)[16], const LAS float* scl  , LAS unsigned* tile, int hh, int rq, int nq) {
#pragma unroll
    for (int i = 0; i < 4; ++i) { const f32x4 s4 = *(const LAS f32x4*)(scl + 64 * hh + 16 * i + 4 * rq);
#pragma unroll
        for (int j = 0; j < 4; ++j) tile[(4 * nq + j) * 33 + 16 * hh + 4 * i + rq] = pg8::pk4_fp8(v[4 * i][j] * s4.x, v[4 * i + 1][j] * s4.y, v[4 * i + 2][j] * s4.z, v[4 * i + 3][j] * s4.w); }
}
__device__ __forceinline__ void cvt8_flush(LAS unsigned* tile, unsigned char* dst  , int Kb, int lane, bool stream = false  ) {
    LDS_WAIT(); asm volatile("" ::: "memory");
    const int nr = lane >> 3, ch = lane & 7;
#pragma unroll
    for (int q = 0; q < 8; ++q) { const LAS unsigned* s = tile + (8 * q + nr) * 33 + 4 * ch; v4u o; o.x = s[0]; o.y = s[1]; o.z = s[2]; o.w = s[3];
        if (stream) __builtin_nontemporal_store(o, (v4u*)(dst + (size_t)(8 * q + nr) * Kb + 16 * ch)); else *(v4u*)(dst + (size_t)(8 * q + nr) * Kb + 16 * ch) = o; }
    LDS_WAIT(); asm volatile("" ::: "memory");
}
__device__ __forceinline__ void cvt8_item(const float* src0, const float* src1, size_t ld_src, unsigned char* dst, int Kb, const float* scale, LAS unsigned* tile, LAS float* scl  , int lane, int nsub  ) {
    const int rq = lane >> 4, nq = lane & 15;
    if (lane < 32) { f32x4 s4 = {256.f, 256.f, 256.f, 256.f}; if (scale) s4 = *(const f32x4*)(scale + 4 * lane) * 256.f; *(LAS f32x4*)(scl + 4 * lane) = s4; }
    LDS_WAIT(); asm volatile("" ::: "memory");
    f32x4 va[16], vb[16];
    cvt8_load(va, src0, ld_src, rq, nq); cvt8_load(vb, src0 + 64 * ld_src, ld_src, rq, nq);
#pragma unroll 1
    for (int s = 0; s + 1 < nsub; ++s) {
        const float* nsrc = (s + 1 < 2 ? src0 : src1) + 64 * ((s + 1) & 1);
        cvt8_pack(va, scl, tile, 0, rq, nq); __builtin_amdgcn_sched_barrier(0);
        cvt8_load(va, nsrc, ld_src, rq, nq); __builtin_amdgcn_sched_barrier(0);
        cvt8_pack(vb, scl, tile, 1, rq, nq); __builtin_amdgcn_sched_barrier(0);
        cvt8_load(vb, nsrc + 64 * ld_src, ld_src, rq, nq); __builtin_amdgcn_sched_barrier(0);
        cvt8_flush(tile, dst + (size_t)(64 * s) * Kb, Kb, lane, nsub == 4);
    }
    cvt8_pack(va, scl, tile, 0, rq, nq);
    cvt8_pack(vb, scl, tile, 1, rq, nq);
    cvt8_flush(tile, dst + (size_t)(64 * (nsub - 1)) * Kb, Kb, lane, nsub == 4);
}
constexpr int I_W13 = NEXP * 16 * 8, I_W2 = NEXP * 8 * 8;
__device__ __forceinline__ void cvt8_moe_item(const float* const* in, unsigned char* ws, int r, LAS unsigned* tile, LAS float* scl, int lane) {
    const float* s0; const float* s1; size_t ld; unsigned char* dst8; int K; const float* scale;
    if (r < I_W13) { const int e = r / 128, q = r % 128, kb = q / 8, nb = q % 8, k0 = 128 * kb;
        const size_t so = (size_t)e * DM * DFF + (size_t)k0 * DFF + 128 * nb;
        s0 = in[14] + so; s1 = in[15] + so; ld = DFF; dst8 = ws + WS_W13 + ((size_t)e * 2048 + 256 * nb) * DM + k0; K = DM; scale = in[9] + k0; }
    else { r -= I_W13; const int e = r / 64, q = r % 64, kb = q / 8, nb = q % 8, k0 = 128 * kb, n = 256 * nb;
        s0 = in[16] + (size_t)e * DFF * DM + (size_t)k0 * DM + n; s1 = s0 + 128; ld = DM; dst8 = ws + WS_W2 + ((size_t)e * 2048 + n) * DFF + k0; K = DFF; scale = nullptr; }
    cvt8_item(s0, s1, ld, dst8, K, scale, tile, scl, lane, 4);
}
__device__ __forceinline__ void p0_prologue(Frame& F) {
    const int gw = F.vcu * NWAVES + F.wave, NGW = F.G * NWAVES, lane = F.lane;
    const float* x = F.in[0]; const float* g1 = F.in[1]; const float* w_in = F.in[2]; const float* b_fg = F.in[3];
    LAS float* tb = (LAS float*)(F.lds + RING_OFF);
    for (int k = F.tid; k < DM; k += NWAVES * 64) { const int j = k >> 8, l = (k & 255) >> 2, i = k & 3; const float g = g1[k];
        const f32x4 a = *(const f32x4*)(w_in + (size_t)k * NCOLS + 3072), b = *(const f32x4*)(w_in + (size_t)k * NCOLS + 3076);
        LAS f32x4* d = (LAS f32x4*)(tb + ((j * 4 + i) * 64 + l) * 8); d[0] = a * g; d[1] = b * g; }
    __syncthreads();
    bf16* xb = (bf16*)(F.ws + WS_XB); float* rstd1 = (float*)(F.ws + WS_RSTD1); float* logf = (float*)(F.ws + WS_LOGF);
    for (int m = gw; m < T; m += NGW) {
        const GAS f32x4* xr = (const GAS f32x4*)(x + (size_t)m * DM) + lane;
        f32x4 v[8]; float ss = 0.f;
#pragma unroll
        for (int j = 0; j < 8; ++j) { v[j] = xr[64 * j]; ss += (v[j].x * v[j].x + v[j].y * v[j].y) + (v[j].z * v[j].z + v[j].w * v[j].w); }
        const float rstd = __builtin_amdgcn_rsqf(wave_sum(ss) * (1.0f / DM) + EPS);
        float fa[8];
#pragma unroll
        for (int h = 0; h < 8; ++h) fa[h] = 0.f;
#pragma unroll
        for (int j = 0; j < 8; ++j)
#pragma unroll
            for (int i = 0; i < 4; ++i) { const LAS f32x4* d = (const LAS f32x4*)(tb + ((j * 4 + i) * 64 + lane) * 8); const f32x4 a = d[0], b = d[1]; const float xv = v[j][i];
                fa[0] += xv * a.x; fa[1] += xv * a.y; fa[2] += xv * a.z; fa[3] += xv * a.w; fa[4] += xv * b.x; fa[5] += xv * b.y; fa[6] += xv * b.z; fa[7] += xv * b.w; }
        GAS v2u* o8 = (GAS v2u*)(xb + (size_t)m * DM) + lane; GAS unsigned* o4 = (GAS unsigned*)(F.ws + WS_X8 + (size_t)m * DM) + lane;
#pragma unroll
        for (int j = 0; j < 8; ++j) { v2u w; w.x = pk2(v[j].x, v[j].y); w.y = pk2(v[j].z, v[j].w); o8[64 * j] = w; o4[64 * j] = pg8::pk4_fp8(16.f * v[j].x, 16.f * v[j].y, 16.f * v[j].z, 16.f * v[j].w); }
        float mine = 0.f;
#pragma unroll
        for (int h = 0; h < 8; ++h) { const float s = wave_sum(fa[h]); if (lane == h) mine = s; }
        if (lane == 0) rstd1[m] = rstd;
        if (lane < 8) { const float z = mine * rstd + b_fg[lane];
            const float ez = __expf(-fabsf(z)); const float ls = fminf(z, 0.f) - (ez < 1e-4f ? ez * (1.0f - 0.5f * ez) : __logf(1.0f + ez));
            const int b = m >> 12, s = m & 4095; logf[(size_t)(b * 8 + lane) * SEQ + s] = ls; }
    }
    { bf16* wr = (bf16*)(F.ws + WS_WR); const float* g2 = F.in[9]; const float* wg = F.in[10]; const float* we = F.in[12];
      for (int idx = (F.vcu * NWAVES * 64 + F.tid); idx < 64 * DM; idx += F.G * NWAVES * 64) { const int r = idx >> 11, k = idx & 2047;
          float v = 0.f; if (r < 4) v = wg[k * 4 + r] * g2[k]; else if (r < 36) v = we[k * 32 + (r - 4)] * g2[k];
          wr[idx] = (bf16)(pk2(v, 0.f) & 0xffffu); } }
    __syncthreads();
    LAS unsigned* tile = (LAS unsigned*)(F.lds + RING_OFF) + F.wave * (64 * 33);
    constexpr int NT16 = 4 * PJ16.n, I_WIN = 32 * NT16, I_WIN8 = 16 * 16, H_X8 = 16 * 8 * PJ8.n, I_PA = P5_F8 ? 0 : 16 * 8, I_PB = P5_F8 ? 0 : 16 * 8, I_WOUT = P6_F8 ? 0 : 32 * 8;
    constexpr int H_PAB = P5_F8 ? 16 * 16 : 0, H_WOUT = P6_F8 ? 16 * 16 : 0;
    constexpr int NITEMS16 = I_WIN + I_PA + I_PB + I_WOUT;
#pragma unroll 1
    for (int it = gw; it < NITEMS16; it += NGW) {
        int r = it; const float* s0; size_t ld; bf16* dst; int K; const float* scale;
        if (r < I_WIN) { const int kb = r / NT16, nb = r % NT16, k0 = 64 * kb, n = 256 * nb, nsrc = pj_srccol(pj_kind16(nb >> 2)) + 256 * (nb & 3);
            s0 = w_in + (size_t)k0 * NCOLS + nsrc; ld = NCOLS; dst = (bf16*)(F.ws + WS_WIN) + (size_t)n * DM + k0; K = DM; scale = g1 + k0; }
        else if ((r -= I_WIN) < I_PA) { const int kb = r / 8, nb = r % 8, k0 = 64 * kb, n = 256 * nb;
            s0 = F.in[6] + (size_t)k0 * DM + n; ld = DM; dst = (bf16*)(F.ws + WS_PAB) + (size_t)n * DM + k0; K = DM; scale = nullptr; }
        else if ((r -= I_PA) < I_PB) { const int kb = r / 8, nb = r % 8, k0 = 64 * kb, n = 256 * nb;
            s0 = F.in[7] + (size_t)k0 * DM + n; ld = DM; dst = (bf16*)(F.ws + WS_PAB) + (size_t)n * DM + MW + k0; K = DM; scale = F.in[5] + k0; }
        else { r -= I_PB; const int kb = r / 8, nb = r % 8, k0 = 64 * kb, n = 256 * nb;
            s0 = F.in[8] + (size_t)k0 * DM + n; ld = DM; dst = (bf16*)(F.ws + WS_WOUT) + (size_t)n * DM + k0; K = DM; scale = nullptr; }
        cvt_item(s0, s0 + 128, ld, dst, K, scale, tile, lane);
    }
#pragma unroll 1
    for (int hi = (gw + NGW - NITEMS16 % NGW) % NGW; hi < 2 * I_WIN8 + H_X8 + H_PAB + H_WOUT; hi += NGW) {
        const float* s0; size_t ld; unsigned char* dst; const float* scale;
        if (hi < 2 * I_WIN8 + H_X8) { int kb, n, scol;
            if (hi < 2 * I_WIN8) { kb = hi / 32; const int nh = hi % 32; n = 128 * nh; scol = GATE_COL0 + (nh & 1) * DM + 128 * (nh >> 1); }
            else { const int r = hi - 2 * I_WIN8, per = 8 * PJ8.n; kb = r / (per > 0 ? per : 1); const int nh = r % (per > 0 ? per : 1); n = 4096 + 128 * nh; scol = pj_srccol(pj_kind8(nh >> 3)) + 128 * (nh & 7); }
            const int k0 = 128 * kb; s0 = w_in + (size_t)k0 * NCOLS + scol; ld = NCOLS; dst = F.ws + WS_WIN8 + (size_t)n * DM + k0; scale = g1 + k0; }
        else if (hi < 2 * I_WIN8 + H_X8 + H_PAB) { const int r = hi - (2 * I_WIN8 + H_X8), kb = r >> 4, n = 128 * (r & 15), k0 = 128 * kb;
            s0 = (kb < 8 ? F.in[6] + (size_t)k0 * DM : F.in[7] + (size_t)(k0 - MW) * DM) + n; ld = DM; dst = F.ws + WS_PAB + (size_t)n * DM + k0; scale = kb < 8 ? nullptr : F.in[5] + (k0 - MW); }
        else { const int r = hi - (2 * I_WIN8 + H_X8 + H_PAB), kb = r >> 4, n = 128 * (r & 15), k0 = 128 * kb;
            s0 = F.in[8] + (size_t)k0 * DM + n; ld = DM; dst = F.ws + WS_WOUT + (size_t)n * DM + k0; scale = nullptr; }
        cvt8_item(s0, s0, ld, dst, DM, scale, tile, (LAS float*)(F.lds + PARK_OFF) + F.wave * 128, lane, 2);
    }
}

__device__ __forceinline__ void naive_cumsum(Frame& F) {
    const float* logf = (const float*)(F.ws + WS_LOGF); float* cum = (float*)(F.ws + WS_CUM);
    LAS float* part = (LAS float*)(F.lds + RING_OFF);
    for (int bh = blockIdx.x; bh < BATCH * NH; bh += F.G) {
        const float* src = logf + (size_t)bh * SEQ + F.tid * 8; float v[8]; float s = 0.f;
#pragma unroll
        for (int i = 0; i < 8; ++i) { v[i] = src[i]; s += v[i]; v[i] = s; }
        part[F.tid] = s; __syncthreads();
        float pre = 0.f; for (int i = 0; i < F.tid; ++i) pre += part[i];
#pragma unroll
        for (int i = 0; i < 8; ++i) cum[(size_t)bh * SEQ + F.tid * 8 + i] = v[i] + pre;
        __syncthreads();
    }
}
__device__ __forceinline__ void naive_attention(Frame& F) {
    const bf16* Q = (const bf16*)(F.ws + WS_QKV); const bf16* Kt = Q + (size_t)T * MW; const bf16* V = Kt + (size_t)T * MW;
    const float* cum = (const float*)(F.ws + WS_CUM); bf16* oa = (bf16*)(F.ws + WS_OAB);
    const int qi = F.tid >> 4, part = F.tid & 15;
    for (int u = blockIdx.x; u < BATCH * NH * (SEQ / 32); u += F.G) {
        const int bh = u / (SEQ / 32), qb = u % (SEQ / 32), row = qb * 32 + qi;
        const bf16* kb = Kt + (size_t)bh * SEQ * HD + part * 8; const bf16* vb = V + (size_t)bh * SEQ * HD + part * 8;
        float q[8], o[8]; { const v4u w = *(const v4u*)(Q + ((size_t)bh * SEQ + row) * HD + part * 8);
            q[0] = bflo(w.x); q[1] = bfhi(w.x); q[2] = bflo(w.y); q[3] = bfhi(w.y); q[4] = bflo(w.z); q[5] = bfhi(w.z); q[6] = bflo(w.w); q[7] = bfhi(w.w); }
#pragma unroll
        for (int d = 0; d < 8; ++d) o[d] = 0.f;
        float m = -1e30f, l = 0.f; const float ci = cum[(size_t)bh * SEQ + row]; const float* cj = cum + (size_t)bh * SEQ;
        const int jend = qb * 32 + 32;
        for (int j0 = 0; j0 < jend; j0 += 4) {
            v4u kw[4], vw[4]; float cjv[4];
#pragma unroll
            for (int e = 0; e < 4; ++e) { kw[e] = *(const v4u*)(kb + (size_t)(j0 + e) * HD); vw[e] = *(const v4u*)(vb + (size_t)(j0 + e) * HD); cjv[e] = cj[j0 + e]; }
#pragma unroll
            for (int e = 0; e < 4; ++e) {
                float s = q[0] * bflo(kw[e].x) + q[1] * bfhi(kw[e].x) + q[2] * bflo(kw[e].y) + q[3] * bfhi(kw[e].y) + q[4] * bflo(kw[e].z) + q[5] * bfhi(kw[e].z) + q[6] * bflo(kw[e].w) + q[7] * bfhi(kw[e].w);
                s += __shfl_xor(s, 1); s += __shfl_xor(s, 2); s += __shfl_xor(s, 4); s += __shfl_xor(s, 8);
                s = s * ATT_SCALE + (ci - cjv[e]);
                if (j0 + e <= row) { const float mn = fmaxf(m, s), al = __expf(m - mn), p = __expf(s - mn); l = l * al + p; m = mn;
                    o[0] = o[0] * al + p * bflo(vw[e].x); o[1] = o[1] * al + p * bfhi(vw[e].x); o[2] = o[2] * al + p * bflo(vw[e].y); o[3] = o[3] * al + p * bfhi(vw[e].y);
                    o[4] = o[4] * al + p * bflo(vw[e].z); o[5] = o[5] * al + p * bfhi(vw[e].z); o[6] = o[6] * al + p * bflo(vw[e].w); o[7] = o[7] * al + p * bfhi(vw[e].w); }
            }
        }
        const float il = 1.0f / l; const int b = bh >> 3, h = bh & 7;
        v4u w; w.x = pk2(o[0] * il, o[1] * il); w.y = pk2(o[2] * il, o[3] * il); w.z = pk2(o[4] * il, o[5] * il); w.w = pk2(o[6] * il, o[7] * il);
        *(v4u*)(oa + ((size_t)(b * SEQ + row)) * (2 * MW) + h * HD + part * 8) = w;
    }
}
__device__ __forceinline__ void naive_hgrn(Frame& F) {
    const bf16* QB = (const bf16*)(F.ws + WS_HG); const bf16* FB = QB + (size_t)T * MW; const bf16* IB = FB + (size_t)T * MW;
    float* obf = (float*)(F.ws + WS_OBF); const float* lbl = F.in[4];
    const int gw = F.vcu * NWAVES + F.wave, NGW = F.G * NWAVES, lane = F.lane, vc = lane & 31, kh = lane >> 5;
    LAS f32x4* fq = (LAS f32x4*)(F.lds + RING_OFF + 65536) + F.wave * 64;
    for (int u = gw; u < BATCH * NH * 4; u += NGW) {
        const int bh = u >> 2, vg = u & 3, b = bh >> 3, h = bh & 7, vcol = vg * 32 + vc;
        const float lb0 = sigm(lbl[h * HD + 2 * lane] - lbl[MW + h * HD + 2 * lane]), lb1 = sigm(lbl[h * HD + 2 * lane + 1] - lbl[MW + h * HD + 2 * lane + 1]);
        float S[64];
#pragma unroll
        for (int k = 0; k < 64; ++k) S[k] = 0.f;
        const size_t base = (size_t)b * SEQ * MW + h * HD;
        unsigned fw = *(const unsigned*)(FB + base + 2 * lane), qw = *(const unsigned*)(QB + base + 2 * lane); bf16 vw = IB[base + vcol];
#pragma unroll 1
        for (int t = 0; t < SEQ; ++t) {
            const unsigned fc = fw, qc = qw; const float v = bf1(vw);
            if (t + 1 < SEQ) { const size_t nb_ = base + (size_t)(t + 1) * MW; fw = *(const unsigned*)(FB + nb_ + 2 * lane); qw = *(const unsigned*)(QB + nb_ + 2 * lane); vw = IB[nb_ + vcol]; }
            const float f0 = lb0 + (1.f - lb0) * sigm(bflo(fc)), f1 = lb1 + (1.f - lb1) * sigm(bfhi(fc));
            fq[lane] = (f32x4){f0, bflo(qc), f1, bfhi(qc)};
            LDS_WAIT(); asm volatile("" ::: "memory");
            float o = 0.f;
#pragma unroll
            for (int i = 0; i < 32; ++i) { const f32x4 w = fq[kh * 32 + i];
                S[2 * i] = w.x * S[2 * i] + (1.f - w.x) * v; o += S[2 * i] * w.y;
                S[2 * i + 1] = w.z * S[2 * i + 1] + (1.f - w.z) * v; o += S[2 * i + 1] * w.w; }
            o += __shfl_xor(o, 32);
            if (kh == 0) obf[base + (size_t)t * MW + vcol] = o;
            LDS_WAIT(); asm volatile("" ::: "memory");
        }
    }
}
__device__ __forceinline__ void naive_hgrn_norm(Frame& F) {
    const float* obf = (const float*)(F.ws + WS_OBF); const bf16* GB = (const bf16*)(F.ws + WS_HG) + (size_t)3 * T * MW; bf16* obn = (bf16*)(F.ws + WS_OAB) + MW;
    const int gw = F.vcu * NWAVES + F.wave, NGW = F.G * NWAVES, lane = F.lane;
    for (int u = gw; u < T * NH; u += NGW) {
        const size_t off = (size_t)u * HD + 2 * lane;
        const float a = obf[off], b = obf[off + 1]; const float ss = wave_sum(a * a + b * b);
        const float rs = 1.0f / sqrtf(ss * (1.0f / HD) + EPS); const unsigned gw_ = *(const unsigned*)(GB + off); const float g0 = bflo(gw_), g1 = bfhi(gw_);
        *(unsigned*)(obn + (size_t)(u >> 3) * (2 * MW) + (u & 7) * HD + 2 * lane) = pk2(a * rs * g0 * sigm(g0), b * rs * g1 * sigm(g1));
    }
}

__device__ __forceinline__ void router_phase(Frame& F) {
    const bf16* x1b = (const bf16*)(F.ws + WS_X1B); const bf16* wr = (const bf16*)(F.ws + WS_WR);
    int* tlist = (int*)(F.ws + WS_TLIST); float* slot_rs = (float*)(F.ws + WS_SLOTRS);
    float* rstd2 = (float*)(F.ws + WS_RSTD2); int* a_e = (int*)(F.ws + WS_AE); int* a_slot = (int*)(F.ws + WS_ASLOT); float* a_w = (float*)(F.ws + WS_AW);
    const float* bgp = F.in[11]; const float* bex = F.in[13];
    const int lane = F.lane, fr = lane & 15, fq = lane >> 4, sub = F.wave & 3, half = F.wave >> 2;
    LAS float* Lg = (LAS float*)(F.lds + RING_OFF) + (sub * 2 + half) * (16 * 48 + 16);
    for (int base = F.vcu * 4; base < T / 16; base += F.G * 4) {
        const int g = base + sub;
        const bf16* arow = x1b + (size_t)(g * 16 + fr) * DM + half * (DM / 2) + 8 * fq; const bf16* brow = wr + (size_t)fr * DM + half * (DM / 2) + 8 * fq;
        pg8::f32x4 acc[3]; for (int n = 0; n < 3; ++n) acc[n] = (pg8::f32x4){0.f, 0.f, 0.f, 0.f};
        float ss = 0.f;
#pragma unroll 8
        for (int k0 = 0; k0 < DM / 2; k0 += 32) {
            const v4u aw = *(const v4u*)(arow + k0);
            ss += bflo(aw.x) * bflo(aw.x) + bfhi(aw.x) * bfhi(aw.x) + bflo(aw.y) * bflo(aw.y) + bfhi(aw.y) * bfhi(aw.y) + bflo(aw.z) * bflo(aw.z) + bfhi(aw.z) * bfhi(aw.z) + bflo(aw.w) * bflo(aw.w) + bfhi(aw.w) * bfhi(aw.w);
            const bf16x8 a = __builtin_bit_cast(bf16x8, aw);
#pragma unroll
            for (int n = 0; n < 3; ++n) { const bf16x8 bfrag = *(const bf16x8*)(brow + (size_t)(n * 16) * DM + k0);
                acc[n] = __builtin_amdgcn_mfma_f32_16x16x32_bf16(a, bfrag, acc[n], 0, 0, 0); }
        }
        ss += __shfl_xor(ss, 16); ss += __shfl_xor(ss, 32);
#pragma unroll
        for (int n = 0; n < 3; ++n)
#pragma unroll
            for (int j = 0; j < 4; ++j) Lg[(4 * fq + j) * 48 + n * 16 + fr] = acc[n][j];
        if (fq == 0) Lg[16 * 48 + fr] = ss;
        __syncthreads();
        if (half == 0 && lane < 16) {
            const LAS float* l0 = Lg + lane * 48; const LAS float* l1 = l0 + (16 * 48 + 16);
            const int t = g * 16 + lane; const float r = __builtin_amdgcn_rsqf((Lg[16 * 48 + lane] + Lg[(16 * 48 + 16) + 16 * 48 + lane]) * (1.0f / DM) + EPS);
            float lg[4]; int gi = 0; float gm = -3.0e38f;
#pragma unroll
            for (int i = 0; i < 4; ++i) { lg[i] = (l0[i] + l1[i]) * r + bgp[i]; if (lg[i] > gm) { gm = lg[i]; gi = i; } }
            float gs = 0.f;
#pragma unroll
            for (int i = 0; i < 4; ++i) gs += __expf(lg[i] - gm);
            const float g_w = __builtin_amdgcn_rcpf(gs);
            float le[8]; int i1 = 0; float m1 = -3.0e38f;
#pragma unroll
            for (int i = 0; i < 8; ++i) { le[i] = (l0[4 + gi * 8 + i] + l1[4 + gi * 8 + i]) * r + bex[gi * 8 + i]; if (le[i] > m1) { m1 = le[i]; i1 = i; } }
            int i2 = 0; float m2 = -3.0e38f;
#pragma unroll
            for (int i = 0; i < 8; ++i) if (i != i1 && le[i] > m2) { m2 = le[i]; i2 = i; }
            const float p2 = __expf(m2 - m1), w1 = __builtin_amdgcn_rcpf(1.0f + p2), w2 = p2 * w1;
            const int e1 = gi * 8 + i1, e2 = gi * 8 + i2;
            const int s1 = (int)__hip_atomic_fetch_add(F.ctl + CW_CNT + e1, 1u, RLX_AGENT), s2 = (int)__hip_atomic_fetch_add(F.ctl + CW_CNT + e2, 1u, RLX_AGENT);
            a_e[2 * t] = e1; a_e[2 * t + 1] = e2; a_slot[2 * t] = s1; a_slot[2 * t + 1] = s2; a_w[2 * t] = g_w * w1; a_w[2 * t + 1] = g_w * w2; rstd2[t] = r;
            tlist[(size_t)e1 * 16384 + s1] = t; tlist[(size_t)e2 * 16384 + s2] = t; slot_rs[(size_t)e1 * 16384 + s1] = r; slot_rs[(size_t)e2 * 16384 + s2] = r;
        }
        __syncthreads();
    }
}
__device__ __forceinline__ void moe_tables(Frame& F) {
    LAS int* tab = (LAS int*)(F.lds + MOE_TAB_OFF);
    if (F.wave == 0) { const int lane = F.lane; const int e = lane & 31;
        const int c = (int)__hip_atomic_load(F.ctl + CW_CNT + e, RLX_AGENT); const int nb = (c + 255) >> 8; int incl = nb;
#pragma unroll
        for (int off = 1; off < 32; off <<= 1) { const int n = __shfl_up(incl, off, 32); if (e >= off) incl += n; }
        const int sb = incl - nb;
        if (lane < 32) { tab[e] = sb * 256; tab[194 + e] = c; for (int b = 0; b < nb; ++b) tab[34 + sb + b] = e; if (e == 31) { tab[32] = incl * 256; tab[33] = incl; } }
    }
    __syncthreads();
}
__device__ __forceinline__ void gather_phase(Frame& F) {
    LAS int* tab = (LAS int*)(F.lds + MOE_TAB_OFF);
    const bf16* x1b = (const bf16*)(F.ws + WS_X1B); bf16* xbuf = (bf16*)(F.ws + WS_XBUF);
    const float* rstd2 = (const float*)(F.ws + WS_RSTD2); const int* a_e = (const int*)(F.ws + WS_AE); const int* a_slot = (const int*)(F.ws + WS_ASLOT);
    int* tokrow = (int*)(F.ws + WS_TOKROW); float* rowscale = (float*)(F.ws + WS_ROWSCALE);
    const int gw = F.vcu * NWAVES + F.wave, NGW = F.G * NWAVES, lane = F.lane;
    for (int a = gw; a < 2 * T; a += NGW) {
        const int t = a >> 1, e = a_e[a], row = tab[e] + a_slot[a];
        const GAS v4u* src = (const GAS v4u*)(x1b + (size_t)t * DM) + lane; GAS v4u* dst = (GAS v4u*)(xbuf + (size_t)row * DM) + lane;
#pragma unroll
        for (int j = 0; j < 4; ++j) dst[64 * j] = src[64 * j];
        if (lane == 0) { tokrow[a] = row; rowscale[row] = rstd2[t]; }
    }
    for (int e = gw; e < NEXP; e += NGW) { const int c = tab[34 + 160 + e], r0 = tab[e] + c, r1 = tab[e] + ((c + 255) & ~255);
        for (int row = r0; row < r1; ++row) { GAS v4u* dst = (GAS v4u*)(xbuf + (size_t)row * DM) + lane;
#pragma unroll
            for (int j = 0; j < 4; ++j) dst[64 * j] = (v4u){0u, 0u, 0u, 0u};
            if (lane == 0) rowscale[row] = 0.f; } }
}
__device__ __forceinline__ void final_rows(const bf16* x1b, const unsigned char* ybuf, int t, int r0, int r1, int lane, v4u (&a)[4], v2u (&b)[4], v2u (&c)[4]) {
    const GAS v4u* xs = (const GAS v4u*)(x1b + (size_t)t * DM) + lane; const GAS v2u* y0 = (const GAS v2u*)(ybuf + (size_t)r0 * DM) + lane; const GAS v2u* y1 = (const GAS v2u*)(ybuf + (size_t)r1 * DM) + lane;
#pragma unroll
    for (int j = 0; j < 4; ++j) { a[j] = xs[64 * j]; b[j] = __builtin_nontemporal_load(y0 + 64 * j); c[j] = __builtin_nontemporal_load(y1 + 64 * j); }
}
typedef float f32x2q __attribute__((ext_vector_type(2)));
__device__ __forceinline__ void fp8x4_to_f32(unsigned w, float (&o)[4]) { const f32x2q lo = __builtin_amdgcn_cvt_pk_f32_fp8((int)w, false), hi = __builtin_amdgcn_cvt_pk_f32_fp8((int)w, true); o[0] = lo.x; o[1] = lo.y; o[2] = hi.x; o[3] = hi.y; }
__device__ __forceinline__ void final_token(float* out, const float* gF, int t, float w0, float w1, int lane, const v4u (&a)[4], const v2u (&b)[4], const v2u (&c)[4]) {
    float v[4][8]; float ss = 0.f;
#pragma unroll
    for (int j = 0; j < 4; ++j) {
        float y0[8], y1[8]; fp8x4_to_f32(b[j].x, *(float(*)[4])&y0[0]); fp8x4_to_f32(b[j].y, *(float(*)[4])&y0[4]); fp8x4_to_f32(c[j].x, *(float(*)[4])&y1[0]); fp8x4_to_f32(c[j].y, *(float(*)[4])&y1[4]);
        const float xx[8] = {bflo(a[j].x), bfhi(a[j].x), bflo(a[j].y), bfhi(a[j].y), bflo(a[j].z), bfhi(a[j].z), bflo(a[j].w), bfhi(a[j].w)};
#pragma unroll
        for (int i = 0; i < 8; ++i) { v[j][i] = xx[i] + w0 * y0[i] + w1 * y1[i]; ss += v[j][i] * v[j][i]; } }
    const float rs = __builtin_amdgcn_rsqf(wave_sum(ss) * (1.0f / DM) + EPS);
#pragma unroll
    for (int j = 0; j < 4; ++j) { const int c0 = 512 * j + 8 * lane; const f32x4 ga = *(const f32x4*)(gF + c0), gb = *(const f32x4*)(gF + c0 + 4);
        f32x4 o0 = {v[j][0] * rs * ga.x, v[j][1] * rs * ga.y, v[j][2] * rs * ga.z, v[j][3] * rs * ga.w}, o1 = {v[j][4] * rs * gb.x, v[j][5] * rs * gb.y, v[j][6] * rs * gb.z, v[j][7] * rs * gb.w};
        __builtin_nontemporal_store(o0, (f32x4*)(out + (size_t)t * DM + c0)); __builtin_nontemporal_store(o1, (f32x4*)(out + (size_t)t * DM + c0 + 4)); }
}
__device__ __forceinline__ void final_phase(Frame& F) {
    const bf16* x1b = (const bf16*)(F.ws + WS_X1B); const unsigned char* ybuf = F.ws + WS_YBUF;
    const int* a_e = (const int*)(F.ws + WS_AE); const int* a_slot = (const int*)(F.ws + WS_ASLOT); const LAS int* tab = (const LAS int*)(F.lds + MOE_TAB_OFF); const float* a_w = (const float*)(F.ws + WS_AW); const float* gF = F.in[17];
    const int gw = F.vcu * NWAVES + F.wave, NGW = F.G * NWAVES, lane = F.lane;
#pragma unroll 1
    for (int t = gw; t < T; t += 2 * NGW) {
        const int t2 = t + NGW; const bool has2 = t2 < T; const int tb = has2 ? t2 : t;
        const int ra0 = tab[a_e[2 * t]] + a_slot[2 * t], ra1 = tab[a_e[2 * t + 1]] + a_slot[2 * t + 1], rb0 = tab[a_e[2 * tb]] + a_slot[2 * tb], rb1 = tab[a_e[2 * tb + 1]] + a_slot[2 * tb + 1];
        const float wa0 = a_w[2 * t] * (1.0f / 32.0f), wa1 = a_w[2 * t + 1] * (1.0f / 32.0f), wb0 = a_w[2 * tb] * (1.0f / 32.0f), wb1 = a_w[2 * tb + 1] * (1.0f / 32.0f);
        v4u a[4], a2[4]; v2u b[4], c[4], b2[4], c2[4];
        final_rows(x1b, ybuf, t, ra0, ra1, lane, a, b, c); final_rows(x1b, ybuf, tb, rb0, rb1, lane, a2, b2, c2);
        final_token(F.out, gF, t, wa0, wa1, lane, a, b, c);
        if (has2) final_token(F.out, gF, t2, wb0, wb1, lane, a2, b2, c2);
    }
}
constexpr int HG_VT_STRIDE = 144, HG_QK_STRIDE = 272, HG_OL_STRIDE = 132;
typedef float f32x16 __attribute__((ext_vector_type(16)));
typedef __bf16 bf16m_t;
__device__ __forceinline__ bf16 f2bf_m(float x) { const bf16m_t b = (bf16m_t)x; return __builtin_bit_cast(bf16, b); }
__device__ __forceinline__ int crow32(int r, int hi) { return (r & 3) + 8 * (r >> 2) + 4 * hi; }
__device__ __forceinline__ float ex2(float x) { return __builtin_amdgcn_exp2f(x); }
__device__ __forceinline__ float sig2(float x) { return __builtin_amdgcn_rcpf(1.0f + __builtin_amdgcn_exp2f(-1.4426950408889634f * x)); }
__device__ __forceinline__ void hg_pre(const unsigned (&fw)[8], float lb0, float lb1, LAS float* tot, int wave, int lane, float (&bl)[8][2], float (&kk)[8][2], float (&blast)[2], float (&bmid)[2]) {
    float r0 = 0.f, r1 = 0.f;
#pragma unroll
    for (int i = 0; i < 8; ++i) { const float f0 = lb0 + (1.f - lb0) * sig2(bflo(fw[i])), f1 = lb1 + (1.f - lb1) * sig2(bfhi(fw[i]));
        kk[i][0] = 1.f - f0; kk[i][1] = 1.f - f1; r0 += __builtin_amdgcn_logf(f0); r1 += __builtin_amdgcn_logf(f1); bl[i][0] = r0; bl[i][1] = r1; }
    *(LAS f32x2v*)(tot + wave * 128 + 2 * lane) = (f32x2v){r0, r1};
    __syncthreads();
    float p0 = 0.f, p1 = 0.f, m0 = 0.f, m1 = 0.f, a0 = 0.f, a1 = 0.f;
#pragma unroll
    for (int w = 0; w < 8; ++w) { const f32x2v tv = *(const LAS f32x2v*)(tot + w * 128 + 2 * lane); if (w < wave) { p0 += tv.x; p1 += tv.y; } if (w < 4) { m0 += tv.x; m1 += tv.y; } a0 += tv.x; a1 += tv.y; }
#pragma unroll
    for (int i = 0; i < 8; ++i) { bl[i][0] += p0; bl[i][1] += p1; }
    blast[0] = a0; blast[1] = a1; bmid[0] = m0; bmid[1] = m1;
}
__device__ __forceinline__ v4u pack8col(const float (&x)[8][2], int j) { v4u o; o.x = pk2(x[0][j], x[1][j]); o.y = pk2(x[2][j], x[3][j]); o.z = pk2(x[4][j], x[5][j]); o.w = pk2(x[6][j], x[7][j]); return o; }
__device__ __forceinline__ float lb_of(const float* lbl, int idx) { return sig2(lbl[idx] - lbl[MW + idx]); }

__device__ __forceinline__ void hgrn_a1(Frame& F) {
    const bf16* FB = (const bf16*)(F.ws + WS_HG) + (size_t)T * MW; const bf16* IB = FB + (size_t)T * MW;
    bf16* UT = (bf16*)(F.ws + WS_U); float* dec = (float*)(F.ws + WS_DEC);
    LAS unsigned char* VT = F.lds + RING_OFF; LAS unsigned char* KET = VT + 128 * HG_VT_STRIDE; LAS float* tot = (LAS float*)(KET + 128 * HG_VT_STRIDE);
    const int wave = F.wave, lane = F.lane, c32 = lane & 31, hi = lane >> 5;
    unsigned fwn[8], vwn[8]; f32x2v lbn[2];
#define HG_A1_LOAD(uu) do { const int bh_ = (uu) >> 6, c_ = (uu) & 63; const size_t rb_ = ((size_t)(bh_ >> 3) * SEQ + 64 * c_) * MW + (bh_ & 7) * HD + (size_t)(8 * wave) * MW + 2 * lane; \
        lbn[0] = *(const f32x2v*)(F.in[4] + (bh_ & 7) * HD + 2 * lane); lbn[1] = *(const f32x2v*)(F.in[4] + MW + (bh_ & 7) * HD + 2 * lane); \
        _Pragma("unroll") for (int i = 0; i < 8; ++i) { fwn[i] = *(const unsigned*)(FB + rb_ + (size_t)i * MW); vwn[i] = *(const unsigned*)(IB + rb_ + (size_t)i * MW); } } while (0)
    if (F.vcu < BATCH * NH * 64) HG_A1_LOAD(F.vcu);
    for (int u = F.vcu; u < BATCH * NH * 64; u += F.G) {
        const int bh = u >> 6, c = u & 63, b = bh >> 3, h = bh & 7;
        const float lb0 = sig2(lbn[0].x - lbn[1].x), lb1 = sig2(lbn[0].y - lbn[1].y);
        unsigned vw[8], fw[8];
#pragma unroll
        for (int i = 0; i < 8; ++i) { vw[i] = vwn[i]; fw[i] = fwn[i]; }
        if (u + F.G < BATCH * NH * 64) HG_A1_LOAD(u + F.G);
        float bl[8][2], kk[8][2], blast[2], bmid[2];
        hg_pre(fw, lb0, lb1, tot, wave, lane, bl, kk, blast, bmid);
        float ke[8][2], vv[8][2];
#pragma unroll
        for (int i = 0; i < 8; ++i) { ke[i][0] = kk[i][0] * ex2(blast[0] - bl[i][0]); ke[i][1] = kk[i][1] * ex2(blast[1] - bl[i][1]); vv[i][0] = bflo(vw[i]); vv[i][1] = bfhi(vw[i]); }
#pragma unroll
        for (int j = 0; j < 2; ++j) { *(LAS v4u*)(KET + (2 * lane + j) * HG_VT_STRIDE + 16 * wave) = pack8col(ke, j); *(LAS v4u*)(VT + (2 * lane + j) * HG_VT_STRIDE + 16 * wave) = pack8col(vv, j); }
        if (wave == 0) *(f32x2v*)(dec + (size_t)u * 128 + 2 * lane) = (f32x2v){ex2(blast[0]), ex2(blast[1])};
        __syncthreads();
        const int vt = wave >> 1, kt0 = 2 * (wave & 1);
        bf16x8 a[4];
#pragma unroll
        for (int ks = 0; ks < 4; ++ks) a[ks] = *(const LAS bf16x8*)(VT + (32 * vt + c32) * HG_VT_STRIDE + (16 * ks + 8 * hi) * 2);
        LAS bf16* stg = (LAS bf16*)(F.lds + RING_OFF + 40960 + wave * 4608);
#pragma unroll
        for (int kq = 0; kq < 2; ++kq) { const int kt = kt0 + kq; f32x16 acc = {};
#pragma unroll
            for (int ks = 0; ks < 4; ++ks) { const bf16x8 bq = *(const LAS bf16x8*)(KET + (32 * kt + c32) * HG_VT_STRIDE + (16 * ks + 8 * hi) * 2); acc = __builtin_amdgcn_mfma_f32_32x32x16_bf16(a[ks], bq, acc, 0, 0, 0); }
#pragma unroll
            for (int r = 0; r < 16; ++r) stg[crow32(r, hi) * 72 + 32 * kq + c32] = f2bf_m(acc[r]); }
        LDS_WAIT(); asm volatile("" ::: "memory");
        { bf16* dst = UT + (size_t)u * 16384 + (size_t)(32 * vt) * 128 + 64 * (wave & 1); const int row = lane >> 3, ch = lane & 7;
#pragma unroll
          for (int q = 0; q < 4; ++q) { const v4u o = *(const LAS v4u*)((LAS unsigned char*)stg + (8 * q + row) * 144 + 16 * ch); *(v4u*)(dst + (size_t)(8 * q + row) * 128 + 8 * ch) = o; } }
        __syncthreads();
    }
}
__device__ __forceinline__ void hgrn_scan(Frame& F) {
    const bf16* UT = (const bf16*)(F.ws + WS_U); bf16* ST = (bf16*)(F.ws + WS_S); const float* dec = (const float*)(F.ws + WS_DEC);
    for (int g = F.vcu * NWAVES * 64 + F.tid; g < BATCH * NH * 4096; g += F.G * NWAVES * 64) {
        const int bh = g >> 12, e = g & 4095, k0 = (e * 4) & 127;
        const bf16* up = UT + (size_t)bh * 64 * 16384 + e * 4; bf16* sp = ST + (size_t)bh * 64 * 16384 + e * 4; const float* dp = dec + (size_t)bh * 64 * 128 + k0;
        float s0 = 0.f, s1 = 0.f, s2 = 0.f, s3 = 0.f;
#pragma unroll 1
        for (int c0 = 0; c0 < 64; c0 += 16) {
            v2u uw[16]; f32x4 d[16];
#pragma unroll
            for (int j = 0; j < 16; ++j) { uw[j] = *(const v2u*)(up + (size_t)(c0 + j) * 16384); d[j] = *(const f32x4*)(dp + (c0 + j) * 128); }
            __builtin_amdgcn_sched_barrier(0);
#pragma unroll
            for (int j = 0; j < 16; ++j) {
                v2u sw; sw.x = pk2(s0, s1); sw.y = pk2(s2, s3); *(v2u*)(sp + (size_t)(c0 + j) * 16384) = sw;
                s0 = d[j].x * s0 + bflo(uw[j].x); s1 = d[j].y * s1 + bfhi(uw[j].x); s2 = d[j].z * s2 + bflo(uw[j].y); s3 = d[j].w * s3 + bfhi(uw[j].y); }
        }
    }
}
__device__ __forceinline__ void hgrn_scan_item(Frame& F, int it, unsigned* cnt) {
    const bf16* UT = (const bf16*)(F.ws + WS_U); const float* dec = (const float*)(F.ws + WS_DEC);
    const __amdgpu_buffer_rsrc_t rsS = __builtin_amdgcn_make_buffer_rsrc((void*)(F.ws + WS_S), 0, 64 * 1024 * 1024, 0x00020000);
    int tid = F.tid; asm volatile("" : "+v"(tid));
    const int g = it * (NWAVES * 64) + tid, bh = g >> 12, e = g & 4095, k0 = (e * 4) & 127;
    const bf16* up = UT + (size_t)bh * 64 * 16384 + e * 4; const float* dp = dec + (size_t)bh * 64 * 128 + k0; const int sbyte = (bh * 64 * 16384 + e * 4) * 2;
    float s0 = 0.f, s1 = 0.f, s2 = 0.f, s3 = 0.f;
#pragma unroll 1
    for (int c0 = 0; c0 < 64; c0 += 16) {
        v2u uw[16]; f32x4 d[16];
#pragma unroll
        for (int j = 0; j < 16; ++j) { uw[j] = *(const v2u*)(up + (size_t)(c0 + j) * 16384); d[j] = *(const f32x4*)(dp + (c0 + j) * 128); }
        __builtin_amdgcn_sched_barrier(0);
#pragma unroll
        for (int j = 0; j < 16; ++j) {
            v2u sw; sw.x = pk2(s0, s1); sw.y = pk2(s2, s3); __builtin_amdgcn_raw_buffer_store_b64(sw, rsS, sbyte + (c0 + j) * 32768, 0, 16);
            s0 = d[j].x * s0 + bflo(uw[j].x); s1 = d[j].y * s1 + bfhi(uw[j].x); s2 = d[j].z * s2 + bflo(uw[j].y); s3 = d[j].w * s3 + bfhi(uw[j].y); }
    }
    asm volatile("s_waitcnt vmcnt(0)" ::: "memory");
    if ((tid & 63) == 0) __hip_atomic_fetch_add(cnt + 64 * bh, 1u, __ATOMIC_RELAXED, __HIP_MEMORY_SCOPE_AGENT);
}
__device__ __forceinline__ void hgrn_a2(Frame& F, int u0, int ustep, int uend) {
    const bf16* QB = (const bf16*)(F.ws + WS_HG); const bf16* FB = QB + (size_t)T * MW; const bf16* IB = FB + (size_t)T * MW; const bf16* GB = IB + (size_t)T * MW;
    const bf16* ST = (const bf16*)(F.ws + WS_S); OAB_t* obn = (OAB_t*)(F.ws + WS_OAB) + MW;
    LAS unsigned char* QE = F.lds + RING_OFF; LAS unsigned char* KD = QE + 64 * HG_QK_STRIDE; LAS unsigned char* QBL = KD + 64 * HG_QK_STRIDE; LAS unsigned char* VT = QBL + 64 * HG_QK_STRIDE;
    LAS unsigned char* AL = VT + 128 * HG_VT_STRIDE; LAS float* OL = (LAS float*)(AL + 64 * HG_VT_STRIDE); LAS float* tot = OL + 64 * HG_OL_STRIDE;
    const int wave = F.wave;
#pragma unroll 1
    for (int u = u0; u < uend; u += ustep) {
        int tid_ = F.tid; asm volatile("" : "+v"(tid_)); const int lane = tid_ & 63, c32 = lane & 31, hi = lane >> 5;
        const int bh = u >> 6, c = u & 63, b = bh >> 3, h = bh & 7; const size_t rowbase = ((size_t)b * SEQ + 64 * c) * MW + h * HD;
        const float lb0 = lb_of(F.in[4], h * HD + 2 * lane), lb1 = lb_of(F.in[4], h * HD + 2 * lane + 1);
        const int tt = wave >> 2, vt = wave & 3;
        bf16x8 st[8];
#pragma unroll
        for (int ks = 0; ks < 8; ++ks) st[ks] = *(const bf16x8*)(ST + (size_t)u * 16384 + (size_t)(32 * vt + c32) * 128 + 16 * ks + 8 * hi);
        unsigned qw[8], vw[8], gw[8], fw[8];
#pragma unroll
        for (int i = 0; i < 8; ++i) { const size_t o = rowbase + (size_t)(8 * wave + i) * MW + 2 * lane; fw[i] = *(const unsigned*)(FB + o); qw[i] = *(const unsigned*)(QB + o); vw[i] = *(const unsigned*)(IB + o); gw[i] = *(const unsigned*)(GB + o); }
        float bl[8][2], kk[8][2], blast[2], bmid[2];
        hg_pre(fw, lb0, lb1, tot, wave, lane, bl, kk, blast, bmid);
        { float vv[8][2];
#pragma unroll
          for (int i = 0; i < 8; ++i) { const int t = 8 * wave + i; const float q0 = bflo(qw[i]), q1 = bfhi(qw[i]);
              *(LAS unsigned*)(QE + t * HG_QK_STRIDE + 4 * lane) = pk2(q0 * ex2(bl[i][0] - bmid[0]), q1 * ex2(bl[i][1] - bmid[1]));
              *(LAS unsigned*)(KD + t * HG_QK_STRIDE + 4 * lane) = pk2(kk[i][0] * ex2(bmid[0] - bl[i][0]), kk[i][1] * ex2(bmid[1] - bl[i][1]));
              *(LAS unsigned*)(QBL + t * HG_QK_STRIDE + 4 * lane) = pk2(q0 * ex2(bl[i][0]), q1 * ex2(bl[i][1]));
              vv[i][0] = bflo(vw[i]); vv[i][1] = bfhi(vw[i]); }
#pragma unroll
          for (int j = 0; j < 2; ++j) *(LAS v4u*)(VT + (2 * lane + j) * HG_VT_STRIDE + 16 * wave) = pack8col(vv, j); }
        __syncthreads();
        if (wave < 3) { const int ta = wave >= 1, sa = wave == 2; f32x16 acc = {};
#pragma unroll
            for (int ks = 0; ks < 8; ++ks) { const bf16x8 a = *(const LAS bf16x8*)(QE + (32 * ta + c32) * HG_QK_STRIDE + (16 * ks + 8 * hi) * 2), bq = *(const LAS bf16x8*)(KD + (32 * sa + c32) * HG_QK_STRIDE + (16 * ks + 8 * hi) * 2);
                acc = __builtin_amdgcn_mfma_f32_32x32x16_bf16(a, bq, acc, 0, 0, 0); }
#pragma unroll
            for (int r = 0; r < 16; ++r) { const int tl = crow32(r, hi); float v = acc[r]; if (ta == sa && c32 > tl) v = 0.f;
                *(LAS bf16*)(AL + (32 * ta + tl) * HG_VT_STRIDE + (32 * sa + c32) * 2) = f2bf_m(v); }
        } else if (wave == 3) { const int row = lane >> 1, half = lane & 1; LAS v4u* p = (LAS v4u*)(AL + row * HG_VT_STRIDE + 64 + half * 32); p[0] = (v4u){0u, 0u, 0u, 0u}; p[1] = (v4u){0u, 0u, 0u, 0u}; }
        __syncthreads();
        { f32x16 acc = {};
#pragma unroll
          for (int ks = 0; ks < 4; ++ks) { const bf16x8 a = *(const LAS bf16x8*)(AL + (32 * tt + c32) * HG_VT_STRIDE + (16 * ks + 8 * hi) * 2), bq = *(const LAS bf16x8*)(VT + (32 * vt + c32) * HG_VT_STRIDE + (16 * ks + 8 * hi) * 2);
              acc = __builtin_amdgcn_mfma_f32_32x32x16_bf16(a, bq, acc, 0, 0, 0); }
#pragma unroll
          for (int ks = 0; ks < 8; ++ks) { const bf16x8 a = *(const LAS bf16x8*)(QBL + (32 * tt + c32) * HG_QK_STRIDE + (16 * ks + 8 * hi) * 2); acc = __builtin_amdgcn_mfma_f32_32x32x16_bf16(a, st[ks], acc, 0, 0, 0); }
#pragma unroll
          for (int r = 0; r < 16; ++r) OL[(32 * tt + crow32(r, hi)) * HG_OL_STRIDE + 32 * vt + c32] = acc[r]; }
        __syncthreads();
        f32x2v o2a[8]; float ssq[8];
#pragma unroll
        for (int i = 0; i < 8; ++i) { o2a[i] = *(const LAS f32x2v*)(OL + (8 * wave + i) * HG_OL_STRIDE + 2 * lane); ssq[i] = o2a[i].x * o2a[i].x + o2a[i].y * o2a[i].y; }
#pragma unroll
        for (int i = 0; i < 8; ++i) { ssq[i] += dpp_f<0xB1>(ssq[i]); ssq[i] += dpp_f<0x4E>(ssq[i]); ssq[i] += dpp_f<0x141>(ssq[i]); ssq[i] += dpp_f<0x140>(ssq[i]); }
#pragma unroll
        for (int i = 0; i < 8; ++i) ssq[i] += __shfl_xor(ssq[i], 16);
#pragma unroll
        for (int i = 0; i < 8; ++i) ssq[i] += __shfl_xor(ssq[i], 32);
#pragma unroll
        for (int i = 0; i < 8; ++i) { const int t = 8 * wave + i; const f32x2v o2 = o2a[i];
            const float rs = __builtin_amdgcn_rsqf(ssq[i] * (1.0f / HD) + EPS); const float g0 = bflo(gw[i]), g1 = bfhi(gw[i]);
            const float y0 = o2.x * rs * g0 * sig2(g0), y1 = o2.y * rs * g1 * sig2(g1);
#if P5_F8
            { const float z0 = 16.f * y0, z1 = 16.f * y1, n0 = dpp_f<0xB1>(z0), n1 = dpp_f<0xB1>(z1);
              if ((lane & 1) == 0) *(unsigned*)(obn + ((size_t)b * SEQ + 64 * c + t) * (2 * MW) + h * HD + 2 * lane) = pg8::pk4_fp8(z0, z1, n0, n1); }
#else
            *(unsigned*)(obn + ((size_t)b * SEQ + 64 * c + t) * (2 * MW) + h * HD + 2 * lane) = pk2(y0, y1);
#endif
            }
    }
}
__device__ __forceinline__ void attn_phase_fast(Frame& F, char* lds) {
    fox::bf16* O = (fox::bf16*)(F.ws + WS_OAB);
    const float* logf = (const float*)(F.ws + WS_LOGF);
    float* cumL = (float*)(lds + fox::LDS_CUM); float* kbL = (float*)(lds + fox::LDS_KB); float* wsum = (float*)(lds + 2 * fox::SHM_V + 2 * fox::SHM_K);
    const int wave = F.wave;
    fox::Seam<fox::bf16> S;
    const fox::rsrc_t rs = __builtin_amdgcn_make_buffer_rsrc((void*)(F.ws + WS_QKV), 0, (int)(3u * (unsigned)T * MW * 2u), 0x00020000);
    for (int L = F.vcu; L < BATCH * NH * 8; L += F.G) {
        const int bh = L >> 3, y = L & 7, b = bh >> 3, h = bh & 7;
        {
            int tid = F.tid; asm volatile("" : "+v"(tid)); const int lane = tid & 63;
            const float* src = logf + (size_t)bh * SEQ + tid * 8; const f32x4 a = *(const f32x4*)src, c = *(const f32x4*)(src + 4);
            float v[8] = {a.x, a.y, a.z, a.w, c.x, c.y, c.z, c.w};
#pragma unroll
            for (int i = 1; i < 8; ++i) v[i] += v[i - 1];
            const float tot = v[7]; float inc = tot;
#pragma unroll
            for (int off = 1; off < 64; off <<= 1) { const float n = __shfl_up(inc, off); if (lane >= off) inc += n; }
            if (lane == 63) wsum[wave] = inc;
            __syncthreads();
            float pre = 0.f; for (int w = 0; w < wave; ++w) pre += wsum[w];
            const float excl = inc - tot + pre;
#pragma unroll
            for (int i = 0; i < 8; ++i) cumL[tid * 8 + i] = v[i] + excl;
            __syncthreads();
        }
        const unsigned TB = (unsigned)T * MW * 2u, hb = (unsigned)bh * SEQ * HD * 2u;
        int jlo0, jlo1;
        {   const float* nq = (const float*)(F.ctl + CW_NRM) + (size_t)bh * 4; const float* nk = nq + 32 * 4;
            const float q2 = (nq[0] + nq[1]) + (nq[2] + nq[3]), k2 = (nk[0] + nk[1]) + (nk[2] + nk[3]);
            const float thrsk = 30.0f + 2.0f * 1.02f * fox::SCALE * sqrtf(q2) * sqrtf(k2);
            int tid = F.tid; asm volatile("" : "+v"(tid)); const int lane = tid & 63;
            const int P0 = y * 256, P1 = (15 - y) * 256; const float c0 = cumL[P0], c1 = cumL[P1]; int n0 = 0, n1 = 0;
#pragma unroll
            for (int i = 0; i < 8; ++i) { const int j = tid * 8 + i; const float cj = cumL[j]; n0 += (j < P0 && cj - c0 >= thrsk) ? 1 : 0; n1 += (j < P1 && cj - c1 >= thrsk) ? 1 : 0; }
#pragma unroll
            for (int o = 1; o < 64; o <<= 1) { n0 += __shfl_xor(n0, o); n1 += __shfl_xor(n1, o); }
            int* wcnt = (int*)wsum + 8;
            if (lane == 0) { wcnt[2 * wave] = n0; wcnt[2 * wave + 1] = n1; }
            __syncthreads();
            int t0 = 0, t1 = 0;
#pragma unroll
            for (int w = 0; w < 8; ++w) { t0 += wcnt[2 * w]; t1 += wcnt[2 * w + 1]; }
            jlo0 = __builtin_amdgcn_readfirstlane(t0) >> 6; jlo1 = __builtin_amdgcn_readfirstlane(t1) >> 6;
        }
        fox::BlockRef<fox::bf16, fox::bf16> cur, nxt;
        { const int P0 = y * 256; cur.Q = hb + (unsigned)P0 * 256u; cur.K = TB + hb; cur.V = 2u * TB + hb; cur.O = O + ((size_t)(b * SEQ + P0)) * (2 * MW) + h * HD; cur.P0 = P0; cur.jlo = jlo0; }
        { const int P1 = (15 - y) * 256; nxt.Q = hb + (unsigned)P1 * 256u; nxt.K = TB + hb; nxt.V = 2u * TB + hb; nxt.O = O + ((size_t)(b * SEQ + P1)) * (2 * MW) + h * HD; nxt.P0 = P1; nxt.jlo = jlo1; }
        fox::causal_swa_prime<fox::bf16, fox::bf16>(rs, cur, SEQ, lds, S);
#pragma unroll 1
        for (int pass = 0; pass < 2; ++pass) {
            {
                int tid = F.tid; asm volatile("" : "+v"(tid));
                const float cref = cumL[cur.P0]; const int j0 = tid * 8;
                if (j0 < cur.P0 + 256) {
#pragma unroll
                    for (int i = 0; i < 8; ++i) kbL[j0 + i] = (cref - cumL[j0 + i]) * (1.0f / fox::SCALE);
                }
                __syncthreads();
            }
            fox::causal_swa_block<fox::bf16, fox::bf16>(rs, cur, nxt, SEQ, SEQ, lds, S);
            cur = nxt;
        }
    }
}

constexpr int QSLOT_OFF = MISC_OFF + 64;
__device__ __forceinline__ void mixer_queue_phase(Frame& F, char* lds) {
    constexpr int NATT = BATCH * NH * 16, NCONV = (I_W13 + I_W2) / NWAVES, NMIX = NATT + NCONV, NA2 = BATCH * NH * 32, NSCAN = BATCH * NH * 8, NQ = NMIX + NA2 + NSCAN + 256;
    static_assert(NCONV * 2 == NATT * 3 && NA2 == 2 * NATT && NATT == 2 * NSCAN, "the item interleave");
    gu32* qctr = F.ctl + CW_QUEUE; volatile LAS int* qslot = (volatile LAS int*)(F.lds + QSLOT_OFF);
    OAB_t* O = (OAB_t*)(F.ws + WS_OAB);
    const float* logf = (const float*)(F.ws + WS_LOGF);
    float* cumL = (float*)(lds + fox::LDS_CUM); float* kbL = (float*)(lds + fox::LDS_KB); float* wsum = (float*)(lds + 2 * fox::SHM_V + 2 * fox::SHM_K);
    const int wave = F.wave;
    fox::Seam<fox::bf16> S;
    const fox::rsrc_t rs = __builtin_amdgcn_make_buffer_rsrc((void*)(F.ws + WS_QKV), 0, (int)(3u * (unsigned)T * MW * 2u), 0x00020000);
    int cached_bh = -1; unsigned scan_mask = 0u; bool conv_done = false;
    unsigned mine = 0u;
    if (F.tid == 0) mine = __hip_atomic_fetch_add(qctr, 1u, RLX_AGENT);
#pragma unroll 1
    for (;;) {
        { int tid = F.tid; asm volatile("" : "+v"(tid)); if (tid == 0) qslot[0] = (int)mine; }
        __syncthreads();
        const int idx = __builtin_amdgcn_readfirstlane(qslot[0]);
        __syncthreads();
        if (idx >= NQ) break;
        { int tid = F.tid; asm volatile("" : "+v"(tid)); if (tid == 0) mine = __hip_atomic_fetch_add(qctr, 1u, RLX_AGENT); }
        int kind, sub, a2u0 = 0, a2u1 = 0;
        if (idx < 4 * NSCAN) { const int per = idx >> 2, sl = idx & 3; kind = sl == 0 ? 3 : (sl == 2 ? 1 : 0); sub = sl == 0 ? per : (sl == 1 ? 2 * per : 2 * per + 1); }
        else if (idx < 4 * NSCAN + 1152) { const int r = idx - 4 * NSCAN, per = r / 3, sl = r - 3 * per; kind = sl == 0 ? 1 : 2; sub = 2 * per + (sl - 1); a2u0 = 2 * sub; a2u1 = a2u0 + 2; }
        else { const int r = idx - (4 * NSCAN + 1152), per = r / 5, sl = r - 5 * per; kind = sl == 0 ? 1 : 2; a2u0 = 1536 + 4 * per + (sl - 1); a2u1 = a2u0 + 1; sub = a2u0 >> 1; }
        if (kind == 3) { hgrn_scan_item(F, sub, (unsigned*)(F.ctl + CW_SCAN)); continue; }
        if (kind == 2) {
            const int bh2 = sub >> 5;
            if (!((scan_mask >> bh2) & 1u)) {
                int tid = F.tid; asm volatile("" : "+v"(tid));
                if (tid < 64) { unsigned polls = 0, m;
                    for (;;) { const unsigned v = (tid < 32) ? __hip_atomic_load(F.ctl + CW_SCAN + 64 * tid, RLX_AGENT) : 0u; m = (unsigned)__ballot(tid < 32 && v >= 64u);
                        if (((m >> bh2) & 1u) || ++polls > (1u << 18)) break; __builtin_amdgcn_s_sleep(8); }
                    __builtin_amdgcn_fence(__ATOMIC_ACQUIRE, "agent");
                    asm volatile("s_waitcnt vmcnt(0)" ::: "memory");
                    if (tid == 0) qslot[2] = (int)m; }
                __syncthreads(); scan_mask |= (unsigned)__builtin_amdgcn_readfirstlane(qslot[2]) | (1u << bh2); __syncthreads();
            }
            hgrn_a2(F, a2u0, 1, a2u1); cached_bh = -1; continue; }
        if (kind == 1) {
            if (conv_done) continue;
            int tid = F.tid; asm volatile("" : "+v"(tid));
            if (tid == 0) qslot[1] = (int)__hip_atomic_fetch_add(F.ctl + CW_CONVQ, 1u, RLX_AGENT);
            __syncthreads(); const int ci = __builtin_amdgcn_readfirstlane(qslot[1]); __syncthreads();
            conv_done = ci >= NCONV;
            if (ci < NCONV) cvt8_moe_item(F.in, F.ws, ci * NWAVES + wave, (LAS unsigned*)(F.lds + RING_OFF) + wave * (64 * 33), (LAS float*)(F.lds + PARK_OFF) + wave * 128, tid & 63);
            continue; }
        const int ai = sub;
        const int bh = ai & 31, qb = 15 - (ai >> 5), b = bh >> 3, h = bh & 7, P0 = qb * 256;
        if (bh != cached_bh) {
            cached_bh = bh;
            int tid = F.tid; asm volatile("" : "+v"(tid)); const int lane = tid & 63;
            const float* src = logf + (size_t)bh * SEQ + tid * 8; const f32x4 a = *(const f32x4*)src, c = *(const f32x4*)(src + 4);
            float v[8] = {a.x, a.y, a.z, a.w, c.x, c.y, c.z, c.w};
#pragma unroll
            for (int i = 1; i < 8; ++i) v[i] += v[i - 1];
            const float tot = v[7]; float inc = tot;
#pragma unroll
            for (int off = 1; off < 64; off <<= 1) { const float n = __shfl_up(inc, off); if (lane >= off) inc += n; }
            if (lane == 63) wsum[wave] = inc;
            __syncthreads();
            float pre = 0.f; for (int w = 0; w < wave; ++w) pre += wsum[w];
            const float excl = inc - tot + pre;
#pragma unroll
            for (int i = 0; i < 8; ++i) cumL[tid * 8 + i] = v[i] + excl;
            __syncthreads();
        }
        const unsigned TB = (unsigned)T * MW * 2u, hb = (unsigned)bh * SEQ * HD * 2u;
        int jlo0;
        {
            const float* nk = (const float*)(F.ctl + CW_NRM) + (size_t)(32 + bh) * 4; const float k2 = (nk[0] + nk[1]) + (nk[2] + nk[3]);
            int tid = F.tid; asm volatile("" : "+v"(tid)); const int lane = tid & 63;
            const float c0 = cumL[P0];
            float amax;
            {   const int row = tid >> 1, half = tid & 1;
                const v4u* qp = (const v4u*)(F.ws + WS_QKV + hb + (size_t)(P0 + row) * 256 + half * 128); const v4u* kp = (const v4u*)((const unsigned char*)qp + TB);
                float qq = 0.f, qk = 0.f;
#pragma unroll
                for (int i = 0; i < 8; ++i) { const v4u a = qp[i], k = kp[i];
                    qq += (bflo(a.x) * bflo(a.x) + bfhi(a.x) * bfhi(a.x)) + (bflo(a.y) * bflo(a.y) + bfhi(a.y) * bfhi(a.y)) + (bflo(a.z) * bflo(a.z) + bfhi(a.z) * bfhi(a.z)) + (bflo(a.w) * bflo(a.w) + bfhi(a.w) * bfhi(a.w));
                    qk += (bflo(a.x) * bflo(k.x) + bfhi(a.x) * bfhi(k.x)) + (bflo(a.y) * bflo(k.y) + bfhi(a.y) * bfhi(k.y)) + (bflo(a.z) * bflo(k.z) + bfhi(a.z) * bfhi(k.z)) + (bflo(a.w) * bflo(k.w) + bfhi(a.w) * bfhi(k.w)); }
                qq += dpp_f<0xB1>(qq); qk += dpp_f<0xB1>(qk);
                float a = 1.02f * fox::SCALE * __builtin_amdgcn_sqrtf(qq) * __builtin_amdgcn_sqrtf(k2) - fox::SCALE * qk + (cumL[P0 + row] - c0);
                a = wave_fmax(a);
                if (lane == 0) wsum[16 + wave] = a;
                __syncthreads();
                amax = wsum[16];
#pragma unroll
                for (int w = 1; w < 8; ++w) amax = fmaxf(amax, wsum[16 + w]);
            }
            const float thrsk = SKIP_T0 + amax;
            int n0 = 0;
#pragma unroll
            for (int i = 0; i < 8; ++i) { const int j = tid * 8 + i; n0 += (j < P0 && cumL[j] - c0 >= thrsk) ? 1 : 0; }
            n0 = wave_isum(n0);
            int* wcnt = (int*)wsum + 8;
            if (lane == 0) wcnt[wave] = n0;
            __syncthreads();
            int t0 = 0;
#pragma unroll
            for (int w = 0; w < 8; ++w) t0 += wcnt[w];
            jlo0 = __builtin_amdgcn_readfirstlane(t0) >> 6;
        }
        fox::BlockRef<fox::bf16, OAB_t> cur;
        cur.Q = hb + (unsigned)P0 * 256u; cur.K = TB + hb; cur.V = 2u * TB + hb; cur.O = O + ((size_t)(b * SEQ + P0)) * (2 * MW) + h * HD; cur.P0 = P0; cur.jlo = jlo0;
        fox::causal_swa_prime<fox::bf16, OAB_t>(rs, cur, SEQ, lds, S);
        {
            int tid = F.tid; asm volatile("" : "+v"(tid));
            const float cref = cumL[P0]; const int j0 = tid * 8;
            if (j0 < P0 + 256) {
#pragma unroll
                for (int i = 0; i < 8; ++i) kbL[j0 + i] = (cref - cumL[j0 + i]) * (1.0f / fox::SCALE);
            }
            __syncthreads();
        }
        fox::causal_swa_block<fox::bf16, OAB_t>(rs, cur, cur, SEQ, SEQ, lds, S);
    }
}

__device__ __forceinline__ void p1_converter(Frame& F) {
    constexpr int NCONV = (I_W13 + I_W2) / NWAVES; volatile LAS int* qslot = (volatile LAS int*)(F.lds + MISC_OFF + 64);
#pragma unroll 1
    for (;;) {
        int tid = F.tid; asm volatile("" : "+v"(tid));
        if (tid == 0) { const unsigned stop = __hip_atomic_load(F.ctl + CW_P1STOP, RLX_AGENT); qslot[1] = stop ? NCONV : (int)__hip_atomic_fetch_add(F.ctl + CW_CONVQ, 1u, RLX_AGENT); }
        __syncthreads(); const int ci = __builtin_amdgcn_readfirstlane(qslot[1]); __syncthreads();
        if (ci >= NCONV) break;
        cvt8_moe_item(F.in, F.ws, ci * NWAVES + F.wave, (LAS unsigned*)(F.lds + RING_OFF) + F.wave * (64 * 33), (LAS float*)(F.lds + PARK_OFF) + F.wave * 128, tid & 63);
    }
}

#ifndef MK_N_LAUNCHES
#define MK_N_LAUNCHES 1
#endif
constexpr int PER_PHASE = 12;
constexpr int N_LAUNCHES = MK_N_LAUNCHES;
static_assert(N_LAUNCHES == 1 || N_LAUNCHES == PER_PHASE, "MK_N_LAUNCHES is 1 or 12");
__device__ __forceinline__ bool fresh(Frame& F) { int t_ = threadIdx.x; asm volatile("" : "+v"(t_)); F.tid = t_; F.lane = t_ & 63; return true; }
struct Args { const float* in[18]; float* out; unsigned char* ws; int ph_lo, ph_hi, li, pad; };
__global__ void __launch_bounds__(NWAVES * 64, 2) fwd_kernel(Args args) {
    extern __shared__ __attribute__((aligned(16))) unsigned char lds[];
    Frame F;
    F.lds = (LAS unsigned char*)lds;
    F.MISC = (volatile LAS unsigned*)(F.lds + MISC_OFF);
    F.tid = threadIdx.x; F.lane = F.tid & 63; F.wave = __builtin_amdgcn_readfirstlane(F.tid >> 6);
    F.G = gridDim.x; { const int bx = blockIdx.x; F.vcu = (F.G % 8 == 0) ? (bx % 8) * (F.G / 8) + bx / 8 : bx; }
    F.ws = args.ws; F.ctl = (gu32*)(args.ws + WS_CTL); F.out = args.out;
    F.in = args.in;
    for (int u = F.tid; u < (LDS_BYTES - LDSCTL_OFF) / 4; u += NWAVES * 64) ((LAS unsigned*)(F.lds + LDSCTL_OFF))[u] = 0u;
    __syncthreads();
    XcdBarrier bar; bar.bar = (unsigned*)(F.ctl + CW_BAR); bar.x = 0; bar.st = nullptr;
    if (N_LAUNCHES != PER_PHASE) bar = xcd_barrier_post((unsigned*)(F.ctl + CW_BAR), F.MISC + 8);
#define GRID_BAR() do { if (N_LAUNCHES != PER_PHASE) xcd_barrier(bar); } while (0)
    const int lo = args.ph_lo, hi = args.ph_hi;
#ifndef PHASE_MASK
#define PHASE_MASK 0xfff
#endif
#define IN(k) (((PHASE_MASK >> (k)) & 1) && lo <= (k) && (k) < hi && fresh(F))
#ifndef DUP_MASK
#define DUP_MASK 0
#endif
#define REP(k) for (int rep_ = 0; rep_ < (((DUP_MASK >> (k)) & 1) ? 2 : 1); ++rep_)
    unsigned char* ws = args.ws;
    bf16* const HG = (bf16*)(ws + WS_HG); bf16* const GT = (bf16*)(ws + WS_GT);

    if (IN(0)) REP(0) { p0_prologue(F); GRID_BAR(); }
    if (IN(1)) REP(1) {
        const int GC = (F.G >= 128 && F.G % 8 == 0) ? P1_CONV_WGS : 0, Gg = F.G - GC;
        if ((int)blockIdx.x < Gg) {
            { pg8::Gemm g{(const bf16*)(ws + WS_XB), (const bf16*)(ws + WS_WIN), T, NPROJ16, DM, ws}; pg8::StaticOrder S; S.init(T, NPROJ16, Gg, (int)blockIdx.x);
              pg8::EpiProj E{(bf16*)(ws + WS_QKV), HG, GT, (const float*)(ws + WS_RSTD1), (unsigned*)(F.ctl + CW_NRM)};
              pg8::gemm_phase<pg8::EpiProj, pg8::StaticOrder, true, true>(F.lds + RING_OFF, g, S, E); }
            { pg8::Gemm g{(const bf16*)(ws + WS_X8), (const bf16*)(ws + WS_WIN8), T, NPROJ8, DM / 2, ws}; pg8::StaticOrderSig S; S.init_sig(T, NPROJ8, Gg, (int)blockIdx.x, (unsigned*)(F.ctl + CW_P1STOP));
              pg8::EpiProjG8 E{GT, (const float*)(ws + WS_RSTD1), (bf16*)(ws + WS_QKV), HG};
              pg8::gemm_phase<pg8::EpiProjG8, pg8::StaticOrderSig, true, true, false, true>(F.lds + RING_OFF, g, S, E); }
        } else p1_converter(F);
        GRID_BAR();
    }
    if (IN(2)) REP(2) { hgrn_a1(F); GRID_BAR(); }
    if (IN(4)) { mixer_queue_phase(F, (char*)lds); GRID_BAR(); }
    if (IN(5)) REP(5) {
        pg8::Gemm g{(const bf16*)(ws + WS_OAB), (const bf16*)(ws + WS_PAB), T, DM, P5_F8 ? DM / 2 : DM, ws}; pg8::StaticOrder S; S.init(T, DM, F.G, (int)blockIdx.x);
        typedef pg8::EpiGate2T<P5_F8 != 0, P6_F8 != 0> EG; EG E{(bf16*)(ws + WS_MRG), GT, GT + (size_t)T * DM};
        pg8::gemm_phase<EG, pg8::StaticOrder, true, true, false, P5_F8 != 0>(F.lds + RING_OFF, g, S, E);
        GRID_BAR();
    }
    if (IN(6)) REP(6) {
        pg8::Gemm g{(const bf16*)(ws + WS_MRG), (const bf16*)(ws + WS_WOUT), T, DM, P6_F8 ? DM / 2 : DM, ws}; pg8::StaticOrder S; S.init(T, DM, F.G, (int)blockIdx.x);
        typedef pg8::EpiResid8T<P6_F8 != 0> ER; ER E{(bf16*)(ws + WS_X1B), (const bf16*)(ws + WS_XB), ws + WS_X1F8};
        pg8::gemm_phase<ER, pg8::StaticOrder, true, true, false, P6_F8 != 0>(F.lds + RING_OFF, g, S, E);
        GRID_BAR();
    }
    if (IN(7)) { router_phase(F); GRID_BAR(); }
#ifdef MOE_XBUF
    if (IN(8)) REP(8) { moe_tables(F); gather_phase(F); GRID_BAR(); }
#endif
    if (IN(9)) REP(9) {
        moe_tables(F);
        const LAS int* tab = (const LAS int*)(F.lds + MOE_TAB_OFF);
#ifdef MOE_XBUF
        pg8::Gemm g{(const bf16*)(ws + WS_XBUF), (const bf16*)(ws + WS_W13), MAXROWS, 2048, DM, ws};
        pg8::MoeOrder S{tab[33], F.G, (int)blockIdx.x, 8, tab + 34};
        pg8::EpiMoe1 E{(bf16*)(ws + WS_HBUF), (const float*)(ws + WS_ROWSCALE)};
        pg8::gemm_phase<pg8::EpiMoe1, pg8::MoeOrder, true, true>(F.lds + RING_OFF, g, S, E);
#else
        pg8::Gemm g{(const bf16*)(ws + WS_X1F8), (const bf16*)(ws + WS_W13), T, 2048, DM / 2, ws};
        pg8::MoeGatherOrder S{tab[33], F.G, (int)blockIdx.x, 8, tab, (const int*)(ws + WS_TLIST), (LAS unsigned*)(F.lds + PARK_OFF), (unsigned*)(F.ctl + CW_HB), -1};
        pg8::EpiMoe1G8 E{ws + WS_HBUF, (const float*)(ws + WS_SLOTRS), tab};
        pg8::gemm_phase<pg8::EpiMoe1G8, pg8::MoeGatherOrder, true, true, true, true>(F.lds + RING_OFF, g, S, E);
        S.flush();
#endif
    }
    if (IN(10)) REP(10) {
        if (N_LAUNCHES == PER_PHASE) moe_tables(F);
        const LAS int* tab = (const LAS int*)(F.lds + MOE_TAB_OFF);
        pg8::Gemm g{(const bf16*)(ws + WS_HBUF), (const bf16*)(ws + WS_W2), MAXROWS, 2048, DFF / 2, ws};
        const int n1 = tab[33] * 8, cb = (int)blockIdx.x, i0 = cb < n1 ? (n1 - cb + F.G - 1) / F.G : 0;
        pg8::MoeCountedOrder S{tab[33], F.G, cb, i0, n1, 8, tab + 34, (const unsigned*)(F.ctl + CW_HB), (volatile LAS int*)(F.lds + QSLOT_OFF) + 3, 0u};
        pg8::EpiPlainS8 E{ws + WS_YBUF, DM, 32.0f / 2048.0f};
        pg8::gemm_phase<pg8::EpiPlainS8, pg8::MoeCountedOrder, true, true, false, true>(F.lds + RING_OFF, g, S, E);
        GRID_BAR();
    }
    if (IN(11)) REP(11) { if (N_LAUNCHES == PER_PHASE) moe_tables(F); final_phase(F); }
#undef IN
}

extern "C" void kernel_launch(void* const* d_in, const int* in_sizes, int n_in, void* d_out, int out_size, void* d_ws, size_t ws_size, hipStream_t stream) {
    static int grid = 0;
    if (grid == 0) {
        if (n_in != 18 || in_sizes[0] != T * DM || out_size != T * DM || ws_size < WS_END) { fprintf(stderr, "kernel_launch: unexpected shapes (n_in %d, in0 %d, out %d, ws %zu)\n", n_in, n_in > 0 ? in_sizes[0] : -1, out_size, ws_size); grid = -1; return; }
        int dev = 0, cus = 0, per_cu = 0;
        if (hipGetDevice(&dev) != hipSuccess || hipDeviceGetAttribute(&cus, hipDeviceAttributeMultiprocessorCount, dev) != hipSuccess) { grid = -1; return; }
        if (hipFuncSetAttribute((const void*)fwd_kernel, hipFuncAttributeMaxDynamicSharedMemorySize, LDS_BYTES) != hipSuccess) { fprintf(stderr, "kernel_launch: hipFuncSetAttribute failed\n"); grid = -1; return; }
        if (hipOccupancyMaxActiveBlocksPerMultiprocessor(&per_cu, (const void*)fwd_kernel, NWAVES * 64, LDS_BYTES) != hipSuccess || per_cu < 1) fprintf(stderr, "kernel_launch: occupancy query says %d\n", per_cu);
        (void)hipGetLastError();
        grid = cus - (cus % 8);
        if (grid <= 0) grid = 8;
    }
    if (grid < 0) return;
    if (hipMemsetAsync((char*)d_ws + WS_CTL, 0, CTL_ZERO_BYTES, stream) != hipSuccess) return;
    Args a{};
    for (int i = 0; i < 18; ++i) a.in[i] = (const float*)d_in[i];
    a.out = (float*)d_out; a.ws = (unsigned char*)d_ws;
    for (int li = 0; li < N_LAUNCHES; ++li) {
        a.ph_lo = (N_LAUNCHES == PER_PHASE) ? li : 0; a.ph_hi = (N_LAUNCHES == PER_PHASE) ? li + 1 : PER_PHASE; a.li = li; a.pad = 0;
        hipLaunchKernelGGL(fwd_kernel, dim3(grid), dim3(NWAVES * 64), LDS_BYTES, stream, a);
    }
}
```

```cpp
#include <hip/hip_runtime.h>
#include <cstdio>
#include <cstdint>
#ifndef PJ_V8
#define PJ_V8 1
#endif
#ifndef PJ_IB8
#define PJ_IB8 0
#endif
#ifndef PJ_GB8
#define PJ_GB8 0
#endif
#ifndef P5_F8
#define P5_F8 0
#endif
#ifndef P6_F8
#define P6_F8 1
#endif
#ifndef P1_CONV_WGS
#define P1_CONV_WGS 32
#endif
#ifndef SKIP_T0
#define SKIP_T0 20.0f
#endif
#ifndef GT_AUX
#define GT_AUX 0
#endif
struct PjList { int k[7]; int n; };
constexpr PjList pj_make(bool f8) { PjList r{}; r.n = 0; for (int kind = 0; kind < 7; ++kind) { const bool is8 = (kind == 2 && PJ_V8) || (kind == 5 && PJ_IB8) || (kind == 6 && PJ_GB8); if (is8 == f8) r.k[r.n++] = kind; } return r; }
constexpr PjList PJ16 = pj_make(false), PJ8 = pj_make(true);
__host__ __device__ __forceinline__ int pj_kind16(int g) { int kind = 0;
#pragma unroll
    for (int i = 0; i < PJ16.n; ++i) if (g == i) kind = PJ16.k[i];
    return kind; }
__host__ __device__ __forceinline__ int pj_kind8(int g) { int kind = 0;
#pragma unroll
    for (int i = 0; i < PJ8.n; ++i) if (g == i) kind = PJ8.k[i];
    return kind; }
__host__ __device__ __forceinline__ int pj_srccol(int kind) { return kind < 3 ? 1024 * kind : 3080 + 1024 * (kind - 3); }
namespace pg8 {
#define PG8_LAS __attribute__((address_space(3)))
typedef unsigned short bf16_t;
typedef short bf16x8 __attribute__((ext_vector_type(8)));
typedef float f32x4 __attribute__((ext_vector_type(4)));
typedef unsigned u32x4 __attribute__((ext_vector_type(4)));
typedef int v4i_t __attribute__((ext_vector_type(4)));
typedef int v8i_t __attribute__((ext_vector_type(8)));
constexpr int BM = 256, BK = 64, HALF = 128, HTB = HALF * BK * 2  , STAGE_BYTES = 8 * HTB, NXCD = 8, WGM = 8;

__host__ __device__ __forceinline__ int lds_byte(int r, int c) { const int st = (r >> 4) * 2 + (c >> 5), rr = r & 15, cc = c & 31, ob = rr * 64 + cc * 2; return st * 1024 + (ob ^ (((ob >> 9) & 1) << 5)); }
__host__ __device__ __forceinline__ void stage_rc(int b, int& R, int& C) { const int st = b / 1024, sb = b % 1024, swz = sb ^ (((sb >> 9) & 1) << 5); R = (st >> 1) * 16 + swz / 64; C = (st & 1) * 32 + (swz % 64) / 2; }
__host__ __device__ __forceinline__ int perm32(int rho) { const int n = rho >> 4, i = rho & 15; return 8 * (i >> 2) + 4 * n + (i & 3); }

struct Unit { int pm, pn, pb; };
struct Gemm { const bf16_t* A; const bf16_t* Bt; int M, N, K; const void* base; };

struct StaticOrder {
    int nM, nN, nwg, G, c;
    __host__ __device__ void init(int M, int N, int G_, int c_) { nM = M / BM; nN = N / BM; nwg = nM * nN; G = G_; c = c_; }
    __host__ __device__ bool next(int i, Unit& u) const {
        const long L = (long)i * G + c; if (L >= nwg) return false;
        int wgid = (int)L; { const int q = nwg / NXCD, r = nwg % NXCD, xcd = wgid % NXCD, off = wgid / NXCD; wgid = (xcd < r ? xcd * (q + 1) : r * (q + 1) + (xcd - r) * q) + off; }
        const int nig = WGM * nN, gid = wgid / nig, fm = gid * WGM, gsz = (nM - fm) < WGM ? (nM - fm) : WGM;
        u.pm = fm + ((wgid % nig) % gsz); u.pn = (wgid % nig) / gsz; u.pb = u.pn; return true;
    }
    __device__ __forceinline__ void a_ready(const Unit&) const {}
    __device__ __forceinline__ void done(const Unit&) const {}
};

struct StaticOrderSig : StaticOrder {
    unsigned* flag; Unit lastu;
    __device__ void init_sig(int M, int N, int G_, int c_, unsigned* flag_) { init(M, N, G_, c_); flag = flag_; const int n = (nwg - c_ + G_ - 1) / G_, nmax = (nwg + G_ - 1) / G_; lastu.pm = -1; lastu.pn = -1; lastu.pb = -1; if (n > 0 && n == nmax) next(n - 1, lastu); }
    __device__ __forceinline__ void a_ready(const Unit& u) const { if (u.pm == lastu.pm && u.pn == lastu.pn && threadIdx.x == 0) __hip_atomic_store(flag, 1u, __ATOMIC_RELAXED, __HIP_MEMORY_SCOPE_AGENT); }
};
typedef float f32x2c_t __attribute__((ext_vector_type(2))); typedef __bf16 bf16x2c_t __attribute__((ext_vector_type(2)));
__device__ __forceinline__ unsigned cvt_pk_bf16(float lo, float hi) { const f32x2c_t v = {lo, hi}; const bf16x2c_t b = __builtin_convertvector(v, bf16x2c_t); return __builtin_bit_cast(unsigned, b); }
typedef float f32x2 __attribute__((ext_vector_type(2)));

__device__ __forceinline__ float bf_lo(unsigned u) { return __uint_as_float(u << 16); }
__device__ __forceinline__ float bf_hi(unsigned u) { return __uint_as_float(u & 0xffff0000u); }
__device__ __forceinline__ float sigmoidf_(float x) { return __builtin_amdgcn_rcpf(1.0f + __builtin_amdgcn_exp2f(-1.4426950408889634f * x)); }
__device__ __forceinline__ u32x4 pack8f(const f32x4 a, const f32x4 b) { u32x4 w; w.x = cvt_pk_bf16(a[0], a[1]); w.y = cvt_pk_bf16(a[2], a[3]); w.z = cvt_pk_bf16(b[0], b[1]); w.w = cvt_pk_bf16(b[2], b[3]); return w; }
__device__ __forceinline__ void unpack8f(const u32x4 w, f32x4& a, f32x4& b) { a = (f32x4){bf_lo(w.x), bf_hi(w.x), bf_lo(w.y), bf_hi(w.y)}; b = (f32x4){bf_lo(w.z), bf_hi(w.z), bf_lo(w.w), bf_hi(w.w)}; }

struct EpiProj {
    static constexpr bool PERM = true, AFTER_DRAIN = false;
    bf16_t* qkv;
    bf16_t* hg;
    bf16_t* gt;
    const float* rstd; unsigned* nrm;
    __device__ __forceinline__ void operator()(const f32x4 (&acc)[2][2][4][2], const Unit& u, int wr, int wc, int fr, int fq) const {
        const int row0 = u.pm * BM + wr * 64 + fr; const int lanecol = wc * 32 + 8 * fq; float mx0 = 0.f, mx1 = 0.f; float ssv[2][4][2];
        bf16_t* base; size_t ld, bjoff; size_t rowbase;
        const int kind = pj_kind16(u.pn >> 2), sub = u.pn & 3;
        if (kind < 3) { const int which = kind, hp = sub, b = u.pm >> 4; base = qkv + (size_t)which * ((size_t)16384 * 1024) + ((size_t)(b * 8 + 2 * hp) * 4096) * 128; ld = 128; bjoff = (size_t)4096 * 128; rowbase = (size_t)(row0 & 4095); }
        else { base = hg + (size_t)(kind - 3) * ((size_t)16384 * 1024) + sub * 256; ld = 1024; bjoff = 128; rowbase = (size_t)row0; }
        float rsv[2][4];
#pragma unroll
        for (int ai = 0; ai < 2; ++ai)
#pragma unroll
            for (int m = 0; m < 4; ++m) rsv[ai][m] = rstd[row0 + ai * HALF + m * 16];
        __builtin_amdgcn_sched_barrier(0);
#pragma unroll
        for (int ai = 0; ai < 2; ++ai)
#pragma unroll
            for (int m = 0; m < 4; ++m) { const int r = ai * HALF + m * 16; const float rs = rsv[ai][m]; bf16_t* rowp = base + (rowbase + r) * ld + lanecol;
#pragma unroll
                for (int bj = 0; bj < 2; ++bj) { const f32x4 v0 = acc[ai][bj][m][0] * rs, v1 = acc[ai][bj][m][1] * rs; *(u32x4*)(rowp + bj * bjoff) = pack8f(v0, v1);
                    ssv[ai][m][bj] = (v0[0] * v0[0] + v0[1] * v0[1]) + (v0[2] * v0[2] + v0[3] * v0[3]) + (v1[0] * v1[0] + v1[1] * v1[1]) + (v1[2] * v1[2] + v1[3] * v1[3]); } }
        if (kind < 2) {
#pragma unroll
            for (int ai = 0; ai < 2; ++ai)
#pragma unroll
                for (int m = 0; m < 4; ++m)
#pragma unroll
                    for (int bj = 0; bj < 2; ++bj) ssv[ai][m][bj] += __shfl_xor(ssv[ai][m][bj], 16);
#pragma unroll
            for (int ai = 0; ai < 2; ++ai)
#pragma unroll
                for (int m = 0; m < 4; ++m)
#pragma unroll
                    for (int bj = 0; bj < 2; ++bj) ssv[ai][m][bj] += __shfl_xor(ssv[ai][m][bj], 32);
#pragma unroll
            for (int ai = 0; ai < 2; ++ai)
#pragma unroll
                for (int m = 0; m < 4; ++m) { mx0 = fmaxf(mx0, ssv[ai][m][0]); mx1 = fmaxf(mx1, ssv[ai][m][1]); }
#pragma unroll
            for (int o = 1; o < 16; o <<= 1) { mx0 = fmaxf(mx0, __shfl_xor(mx0, o)); mx1 = fmaxf(mx1, __shfl_xor(mx1, o)); }
            if (fr == 0 && fq == 0) { const int which = kind, hp = sub, b = u.pm >> 4; unsigned* p = nrm + ((which * 32 + b * 8 + 2 * hp) * 4 + wc);
                atomicMax(p, __float_as_uint(mx0)); atomicMax(p + 4, __float_as_uint(mx1)); } }
    }
};
__device__ __forceinline__ float clamp448(float x) { return fminf(fmaxf(x, -448.f), 448.f); }
__device__ __forceinline__ unsigned pk4_fp8(float a, float b, float c, float d) { int w = 0; w = __builtin_amdgcn_cvt_pk_fp8_f32(clamp448(a), clamp448(b), w, false); w = __builtin_amdgcn_cvt_pk_fp8_f32(clamp448(c), clamp448(d), w, true); return (unsigned)w; }
typedef unsigned u32x2 __attribute__((ext_vector_type(2)));
__device__ __forceinline__ float cl43(float x) { return fminf(fmaxf(x, -43.f), 43.f); }
struct EpiProjG8 {
    static constexpr bool PERM = true, AFTER_DRAIN = false;
    bf16_t* gt; const float* rstd; bf16_t* qkv; bf16_t* hg;
    __device__ __forceinline__ void operator()(const f32x4 (&acc)[2][2][4][2], const Unit& u, int wr, int wc, int fr, int fq) const {
        if (u.pn >= 16) {
            const int row0 = u.pm * BM + wr * 64 + fr; const int lanecol = wc * 32 + 8 * fq; const int kind = pj_kind8((u.pn - 16) >> 2), sub = u.pn & 3;
            bf16_t* base; size_t ld, bjoff; size_t rowbase;
            if (kind < 3) { const int b = u.pm >> 4; base = qkv + (size_t)kind * ((size_t)16384 * 1024) + ((size_t)(b * 8 + 2 * sub) * 4096) * 128; ld = 128; bjoff = (size_t)4096 * 128; rowbase = (size_t)(row0 & 4095); }
            else { base = hg + (size_t)(kind - 3) * ((size_t)16384 * 1024) + sub * 256; ld = 1024; bjoff = 128; rowbase = (size_t)row0; }
            float rsv[2][4];
#pragma unroll
            for (int ai = 0; ai < 2; ++ai)
#pragma unroll
                for (int m = 0; m < 4; ++m) rsv[ai][m] = rstd[row0 + ai * HALF + m * 16];
            __builtin_amdgcn_sched_barrier(0);
#pragma unroll
            for (int ai = 0; ai < 2; ++ai)
#pragma unroll
                for (int m = 0; m < 4; ++m) { const int r = ai * HALF + m * 16; const float rs = rsv[ai][m] * (1.0f / 4096.0f); bf16_t* rowp = base + (rowbase + r) * ld + lanecol;
#pragma unroll
                    for (int bj = 0; bj < 2; ++bj) *(u32x4*)(rowp + bj * bjoff) = pack8f(acc[ai][bj][m][0] * rs, acc[ai][bj][m][1] * rs); }
            return;
        }
        const __amdgpu_buffer_rsrc_t rg = __builtin_amdgcn_make_buffer_rsrc((void*)gt, 0, 16384 * 2048 * 2, 0x00020000), rg2 = __builtin_amdgcn_make_buffer_rsrc((void*)(gt + (size_t)16384 * 2048), 0, 16384 * 2048 * 2, 0x00020000);
        const __amdgpu_buffer_rsrc_t rr = __builtin_amdgcn_make_buffer_rsrc((void*)rstd, 0, 16384 * 4, 0x00020000);
        const int row0 = u.pm * BM + wr * 64 + fr; const int colb = (u.pn * HALF + wc * 32 + 8 * fq) * 2;
        float rsv[2][4];
#pragma unroll
        for (int ai = 0; ai < 2; ++ai)
#pragma unroll
            for (int m = 0; m < 4; ++m) rsv[ai][m] = __builtin_bit_cast(float, __builtin_amdgcn_raw_buffer_load_b32(rr, (row0 + ai * HALF + m * 16) * 4, 0, 0));
        __builtin_amdgcn_sched_barrier(0);
#pragma unroll
        for (int ai = 0; ai < 2; ++ai)
#pragma unroll
            for (int m = 0; m < 4; ++m) { const int r = row0 + ai * HALF + m * 16; const float rs = rsv[ai][m] * (-1.4426950408889634f / 4096.0f);
                f32x4 q0, q1, s0, s1;
#pragma unroll
                for (int i = 0; i < 4; ++i) { const float ea0 = fminf(1.0f + __builtin_amdgcn_exp2f(acc[ai][0][m][0][i] * rs), 1e13f), eb0 = fminf(1.0f + __builtin_amdgcn_exp2f(acc[ai][1][m][0][i] * rs), 1e13f);
                    const float ea1 = fminf(1.0f + __builtin_amdgcn_exp2f(acc[ai][0][m][1][i] * rs), 1e13f), eb1 = fminf(1.0f + __builtin_amdgcn_exp2f(acc[ai][1][m][1][i] * rs), 1e13f);
                    q0[i] = eb0 * __builtin_amdgcn_rcpf(ea0); q1[i] = eb1 * __builtin_amdgcn_rcpf(ea1); s0[i] = __builtin_amdgcn_rcpf(eb0); s1[i] = __builtin_amdgcn_rcpf(eb1); }
                const int gidx = (((((u.pm * 16 + u.pn) * 2 + ai) * 4 + m) * 8 + (wr * 4 + wc)) * 64 + (fr + 16 * fq)) * 16;
                __builtin_amdgcn_raw_buffer_store_b128(pack8f(q0, q1), rg, gidx, 0, GT_AUX);
                __builtin_amdgcn_raw_buffer_store_b128(pack8f(s0, s1), rg2, gidx, 0, GT_AUX); }
    }
};
struct EpiPlain {
    static constexpr bool PERM = true, AFTER_DRAIN = false;
    bf16_t* O; int ldc;
    __device__ __forceinline__ void operator()(const f32x4 (&acc)[2][2][4][2], const Unit& u, int wr, int wc, int fr, int fq) const {
        const int row0 = u.pm * BM + wr * 64 + fr, col0 = u.pn * BM + wc * 32 + 8 * fq;
#pragma unroll
        for (int ai = 0; ai < 2; ++ai)
#pragma unroll
            for (int m = 0; m < 4; ++m) { bf16_t* rowp = O + (size_t)(row0 + ai * HALF + m * 16) * ldc + col0;
#pragma unroll
                for (int bj = 0; bj < 2; ++bj) *(u32x4*)(rowp + bj * HALF) = pack8f(acc[ai][bj][m][0], acc[ai][bj][m][1]); }
    }
};
struct EpiPlainS {
    static constexpr bool PERM = true, AFTER_DRAIN = false;
    bf16_t* O; int ldc; float s;
    __device__ __forceinline__ void operator()(const f32x4 (&acc)[2][2][4][2], const Unit& u, int wr, int wc, int fr, int fq) const {
        const int row0 = u.pm * BM + wr * 64 + fr, col0 = u.pn * BM + wc * 32 + 8 * fq;
#pragma unroll
        for (int ai = 0; ai < 2; ++ai)
#pragma unroll
            for (int m = 0; m < 4; ++m) { bf16_t* rowp = O + (size_t)(row0 + ai * HALF + m * 16) * ldc + col0;
#pragma unroll
                for (int bj = 0; bj < 2; ++bj) *(u32x4*)(rowp + bj * HALF) = pack8f(acc[ai][bj][m][0] * s, acc[ai][bj][m][1] * s); }
    }
};
struct EpiPlainS8 {
    static constexpr bool PERM = true, AFTER_DRAIN = false;
    unsigned char* O; int ldc; float s;
    __device__ __forceinline__ void operator()(const f32x4 (&acc)[2][2][4][2], const Unit& u, int wr, int wc, int fr, int fq) const {
        const int row0 = u.pm * BM + wr * 64 + fr, col0 = u.pn * BM + wc * 32 + 8 * fq;
#pragma unroll
        for (int ai = 0; ai < 2; ++ai)
#pragma unroll
            for (int m = 0; m < 4; ++m) { unsigned char* rowp = O + (size_t)(row0 + ai * HALF + m * 16) * ldc + col0;
#pragma unroll
                for (int bj = 0; bj < 2; ++bj) { const f32x4 v0 = acc[ai][bj][m][0] * s, v1 = acc[ai][bj][m][1] * s; u32x2 w; w.x = pk4_fp8(v0[0], v0[1], v0[2], v0[3]); w.y = pk4_fp8(v1[0], v1[1], v1[2], v1[3]); *(u32x2*)(rowp + bj * HALF) = w; } }
    }
};
template <bool ADD> struct EpiGate {
    static constexpr bool PERM = true, AFTER_DRAIN = false;
    bf16_t* O; const bf16_t* gate; const bf16_t* prev;
    __device__ __forceinline__ void operator()(const f32x4 (&acc)[2][2][4][2], const Unit& u, int wr, int wc, int fr, int fq) const {
        const int row0 = u.pm * BM + wr * 64 + fr, col0 = u.pn * BM + wc * 32 + 8 * fq;
#pragma unroll
        for (int ai = 0; ai < 2; ++ai)
#pragma unroll
            for (int m = 0; m < 4; ++m) { const size_t off = (size_t)(row0 + ai * HALF + m * 16) * 2048 + col0;
#pragma unroll
                for (int bj = 0; bj < 2; ++bj) { f32x4 g0, g1; unpack8f(*(const u32x4*)(gate + off + bj * HALF), g0, g1);
                    f32x4 v0, v1;
#pragma unroll
                    for (int i = 0; i < 4; ++i) { v0[i] = sigmoidf_(g0[i]) * acc[ai][bj][m][0][i]; v1[i] = sigmoidf_(g1[i]) * acc[ai][bj][m][1][i]; }
                    if (ADD) { f32x4 p0, p1; unpack8f(*(const u32x4*)(prev + off + bj * HALF), p0, p1); v0 += p0; v1 += p1; }
                    *(u32x4*)(O + off + bj * HALF) = pack8f(v0, v1); } }
    }
};
template <bool IN8, bool OUT8> struct EpiGate2T {
    static constexpr bool PERM = true, AFTER_DRAIN = false, MID = true;
    bf16_t* O; const bf16_t* rat; const bf16_t* sb;
    __device__ __forceinline__ void mid(f32x4 (&acc)[2][2][4][2], const Unit& u, int wr, int wc, int fr, int fq) const {
        const int row0 = u.pm * BM + wr * 64 + fr, col0 = u.pn * BM + wc * 32 + 8 * fq;
#pragma unroll
        for (int ai = 0; ai < 2; ++ai)
#pragma unroll
            for (int m = 0; m < 4; ++m) { const size_t off = (size_t)(row0 + ai * HALF + m * 16) * 2048 + col0;
#pragma unroll
                for (int bj = 0; bj < 2; ++bj) { f32x4 a0, a1; unpack8f(*(const u32x4*)(rat + (size_t)((((((u.pm * 16 + 2 * u.pn + bj) * 2 + ai) * 4 + m) * 8 + (wr * 4 + wc)) * 64 + (fr + 16 * fq)) * 8)), a0, a1); acc[ai][bj][m][0] *= a0; acc[ai][bj][m][1] *= a1; } }
    }
    __device__ __forceinline__ void operator()(const f32x4 (&acc)[2][2][4][2], const Unit& u, int wr, int wc, int fr, int fq) const {
        const int row0 = u.pm * BM + wr * 64 + fr, col0 = u.pn * BM + wc * 32 + 8 * fq;
        constexpr float sc = (IN8 ? 1.0f / 4096.0f : 1.0f) * (OUT8 ? 16.0f : 1.0f);
#pragma unroll
        for (int ai = 0; ai < 2; ++ai) {
            u32x4 gv[4][2];
#pragma unroll
            for (int m = 0; m < 4; ++m)
#pragma unroll
                for (int bj = 0; bj < 2; ++bj) gv[m][bj] = *(const u32x4*)(sb + (size_t)((((((u.pm * 16 + 2 * u.pn + bj) * 2 + ai) * 4 + m) * 8 + (wr * 4 + wc)) * 64 + (fr + 16 * fq)) * 8));
            __builtin_amdgcn_sched_barrier(0);
#pragma unroll
            for (int m = 0; m < 4; ++m) { const size_t off = (size_t)(row0 + ai * HALF + m * 16) * 2048 + col0;
#pragma unroll
                for (int bj = 0; bj < 2; ++bj) { f32x4 g0, g1; unpack8f(gv[m][bj], g0, g1); const f32x4 v0 = acc[ai][bj][m][0] * g0 * sc, v1 = acc[ai][bj][m][1] * g1 * sc;
                    if constexpr (OUT8) { u32x2 w; w.x = pk4_fp8(v0[0], v0[1], v0[2], v0[3]); w.y = pk4_fp8(v1[0], v1[1], v1[2], v1[3]); *(u32x2*)((unsigned char*)O + off + bj * HALF) = w; }
                    else *(u32x4*)(O + off + bj * HALF) = pack8f(v0, v1); } } }
    }
};
struct EpiResid {
    static constexpr bool PERM = true, AFTER_DRAIN = false;
    bf16_t* O; const float* X;
    __device__ __forceinline__ void operator()(const f32x4 (&acc)[2][2][4][2], const Unit& u, int wr, int wc, int fr, int fq) const {
        const int row0 = u.pm * BM + wr * 64 + fr, col0 = u.pn * BM + wc * 32 + 8 * fq;
#pragma unroll
        for (int ai = 0; ai < 2; ++ai)
#pragma unroll
            for (int m = 0; m < 4; ++m) { const size_t off = (size_t)(row0 + ai * HALF + m * 16) * 2048 + col0;
#pragma unroll
                for (int bj = 0; bj < 2; ++bj) { const f32x4 x0 = *(const f32x4*)(X + off + bj * HALF), x1 = *(const f32x4*)(X + off + bj * HALF + 4);
                    *(u32x4*)(O + off + bj * HALF) = pack8f(acc[ai][bj][m][0] + x0, acc[ai][bj][m][1] + x1); } }
    }
};
template <bool IN8> struct EpiResid8T {
    static constexpr bool PERM = true, AFTER_DRAIN = false;
    bf16_t* O; const bf16_t* X; unsigned char* O8;
    __device__ __forceinline__ void operator()(const f32x4 (&acc)[2][2][4][2], const Unit& u, int wr, int wc, int fr, int fq) const {
        const int row0 = u.pm * BM + wr * 64 + fr, col0 = u.pn * BM + wc * 32 + 8 * fq;
#pragma unroll
        for (int ai = 0; ai < 2; ++ai) {
            u32x4 xv[4][2];
#pragma unroll
            for (int m = 0; m < 4; ++m)
#pragma unroll
                for (int bj = 0; bj < 2; ++bj) xv[m][bj] = *(const u32x4*)(X + (size_t)(row0 + ai * HALF + m * 16) * 2048 + col0 + bj * HALF);
            __builtin_amdgcn_sched_barrier(0);
#pragma unroll
            for (int m = 0; m < 4; ++m) { const size_t off = (size_t)(row0 + ai * HALF + m * 16) * 2048 + col0;
#pragma unroll
                for (int bj = 0; bj < 2; ++bj) { f32x4 x0, x1; unpack8f(xv[m][bj], x0, x1); const f32x4 v0 = acc[ai][bj][m][0] * (IN8 ? 1.0f / 4096.0f : 1.0f) + x0, v1 = acc[ai][bj][m][1] * (IN8 ? 1.0f / 4096.0f : 1.0f) + x1;
                    *(u32x4*)(O + off + bj * HALF) = pack8f(v0, v1);
                    u32x2 w; w.x = pk4_fp8(16.f * v0[0], 16.f * v0[1], 16.f * v0[2], 16.f * v0[3]); w.y = pk4_fp8(16.f * v1[0], 16.f * v1[1], 16.f * v1[2], 16.f * v1[3]); *(u32x2*)(O8 + off + bj * HALF) = w; } } }
    }
};
struct EpiMoe1 {
    static constexpr bool PERM = true, AFTER_DRAIN = false;
    bf16_t* Hb; const float* rowscale;
    __device__ __forceinline__ void operator()(const f32x4 (&acc)[2][2][4][2], const Unit& u, int wr, int wc, int fr, int fq) const {
        const int row0 = u.pm * BM + wr * 64 + fr, col0 = u.pn * HALF + wc * 32 + 8 * fq;
#pragma unroll
        for (int ai = 0; ai < 2; ++ai)
#pragma unroll
            for (int m = 0; m < 4; ++m) { const int row = row0 + ai * HALF + m * 16; const float rs = rowscale[row]; f32x4 v0, v1;
#pragma unroll
                for (int i = 0; i < 4; ++i) { const float a0 = acc[ai][0][m][0][i] * rs, b0 = acc[ai][1][m][0][i] * rs, a1 = acc[ai][0][m][1][i] * rs, b1 = acc[ai][1][m][1][i] * rs;
                    v0[i] = a0 * sigmoidf_(a0) * b0; v1[i] = a1 * sigmoidf_(a1) * b1; }
                *(u32x4*)(Hb + (size_t)row * 1024 + col0) = pack8f(v0, v1); }
    }
};
struct EpiMoe1G {
    static constexpr bool PERM = true, AFTER_DRAIN = false;
    bf16_t* Hb; const float* slot_rs; const PG8_LAS int* tab;
    __device__ __forceinline__ void operator()(const f32x4 (&acc)[2][2][4][2], const Unit& u, int wr, int wc, int fr, int fq) const {
        const int row0 = u.pm * BM + wr * 64 + fr, col0 = u.pn * HALF + wc * 32 + 8 * fq; const int e = tab[34 + u.pm], ps = tab[e], cn = tab[194 + e];
#pragma unroll
        for (int ai = 0; ai < 2; ++ai)
#pragma unroll
            for (int m = 0; m < 4; ++m) { const int row = row0 + ai * HALF + m * 16, slot = row - ps; const float rs = slot < cn ? slot_rs[(size_t)e * 16384 + slot] : 0.f; f32x4 v0, v1;
#pragma unroll
                for (int i = 0; i < 4; ++i) { const float a0 = acc[ai][0][m][0][i] * rs, b0 = acc[ai][1][m][0][i] * rs, a1 = acc[ai][0][m][1][i] * rs, b1 = acc[ai][1][m][1][i] * rs;
                    v0[i] = a0 * sigmoidf_(a0) * b0; v1[i] = a1 * sigmoidf_(a1) * b1; }
                *(u32x4*)(Hb + (size_t)row * 1024 + col0) = pack8f(v0, v1); }
    }
};
struct EpiMoe1G8 {
    static constexpr bool PERM = true, AFTER_DRAIN = false;
    unsigned char* Hb; const float* slot_rs; const PG8_LAS int* tab;
    __device__ __forceinline__ void operator()(const f32x4 (&acc)[2][2][4][2], const Unit& u, int wr, int wc, int fr, int fq) const {
        const int e = tab[34 + u.pm], ps = tab[e], cn = tab[194 + e];
        const int slot0 = u.pm * BM + wr * 64 + fr - ps; const float* rsp = slot_rs + (size_t)e * 16384 + slot0; const int hoff = (u.pm * BM + wr * 64 + fr) * 1024 + (u.pn * HALF + wc * 32 + 8 * fq);
        const __amdgpu_buffer_rsrc_t rh = __builtin_amdgcn_make_buffer_rsrc((void*)Hb, 0, 160 * 256 * 1024, 0x00020000);
#pragma unroll
        for (int ai = 0; ai < 2; ++ai) {
            float rsv[4];
#pragma unroll
            for (int m = 0; m < 4; ++m) { const int dr = ai * HALF + m * 16; rsv[m] = (slot0 + dr) < cn ? rsp[dr] : 0.f; }
            __builtin_amdgcn_sched_barrier(0);
#pragma unroll
            for (int m = 0; m < 4; ++m) { const int dr = ai * HALF + m * 16; const float rs = rsv[m] * (1.0f / 4096.0f); f32x4 v0, v1;
#pragma unroll
                for (int i = 0; i < 4; ++i) { const float a0 = acc[ai][0][m][0][i] * rs, b0 = acc[ai][1][m][0][i] * rs, a1 = acc[ai][0][m][1][i] * rs, b1 = acc[ai][1][m][1][i] * rs;
                    v0[i] = 8.f * a0 * sigmoidf_(a0) * b0; v1[i] = 8.f * a1 * sigmoidf_(a1) * b1; }
                u32x2 w; w.x = pk4_fp8(v0[0], v0[1], v0[2], v0[3]); w.y = pk4_fp8(v1[0], v1[1], v1[2], v1[3]); __builtin_amdgcn_raw_buffer_store_b64(w, rh, hoff + dr * 1024, 0, 16);
                }
            asm volatile("" ::: "memory"); }
    }
};
struct MoeGatherOrder {
    int nblk, G, c, tiles_per_e; const PG8_LAS int* tab; const int* tlist; PG8_LAS unsigned* park; unsigned* cnt; mutable int pend;
    __device__ __forceinline__ bool next(int i, Unit& u) const {
        const long L = (long)i * G + c; const int idx = (int)(L >> 3); if (idx >= nblk) return false;
        u.pm = idx; u.pn = (int)(L & 7); u.pb = tab[34 + idx] * tiles_per_e + u.pn; return true;
    }
    __device__ __forceinline__ int arow(const Unit& u, int r) const { const int e = tab[34 + u.pm], slot = u.pm * BM + r - tab[e], cm = tab[194 + e] - 1; return tlist[(size_t)e * 16384 + (slot < cm ? slot : cm)]; }
    __device__ __forceinline__ void a_ready(const Unit&) const {}
    __device__ __forceinline__ void publish(int blk) const { if ((threadIdx.x & 63) == 0) __hip_atomic_fetch_add(cnt + 64 * blk, 1u, __ATOMIC_RELAXED, __HIP_MEMORY_SCOPE_AGENT); }
    __device__ __forceinline__ void done(const Unit& u) const { if (pend >= 0) publish(pend); pend = u.pm; }
    __device__ __forceinline__ void flush() const { asm volatile("s_waitcnt vmcnt(0)" ::: "memory"); if (pend >= 0) publish(pend); pend = -1; }
};
struct MoeCountedOrder {
    int nblk, G, c, i0, n1, tiles_per_e; const PG8_LAS int* blk_e; const unsigned* cnt; volatile PG8_LAS int* bc; mutable unsigned ahead;
    __device__ __forceinline__ bool next(int i, Unit& u) const {
        const long L = (long)(i + i0) * G + c - n1; const int idx = (int)(L >> 3); if (idx >= nblk) return false;
        u.pm = idx; u.pn = (int)(L & 7); u.pb = blk_e[idx] * tiles_per_e + u.pn; return true;
    }
    __device__ __forceinline__ void a_ready(const Unit& u) const {
        if (ahead & 1u) { ahead >>= 1; return; }
        if (threadIdx.x < 64) { unsigned polls = 0, m;
            const int step = G >> 3, bj = u.pm + step * (int)threadIdx.x;
            for (;;) { const unsigned v = (threadIdx.x < 8 && bj < nblk) ? __hip_atomic_load(cnt + 64 * bj, __ATOMIC_RELAXED, __HIP_MEMORY_SCOPE_AGENT) : 64u;
                m = (unsigned)__ballot(v >= 64u) & 0xffu;
                if ((m & 1u) || ++polls > (1u << 20)) break; __builtin_amdgcn_s_sleep(2); }
            __builtin_amdgcn_fence(__ATOMIC_ACQUIRE, "agent");
            asm volatile("s_waitcnt vmcnt(0)" ::: "memory");
            if (threadIdx.x == 0) bc[0] = (int)m; asm volatile("s_waitcnt lgkmcnt(0)" ::: "memory"); }
        asm volatile("" ::: "memory"); __builtin_amdgcn_s_barrier(); asm volatile("" ::: "memory");
        ahead = ((unsigned)__builtin_amdgcn_readfirstlane(bc[0])) >> 1;
    }
    __device__ __forceinline__ void done(const Unit&) const {}
};
struct MoeOrder {
    int nblk, G, c, tiles_per_e; const PG8_LAS int* blk_e;
    __device__ __forceinline__ bool next(int i, Unit& u) const {
        const long L = (long)i * G + c; const int idx = (int)(L >> 3); if (idx >= nblk) return false;
        u.pm = idx; u.pn = (int)(L & 7); u.pb = blk_e[idx] * tiles_per_e + u.pn; return true;
    }
    __device__ __forceinline__ void a_ready(const Unit&) const {}
    __device__ __forceinline__ void done(const Unit&) const {}
};
template <class E_, class = void> struct epi_has_mid { static constexpr bool v = false; };
template <class E_> struct epi_has_mid<E_, decltype((void)E_::MID)> { static constexpr bool v = E_::MID; };
template <class Epi, class Sched, bool ALIGN_EPI = false, bool SP2 = false, bool GATHER = false, bool F8 = false>
__device__ __forceinline__ void gemm_phase(PG8_LAS unsigned char* lds, const Gemm g, const Sched& S, const Epi& E) {
    const int tid = threadIdx.x, wid = __builtin_amdgcn_readfirstlane(tid >> 6), lane = tid & 63, wr = wid >> 2, wc = wid & 3, fr = lane & 15, fq = lane >> 4;
    const int K = g.K, nt = K / BK;
    unsigned voffA[2], voffB[2];
#pragma unroll
    for (int i = 0; i < 2; ++i) { int R, C; stage_rc(tid * 16 + i * 8192, R, C); const int Rb = Epi::PERM ? ((R & ~31) + perm32(R & 31)) : R;
        voffA[i] = (unsigned)(R * K + C) * 2u; voffB[i] = (unsigned)(Rb * K + C) * 2u; }
    static_assert(!GATHER || SP2, "GATHER is implemented for the SP2 loop");
    unsigned cvA[2][2] = {{0u, 0u}, {0u, 0u}}; const unsigned svA[2][2] = {{0u, 0u}, {0u, 0u}};
    const unsigned kstep = (unsigned)(BK * 2);
    const unsigned hstep = (unsigned)HALF * (unsigned)K * 2u;
    const unsigned tstep = 2u * hstep;
    const unsigned qstep = 64u * (unsigned)K * 2u;
    const unsigned ldsw = (unsigned)wid * 1024u;
    const int aoff = F8 ? (lds_byte(wr * 64 + fr, fq * 16) + 16 * (fq & 1)) : lds_byte(wr * 64 + fr, fq * 8), boff = F8 ? (lds_byte(wc * 32 + fr, fq * 16) + 16 * (fq & 1)) : lds_byte(wc * 32 + fr, fq * 8);
    static_assert(!F8 || SP2, "F8 is implemented for the SP2 loop");
#define PG8_SA(b, h) (((b) * 2 + (h)) * HTB)
#define PG8_SB(b, h) ((4 + (b) * 2 + (h)) * HTB)
#define PG8_STAGE(bufoff, gbase, voff) do { _Pragma("unroll") for (int _i = 0; _i < 2; ++_i) \
        __builtin_amdgcn_raw_ptr_buffer_load_lds(rsw, (PG8_LAS void*)(lds + (bufoff) + ldsw + _i * 8192), 16, (int)(voff)[_i], (int)(gbase), 0, 0); } while (0)
#define PG8_STAGE1(bufoff, gbase, voff0) do { _Pragma("unroll") for (int _i = 0; _i < 2; ++_i) \
        __builtin_amdgcn_raw_ptr_buffer_load_lds(rsw, (PG8_LAS void*)(lds + (bufoff) + ldsw + _i * 8192), 16, (int)(voff0), (int)((gbase) + (unsigned)_i * qstep), 0, 0); } while (0)
#define PG8_STAGE_A(bufoff, ptr, h, nx) do { if constexpr (GATHER) { unsigned vo_[2]; vo_[0] = (nx) ? svA[h][0] : cvA[h][0]; vo_[1] = (nx) ? svA[h][1] : cvA[h][1]; PG8_STAGE(bufoff, ptr, vo_); } \
        else { PG8_STAGE1(bufoff, (ptr) + (h) * hstep, voffA[0]); } } while (0)
#define PG8_GOFF(dst, u) do { int t_ = threadIdx.x; asm volatile("" : "+v"(t_)); _Pragma("unroll") for (int i_ = 0; i_ < 2; ++i_) { int R_, C_; stage_rc(t_ * 16 + i_ * 8192, R_, C_); _Pragma("unroll") for (int h_ = 0; h_ < 2; ++h_) dst[h_][i_] = (unsigned)S.arow(u, h_ * HALF + R_) * (unsigned)(K * 2) + (unsigned)C_ * 2u; } } while (0)
#define PG8_LDA(dst, b, h) do { if constexpr (F8) { _Pragma("unroll") for (int m = 0; m < 4; ++m) { const v4i_t lo_ = *(const PG8_LAS v4i_t*)(lds + PG8_SA(b, h) + aoff + m * 2048), hi_ = *(const PG8_LAS v4i_t*)(lds + PG8_SA(b, h) + (aoff ^ 16) + m * 2048); \
            dst##8[m] = __builtin_shufflevector(lo_, hi_, 0, 1, 2, 3, 4, 5, 6, 7); } } \
        else { _Pragma("unroll") for (int m = 0; m < 4; ++m) _Pragma("unroll") for (int k = 0; k < 2; ++k) dst[m][k] = *(const PG8_LAS bf16x8*)(lds + PG8_SA(b, h) + aoff + m * 2048 + k * 1024); } } while (0)
#define PG8_LDB(dst, b, h) do { if constexpr (F8) { _Pragma("unroll") for (int n = 0; n < 2; ++n) { const v4i_t lo_ = *(const PG8_LAS v4i_t*)(lds + PG8_SB(b, h) + boff + n * 2048), hi_ = *(const PG8_LAS v4i_t*)(lds + PG8_SB(b, h) + (boff ^ 16) + n * 2048); \
            dst##8[n] = __builtin_shufflevector(lo_, hi_, 0, 1, 2, 3, 4, 5, 6, 7); } } \
        else { _Pragma("unroll") for (int n = 0; n < 2; ++n) _Pragma("unroll") for (int k = 0; k < 2; ++k) dst[n][k] = *(const PG8_LAS bf16x8*)(lds + PG8_SB(b, h) + boff + n * 2048 + k * 1024); } } while (0)
#define PG8_MMA(ai, bj, At, Bt) do { __builtin_amdgcn_s_setprio(1); if constexpr (F8) { _Pragma("unroll") for (int m = 0; m < 4; ++m) _Pragma("unroll") for (int n = 0; n < 2; ++n) \
            acc[ai][bj][m][n] = __builtin_amdgcn_mfma_scale_f32_16x16x128_f8f6f4(Bt##8[n], At##8[m], acc[ai][bj][m][n], 0, 0, 0, 0, 0, 0); } \
        else { _Pragma("unroll") for (int m = 0; m < 4; ++m) _Pragma("unroll") for (int n = 0; n < 2; ++n) _Pragma("unroll") for (int k = 0; k < 2; ++k) \
            acc[ai][bj][m][n] = __builtin_amdgcn_mfma_f32_16x16x32_bf16(Bt[n][k], At[m][k], acc[ai][bj][m][n], 0, 0, 0); } __builtin_amdgcn_s_setprio(0); } while (0)
#define PG8_WAIT_V(n) asm volatile("s_waitcnt vmcnt(" #n ")" ::: "memory")
#define PG8_WAIT_L(n) asm volatile("s_waitcnt lgkmcnt(" #n ")" ::: "memory")
#define PG8_BAR __builtin_amdgcn_s_barrier()
#define PG8_SCHED __builtin_amdgcn_sched_barrier(0)
    Unit cur, nxt; int ui = 0;
    if (!S.next(0, cur)) return;
    f32x4 acc[2][2][4][2];
#pragma unroll
    for (int a = 0; a < 2; ++a)
#pragma unroll
        for (int b = 0; b < 2; ++b)
#pragma unroll
            for (int m = 0; m < 4; ++m)
#pragma unroll
                for (int n = 0; n < 2; ++n) acc[a][b][m][n] = (f32x4){0.f, 0.f, 0.f, 0.f};
    bf16x8 At[4][2], B0[2][2], B1[2][2]; v8i_t At8[4], B08[2], B18[2];
    const __amdgpu_buffer_rsrc_t rsw = __builtin_amdgcn_make_buffer_rsrc((void*)g.base, 0, 0x7ffffff0, 0x00020000);
    const unsigned oA0 = (unsigned)((const char*)g.A - (const char*)g.base), oB0 = (unsigned)((const char*)g.Bt - (const char*)g.base);
    unsigned cA = oA0 + (GATHER ? 0u : (unsigned)cur.pm * tstep); unsigned cB = oB0 + (unsigned)cur.pb * tstep;
    if constexpr (GATHER) PG8_GOFF(cvA, cur);
    S.a_ready(cur);
    if constexpr (SP2) {
        PG8_STAGE1(PG8_SB(0, 0), cB, voffB[0]); PG8_STAGE1(PG8_SB(0, 1), cB + hstep, voffB[0]); PG8_STAGE_A(PG8_SA(0, 0), cA, 0, false); PG8_STAGE_A(PG8_SA(0, 1), cA, 1, false);
        if (wr == 1) PG8_BAR;
        PG8_WAIT_V(2); PG8_BAR;
        PG8_STAGE1(PG8_SB(1, 0), cB + kstep, voffB[0]); PG8_STAGE_A(PG8_SA(1, 0), cA + kstep, 0, false); PG8_STAGE1(PG8_SB(1, 1), cB + hstep + kstep, voffB[0]);
        PG8_WAIT_V(6); PG8_BAR;
    } else {
        PG8_STAGE1(PG8_SB(0, 0), cB, voffB[0]); PG8_STAGE(PG8_SA(0, 0), cA, voffA); PG8_STAGE1(PG8_SB(0, 1), cB + hstep, voffB[0]); PG8_STAGE(PG8_SA(0, 1), cA + hstep, voffA);
        if (wr == 1) PG8_BAR;
        PG8_WAIT_V(4); PG8_BAR;
        PG8_STAGE1(PG8_SB(1, 0), cB + kstep, voffB[0]); PG8_STAGE(PG8_SA(1, 0), cA + kstep, voffA); PG8_STAGE1(PG8_SB(1, 1), cB + hstep + kstep, voffB[0]);
        PG8_WAIT_V(6); PG8_BAR;
    }
    for (;;) {
        const bool has_next = S.next(ui + 1, nxt);
        if constexpr (GATHER) { if (ui == 0) { unsigned tv_[2][2]; if (has_next) PG8_GOFF(tv_, nxt); else { tv_[0][0] = cvA[0][0]; tv_[0][1] = cvA[0][1]; tv_[1][0] = cvA[1][0]; tv_[1][1] = cvA[1][1]; }
            { int t_ = threadIdx.x; asm volatile("" : "+v"(t_)); *(PG8_LAS u32x4*)(S.park + t_ * 4) = (u32x4){tv_[0][0], tv_[0][1], tv_[1][0], tv_[1][1]}; } } }
        const unsigned nA = (has_next && !GATHER) ? oA0 + (unsigned)nxt.pm * tstep : cA; const unsigned nB = has_next ? oB0 + (unsigned)nxt.pb * tstep : cB;
#pragma unroll 1
        for (int t = 0; t < nt; t += 2) {
            const bool last = (t == nt - 2);
            const unsigned a1 = cA + (unsigned)(t + 1) * kstep;
            const unsigned a2 = last ? nA : cA + (unsigned)(t + 2) * kstep; const unsigned b2 = last ? nB : cB + (unsigned)(t + 2) * kstep;
            const unsigned a3 = a2 + kstep; const unsigned b3 = b2 + kstep;
            if (last && has_next) S.a_ready(nxt);
            if constexpr (epi_has_mid<Epi>::v) { if (t == (nt >> 1)) { int t_ = threadIdx.x; asm volatile("" : "+v"(t_)); const int l_ = t_ & 63, w_ = __builtin_amdgcn_readfirstlane(t_ >> 6); E.mid(acc, cur, w_ >> 2, w_ & 3, l_ & 15, l_ >> 4); } }
            unsigned svA[2][2] = {{cvA[0][0], cvA[0][1]}, {cvA[1][0], cvA[1][1]}};
            if constexpr (GATHER) { if (last) { int t_ = threadIdx.x; asm volatile("" : "+v"(t_)); const u32x4 pv_ = *(const PG8_LAS u32x4*)(S.park + t_ * 4); svA[0][0] = pv_.x; svA[0][1] = pv_.y; svA[1][0] = pv_.z; svA[1][1] = pv_.w; } }
            if constexpr (SP2) {
            PG8_LDB(B0, 0, 0); PG8_LDB(B1, 0, 1); PG8_SCHED; PG8_LDA(At, 0, 0); PG8_STAGE_A(PG8_SA(1, 1), a1, 1, false);
            PG8_WAIT_V(8); PG8_WAIT_L(0); PG8_BAR; PG8_MMA(0, 0, At, B0); PG8_MMA(0, 1, At, B1); PG8_BAR; PG8_SCHED;
            PG8_LDA(At, 0, 1); PG8_STAGE1(PG8_SB(0, 0), b2, voffB[0]); PG8_STAGE1(PG8_SB(0, 1), b2 + hstep, voffB[0]); PG8_STAGE_A(PG8_SA(0, 0), a2, 0, last);
            PG8_WAIT_V(8); PG8_WAIT_L(0); PG8_BAR; PG8_MMA(1, 0, At, B0); PG8_MMA(1, 1, At, B1); PG8_BAR; PG8_SCHED;
            PG8_LDB(B0, 1, 0); PG8_LDB(B1, 1, 1); PG8_SCHED; PG8_LDA(At, 1, 0); PG8_STAGE_A(PG8_SA(0, 1), a2, 1, last);
            PG8_WAIT_V(8); PG8_WAIT_L(0); PG8_BAR; PG8_MMA(0, 0, At, B0); PG8_MMA(0, 1, At, B1); PG8_BAR; PG8_SCHED;
            PG8_LDA(At, 1, 1); PG8_STAGE1(PG8_SB(1, 0), b3, voffB[0]); PG8_STAGE1(PG8_SB(1, 1), b3 + hstep, voffB[0]); PG8_STAGE_A(PG8_SA(1, 0), a3, 0, last);
            PG8_WAIT_V(8); PG8_WAIT_L(0); PG8_BAR; PG8_MMA(1, 0, At, B0); PG8_MMA(1, 1, At, B1); PG8_BAR; PG8_SCHED;
            } else {
            PG8_LDB(B0, 0, 0); PG8_SCHED; PG8_LDA(At, 0, 0); PG8_STAGE(PG8_SA(1, 1), a1 + hstep, voffA);
            PG8_WAIT_L(8); PG8_BAR; PG8_WAIT_L(0); PG8_MMA(0, 0, At, B0); PG8_BAR; PG8_SCHED;
            PG8_LDB(B1, 0, 1); PG8_STAGE1(PG8_SB(0, 0), b2, voffB[0]);
            PG8_BAR; PG8_WAIT_L(0); PG8_MMA(0, 1, At, B1); PG8_BAR;
            PG8_LDA(At, 0, 1); PG8_STAGE(PG8_SA(0, 0), a2, voffA);
            PG8_BAR; PG8_WAIT_L(0); PG8_MMA(1, 0, At, B0); PG8_BAR; PG8_SCHED;
            PG8_STAGE1(PG8_SB(0, 1), b2 + hstep, voffB[0]);
            PG8_WAIT_V(6); PG8_BAR; PG8_MMA(1, 1, At, B1); PG8_BAR;
            PG8_LDB(B0, 1, 0); PG8_SCHED; PG8_LDA(At, 1, 0); PG8_STAGE(PG8_SA(0, 1), a2 + hstep, voffA);
            PG8_WAIT_L(8); PG8_BAR; PG8_WAIT_L(0); PG8_MMA(0, 0, At, B0); PG8_BAR; PG8_SCHED;
            PG8_LDB(B1, 1, 1); PG8_STAGE1(PG8_SB(1, 0), b3, voffB[0]);
            PG8_BAR; PG8_WAIT_L(0); PG8_MMA(0, 1, At, B1); PG8_BAR;
            PG8_LDA(At, 1, 1); PG8_STAGE(PG8_SA(1, 0), a3, voffA);
            PG8_BAR; PG8_WAIT_L(0); PG8_MMA(1, 0, At, B0); PG8_BAR; PG8_SCHED;
            PG8_STAGE1(PG8_SB(1, 1), b3 + hstep, voffB[0]);
            PG8_WAIT_V(6); PG8_BAR; PG8_MMA(1, 1, At, B1); PG8_BAR;
            }
        }
        Unit nn2; bool has_nn = false; unsigned tv2[2][2] = {{0u, 0u}, {0u, 0u}};
        if constexpr (GATHER) { has_nn = has_next && S.next(ui + 2, nn2); if (has_nn) PG8_GOFF(tv2, nn2); }
        if constexpr (ALIGN_EPI) { if (wr == 0) PG8_BAR; }
        if constexpr (!Epi::AFTER_DRAIN) { int t_ = threadIdx.x; asm volatile("" : "+v"(t_));
            const int l_ = t_ & 63, w_ = __builtin_amdgcn_readfirstlane(t_ >> 6); E(acc, cur, w_ >> 2, w_ & 3, l_ & 15, l_ >> 4); S.done(cur); }
        if (!has_next) break;
#pragma unroll
        for (int a = 0; a < 2; ++a)
#pragma unroll
            for (int b = 0; b < 2; ++b)
#pragma unroll
                for (int m = 0; m < 4; ++m)
#pragma unroll
                    for (int n = 0; n < 2; ++n) acc[a][b][m][n] = (f32x4){0.f, 0.f, 0.f, 0.f};
        cur = nxt; cA = nA; cB = nB; ++ui;
        if constexpr (GATHER) { int t_ = threadIdx.x; asm volatile("" : "+v"(t_)); const u32x4 pv_ = *(const PG8_LAS u32x4*)(S.park + t_ * 4); cvA[0][0] = pv_.x; cvA[0][1] = pv_.y; cvA[1][0] = pv_.z; cvA[1][1] = pv_.w;
            *(PG8_LAS u32x4*)(S.park + t_ * 4) = has_nn ? (u32x4){tv2[0][0], tv2[0][1], tv2[1][0], tv2[1][1]} : pv_; }
        if constexpr (ALIGN_EPI) { if (wr == 1) PG8_BAR; }
    }
    PG8_WAIT_V(0);
    if constexpr (!ALIGN_EPI) { if (wr == 0) PG8_BAR; }
    PG8_BAR;
    if constexpr (Epi::AFTER_DRAIN) { E.fused(acc, cur, wr, wc, fr, fq, lds, wid, lane); S.done(cur); }
#undef PG8_SA
#undef PG8_SB
#undef PG8_STAGE
#undef PG8_STAGE_A
#undef PG8_GOFF
#undef PG8_LDA
#undef PG8_LDB
#undef PG8_MMA
#undef PG8_WAIT_V
#undef PG8_WAIT_L
#undef PG8_BAR
#undef PG8_SCHED
}
}

constexpr int NWAVES = 8;
constexpr int BATCH = 4, SEQ = 4096, DM = 2048, T = BATCH * SEQ;
constexpr int NCOLS = 11272, NPROJ = 11264, NPROJ16 = 1024 * PJ16.n, NPROJ8 = 4096 + 1024 * PJ8.n, GATE_COL0 = 7176;
constexpr int NH = 8, HD = 128, MW = NH * HD;
constexpr int NEXP = 32, NGRP = 4, EPG = 8, DFF = 1024;
constexpr int MAXBLK = 160, MAXROWS = MAXBLK * 256;
constexpr float EPS = 1e-6f;
constexpr float ATT_SCALE = 0.08838834764831845f;

constexpr size_t MiB = 1u << 20, KiB = 1u << 10;
constexpr size_t WS_CTL = 0, CTL_ZERO_BYTES = 128 * KiB;
constexpr size_t WS_RSTD1 = 1 * MiB, WS_LOGF = WS_RSTD1 + 64 * KiB, WS_CUM = WS_LOGF + 512 * KiB, WS_RSTD2 = WS_CUM + 512 * KiB,
                 WS_AE = WS_RSTD2 + 64 * KiB, WS_ASLOT = WS_AE + 128 * KiB, WS_AW = WS_ASLOT + 128 * KiB, WS_TOKROW = WS_AW + 128 * KiB, WS_ROWSCALE = WS_TOKROW + 128 * KiB;
static_assert(WS_ROWSCALE + MAXROWS * 4 <= 4 * MiB, "small arrays");
constexpr size_t WS_DEC = 5 * MiB;
constexpr size_t WS_TLIST = 6 * MiB, WS_SLOTRS = 8 * MiB;
constexpr size_t WS_WR = 4 * MiB;
constexpr size_t WS_WIN = 16 * MiB, WS_PAB = 60 * MiB, WS_WOUT = 68 * MiB, WS_W13 = 76 * MiB, WS_W2 = 204 * MiB, WS_ARENA = 268 * MiB;
constexpr size_t AR(size_t m) { return WS_ARENA + m * MiB; }
constexpr size_t WS_GT = AR(0);
constexpr size_t WS_HG = AR(128);
constexpr size_t WS_QKV = AR(256);
constexpr size_t WS_OAB = AR(512);
constexpr size_t WS_U = AR(384), WS_S = AR(448);
constexpr size_t WS_X8 = AR(448);
constexpr size_t WS_WIN8 = AR(480);
constexpr size_t WS_XB = AR(576);
constexpr size_t WS_OBF = AR(384);
constexpr size_t WS_MRG = AR(384);
constexpr size_t WS_X1B = AR(0);
constexpr size_t WS_X1F8 = AR(64);
constexpr size_t WS_XBUF = AR(64);
constexpr size_t WS_HBUF = AR(224);
constexpr size_t WS_YBUF = AR(304);
constexpr size_t WS_END = AR(640);
static_assert(WS_END <= 1024 * MiB, "d_ws map");
constexpr int CW_TMO = 0, CW_CODE = 1, CW_BAR = 4096, CW_CNT = 16384, CW_NRM = 16512, CW_QUEUE = 16832, CW_CONVQ = 16896, CW_P1STOP = 16960, CW_HB = 17408, CW_SCAN = 28672;

constexpr int RING_OFF = 0, RING_BYTES = 131072;
constexpr int LDSCTL_OFF = RING_BYTES, MISC_OFF = LDSCTL_OFF + 320;
constexpr int MOE_TAB_OFF = MISC_OFF + 128;
constexpr int PARK_OFF = MOE_TAB_OFF + 1024;
constexpr int LDS_BYTES = 147456;
static_assert(PARK_OFF % 16 == 0 && PARK_OFF + 8192 <= LDS_BYTES, "LDS map");
static_assert(MOE_TAB_OFF + (33 + 1 + 160 + 32) * 4 <= LDS_BYTES, "LDS map");

#define GAS __attribute__((address_space(1)))
#define LAS __attribute__((address_space(3)))
typedef unsigned short bf16;
#if P5_F8
typedef unsigned char OAB_t;
#else
typedef unsigned short OAB_t;
#endif
typedef unsigned v4u __attribute__((ext_vector_type(4)));
typedef unsigned v2u __attribute__((ext_vector_type(2)));
typedef float f32x4 __attribute__((ext_vector_type(4)));
typedef float f32x2v __attribute__((ext_vector_type(2)));
typedef short bf16x8 __attribute__((ext_vector_type(8)));
typedef GAS unsigned gu32;
#define RLX_AGENT __ATOMIC_RELAXED, __HIP_MEMORY_SCOPE_AGENT
#define LDS_WAIT() asm volatile("s_waitcnt lgkmcnt(0)" ::: "memory")
#define VM_WAIT() asm volatile("s_waitcnt vmcnt(0)" ::: "memory")
__device__ __forceinline__ float bflo(unsigned u) { return __uint_as_float(u << 16); }
__device__ __forceinline__ float bfhi(unsigned u) { return __uint_as_float(u & 0xffff0000u); }
__device__ __forceinline__ float bf1(bf16 h) { return __uint_as_float((unsigned)h << 16); }
__device__ __forceinline__ unsigned pk2(float lo, float hi) { unsigned r; asm volatile("v_cvt_pk_bf16_f32 %0, %1, %2" : "=v"(r) : "v"(lo), "v"(hi)); return r; }
__device__ __forceinline__ float sigm(float x) { return 1.0f / (1.0f + __expf(-x)); }
template <int CTRL> __device__ __forceinline__ float dpp_f(float v) { return __builtin_bit_cast(float, __builtin_amdgcn_update_dpp(0, __builtin_bit_cast(int, v), CTRL, 0xF, 0xF, true)); }
__device__ __forceinline__ float wave_sum(float v) {
    v += dpp_f<0xB1>(v); v += dpp_f<0x4E>(v); v += dpp_f<0x141>(v); v += dpp_f<0x140>(v);
    v += __shfl_xor(v, 16); v += __shfl_xor(v, 32);
    return v;
}
template <int CTRL> __device__ __forceinline__ int dpp_i(int v) { return __builtin_amdgcn_update_dpp(0, v, CTRL, 0xF, 0xF, true); }
__device__ __forceinline__ int wave_isum(int v) { v += dpp_i<0xB1>(v); v += dpp_i<0x4E>(v); v += dpp_i<0x141>(v); v += dpp_i<0x140>(v); v += __shfl_xor(v, 16); v += __shfl_xor(v, 32); return v; }
__device__ __forceinline__ float wave_fmax(float v) { v = fmaxf(v, dpp_f<0xB1>(v)); v = fmaxf(v, dpp_f<0x4E>(v)); v = fmaxf(v, dpp_f<0x141>(v)); v = fmaxf(v, dpp_f<0x140>(v)); v = fmaxf(v, __shfl_xor(v, 16)); v = fmaxf(v, __shfl_xor(v, 32)); return v; }
#define XB_TMO      128
#define XB_XCNT(j)  (256  + 64 * (j))
#define XB_XSUB(j)  (1280 + 64 * (j))
#define XB_XGEN(j)  (2304 + 64 * (j))
#define XB_TOP      3328
#define XB_TOPGEN   3392
#define XCD_BAR_WORDS 3456
#define XB_SPIN_CAP (1u << 18)

__device__ __forceinline__ unsigned xb_ld(unsigned* p)              { return __hip_atomic_load(p, __ATOMIC_RELAXED, __HIP_MEMORY_SCOPE_AGENT); }
__device__ __forceinline__ unsigned xb_add(unsigned* p, unsigned v) { return __hip_atomic_fetch_add(p, v, __ATOMIC_RELAXED, __HIP_MEMORY_SCOPE_AGENT); }
__device__ __forceinline__ unsigned xb_xcc_id() { return (unsigned)__builtin_amdgcn_s_getreg((3 << 11) | 20) & 0xFu; }
#define XB_SPIN(cond, bar) do { unsigned _sp = 0; while (cond) { __builtin_amdgcn_s_sleep(1); \
    if ((++_sp & 255u) == 0u) { if (xb_ld(&(bar)[XB_TMO])) break; if (_sp > XB_SPIN_CAP) { atomicAdd(&(bar)[XB_TMO], 1u); break; } } } } while (0)

struct XcdBarrier {
    unsigned* bar; unsigned x;
    volatile LAS unsigned* st;
};

__device__ __forceinline__ XcdBarrier xcd_barrier_post(unsigned* bar, volatile LAS unsigned* st) {
    XcdBarrier b; b.bar = bar; b.x = xb_xcc_id(); b.st = st;
    if (threadIdx.x == 0) (void)xb_add(&bar[XB_XCNT(b.x)], 1u);
    return b;
}
__device__ __forceinline__ void xcd_barrier_complete(unsigned* bar, unsigned x, unsigned& nloc, unsigned& nx) {
    const unsigned G = gridDim.x * gridDim.y * gridDim.z;
    unsigned sum, cnt, mine, sp = 0u;
    for (;;) {
        sum = 0u; cnt = 0u; mine = 0u;
#pragma unroll
        for (unsigned j = 0; j < 16; ++j) { const unsigned c = xb_ld(&bar[XB_XCNT(j)]); sum += c; cnt += (c > 0u) ? 1u : 0u; mine = (j == x) ? c : mine; }
        if (sum == G) break;
        __builtin_amdgcn_s_sleep(1);
        if ((++sp & 255u) == 0u) { if (xb_ld(&bar[XB_TMO])) break; if (sp > XB_SPIN_CAP) { atomicAdd(&bar[XB_TMO], 1u); break; } }
    }
    nloc = mine > 0u ? mine : 1u; nx = cnt > 0u ? cnt : 1u;
}

__device__ __forceinline__ void xcd_barrier(const XcdBarrier& b) {
    asm volatile("s_waitcnt vmcnt(0)" ::: "memory");
    __syncthreads();
    if (threadIdx.x == 0) {
        unsigned* bar = b.bar;
        __builtin_amdgcn_s_waitcnt(0);
        unsigned nloc = b.st[0], nx = b.st[1];
        if (nloc == 0u) { xcd_barrier_complete(bar, b.x, nloc, nx); b.st[0] = nloc; b.st[1] = nx; }
        const unsigned old = xb_add(&bar[XB_XSUB(b.x)], 1u);
        const unsigned gen = old / nloc;
        if (old + 1u == (gen + 1u) * nloc) {
            __builtin_amdgcn_fence(__ATOMIC_RELEASE, "agent");
            asm volatile("s_waitcnt vmcnt(0)" ::: "memory");
            const unsigned og = xb_add(&bar[XB_TOP], 1u);
            const unsigned tg = og / nx;
            if (og + 1u == (tg + 1u) * nx) xb_add(&bar[XB_TOPGEN], 1u);
            else XB_SPIN(xb_ld(&bar[XB_TOPGEN]) == tg, bar);
            __builtin_amdgcn_fence(__ATOMIC_ACQUIRE, "agent");
            xb_add(&bar[XB_XGEN(b.x)], 1u);
            asm volatile("s_waitcnt vmcnt(0)" ::: "memory");
        } else {
            XB_SPIN(xb_ld(&bar[XB_XGEN(b.x)]) == gen, bar);
            __builtin_amdgcn_fence(__ATOMIC_ACQUIRE, "agent");
            asm volatile("s_waitcnt vmcnt(0)" ::: "memory");
        }
    }
    __syncthreads();
}

#include <hip/hip_bf16.h>
namespace fox {
constexpr int D = 128, OSTRIDE = 2048;
constexpr float THR = 8.f;
constexpr bool WSKIP = false;
constexpr float SCALE = 0.08838834764831845f;
constexpr int NW = 8, QBLK = 32, KVBLK = 64, QB = NW * QBLK;
constexpr int SHM_V = KVBLK * D * 2, SHM_K = KVBLK * D * 2;
constexpr int ATT_LDS = 2 * SHM_V + 2 * SHM_K + NW * 64 * 4;
constexpr int LDS_CUM = ATT_LDS, LDS_KB = ATT_LDS + 16384, ATT_LDS_TOTAL = ATT_LDS + 32768;

using bf16 = __hip_bfloat16;
typedef short bf16x8 __attribute__((ext_vector_type(8)));
typedef short s16x4 __attribute__((ext_vector_type(4)));
typedef float f32x16 __attribute__((ext_vector_type(16)));
typedef float f32x4 __attribute__((ext_vector_type(4)));
typedef unsigned u32x4 __attribute__((ext_vector_type(4)));
template <class A, class Bt> struct same_t { static constexpr bool v = false; };
template <class A> struct same_t<A, A> { static constexpr bool v = true; };

#define KSWZ(row, colB) ((row) * 256 + ((colB) ^ (((row) & 7) << 4)))
#define SBAR() __builtin_amdgcn_sched_barrier(0)
__device__ __forceinline__ int v_st(int k, int c) { const int kk = (k & ~0xC) | ((k & 4) << 1) | ((k & 8) >> 1); return ((kk >> 3) * 4 + (c >> 5)) * 512 + ((kk & 7) * 32 + (c & 31)) * 2; }
__device__ __forceinline__ int v_rd_base(int lane) { return ((lane & 3) << 3) | (((lane >> 2) & 3) << 6) | (((lane >> 4) & 1) << 5) | (((lane >> 5) & 1) << 8); }
constexpr int v_rd_off(int d0, int ks, int half) { return d0 * 512 + ks * 4096 + half * 2048; }
__device__ __forceinline__ int crow(int r, int hi) { return (r & 3) + 8 * (r >> 2) + 4 * hi; }
__device__ __forceinline__ unsigned cvtpk(float lo, float hi) {
    typedef float f2_t __attribute__((ext_vector_type(2))); typedef __bf16 b2_t __attribute__((ext_vector_type(2)));
    const f2_t v = {lo, hi}; const b2_t b = __builtin_convertvector(v, b2_t); return __builtin_bit_cast(unsigned, b);
}
__device__ __forceinline__ bf16x8 pack8(f32x4 a, f32x4 b) {
    u32x4 w = {cvtpk(a[0], a[1]), cvtpk(a[2], a[3]), cvtpk(b[0], b[1]), cvtpk(b[2], b[3])};
    return *reinterpret_cast<bf16x8*>(&w);
}
template <class T> __device__ __forceinline__ bf16x8 load8(const T* p) {
    if constexpr (same_t<T, float>::v) { return pack8(*(const f32x4*)p, *(const f32x4*)(p + 4)); }
    else { return *reinterpret_cast<const bf16x8*>(p); }
}
__device__ __forceinline__ void mask_tile(f32x16& p0, f32x16& p1, int dq, unsigned W) {
    const float NEG = -__builtin_inff();
#pragma unroll
    for (int r = 0; r < 16; ++r) {
        const int c = (r & 3) + 8 * (r >> 2);
        if ((unsigned)(dq - c) >= W) p0[r] = NEG;
        if ((unsigned)(dq - c - 32) >= W) p1[r] = NEG;
    }
}
__device__ __forceinline__ void partialSM(f32x16& p0, f32x16& p1, float& m_reg, float& mn, float& alpha) {
    float pmax = p0[0]; for (int r = 1; r < 16; ++r) pmax = fmaxf(pmax, p0[r]); for (int r = 0; r < 16; ++r) pmax = fmaxf(pmax, p1[r]);
    { auto rr = __builtin_amdgcn_permlane32_swap(__float_as_uint(pmax), __float_as_uint(pmax), false, false);
      pmax = fmaxf(__uint_as_float(rr[0]), __uint_as_float(rr[1])); }
    constexpr float C2 = 1.4426950408889634f * SCALE;
    if (__builtin_expect(__all((pmax - m_reg) * SCALE <= THR), 1)) { mn = m_reg; alpha = 1.f; }
    else { mn = fmaxf(m_reg, pmax); alpha = __builtin_amdgcn_exp2f((m_reg - mn) * C2); m_reg = mn; }
    const float mnL = -mn * C2;
    for (int r = 0; r < 16; ++r) p0[r] = fmaf(p0[r], C2, mnL); for (int r = 0; r < 16; ++r) p1[r] = fmaf(p1[r], C2, mnL);
    for (int r = 0; r < 16; ++r) p0[r] = __builtin_amdgcn_exp2f(p0[r]);
}
__device__ __forceinline__ void finishSM(f32x16& p0, f32x16& p1, float alpha, float& l_reg, bf16x8& pa0, bf16x8& pa1, bf16x8& pa2, bf16x8& pa3) {
    for (int r = 0; r < 16; ++r) p1[r] = __builtin_amdgcn_exp2f(p1[r]);
    float ps = 0; for (int r = 0; r < 16; ++r) ps += p0[r]; for (int r = 0; r < 16; ++r) ps += p1[r];
    { auto rr = __builtin_amdgcn_permlane32_swap(__float_as_uint(ps), __float_as_uint(ps), false, false);
      ps = __uint_as_float(rr[0]) + __uint_as_float(rr[1]); }
    l_reg = l_reg * alpha + ps;
#define PK4(P, B_, OUT) do { unsigned a0 = cvtpk(P[B_+0], P[B_+1]), a1 = cvtpk(P[B_+2], P[B_+3]);                          \
        unsigned b0 = cvtpk(P[B_+4], P[B_+5]), b1 = cvtpk(P[B_+6], P[B_+7]);                                             \
        auto r0 = __builtin_amdgcn_permlane32_swap(a0, b0, false, false); auto r1 = __builtin_amdgcn_permlane32_swap(a1, b1, false, false); \
        u32x4 w = {r0[0], r1[0], r0[1], r1[1]}; OUT = *reinterpret_cast<bf16x8*>(&w); } while (0)
    PK4(p0, 0, pa0); PK4(p0, 8, pa1); PK4(p1, 0, pa2); PK4(p1, 8, pa3);
#undef PK4
}
template <int KB, bool SK>
__device__ __forceinline__ void qkt(f32x16& p0, f32x16& p1, const char* K_lds, int r32, int hi, const bf16x8* qr, bool act, const float* kbt  ) {
    if (SK && !act) { const float NEG = -__builtin_inff();
#pragma unroll
        for (int r = 0; r < 16; ++r) { p0[r] = NEG; p1[r] = NEG; } return; }
#pragma unroll
    for (int g = 0; g < 4; ++g) { const f32x4 a = *(const f32x4*)(kbt + 8 * g), b = *(const f32x4*)(kbt + 32 + 8 * g);
        p0[4 * g] = a[0]; p0[4 * g + 1] = a[1]; p0[4 * g + 2] = a[2]; p0[4 * g + 3] = a[3]; p1[4 * g] = b[0]; p1[4 * g + 1] = b[1]; p1[4 * g + 2] = b[2]; p1[4 * g + 3] = b[3]; }
    const char* kb[4];
#pragma unroll
    for (int dd = 0; dd < 4; ++dd) kb[dd] = K_lds + KB * SHM_K + KSWZ(r32, (dd * 16 + hi * 8) * 2);
#pragma unroll
    for (int d0 = 0; d0 < 8; ++d0) { const char* a = kb[d0 & 3] + (d0 >> 2) * 128;
        bf16x8 b0 = *reinterpret_cast<const bf16x8*>(a);
        bf16x8 b1 = *reinterpret_cast<const bf16x8*>(a + 32 * 256);
        p0 = __builtin_amdgcn_mfma_f32_32x32x16_bf16(b0, qr[d0], p0, 0, 0, 0);
        p1 = __builtin_amdgcn_mfma_f32_32x32x16_bf16(b1, qr[d0], p1, 0, 0, 0); }
}
template <int VB, bool SK>
__device__ __forceinline__ void pv_tile(f32x16* o, int vb0, bf16x8 pa0, bf16x8 pa1, bf16x8 pa2, bf16x8 pa3, bool act) {
    if (SK && !act) return;
#define TRRD(dst, off) asm volatile("ds_read_b64_tr_b16 %0, %1 offset:%2" : "=&v"(dst) : "v"(vb0), "i"(off) : "memory")
#define PV_D0(d0) do { s16x4 l0, l1, l2, l3, h0, h1, h2, h3; constexpr int b_ = VB * SHM_V + v_rd_off(d0, 0, 0);     \
        TRRD(l0, b_); TRRD(h0, b_ + 2048); TRRD(l1, b_ + 4096); TRRD(h1, b_ + 6144); TRRD(l2, b_ + 8192); TRRD(h2, b_ + 10240); TRRD(l3, b_ + 12288); TRRD(h3, b_ + 14336); \
        asm volatile("s_waitcnt lgkmcnt(0)" ::: "memory"); SBAR();                 \
        o[d0] = __builtin_amdgcn_mfma_f32_32x32x16_bf16(pa0, (bf16x8){l0[0], l0[1], l0[2], l0[3], h0[0], h0[1], h0[2], h0[3]}, o[d0], 0, 0, 0);   \
        o[d0] = __builtin_amdgcn_mfma_f32_32x32x16_bf16(pa1, (bf16x8){l1[0], l1[1], l1[2], l1[3], h1[0], h1[1], h1[2], h1[3]}, o[d0], 0, 0, 0);   \
        o[d0] = __builtin_amdgcn_mfma_f32_32x32x16_bf16(pa2, (bf16x8){l2[0], l2[1], l2[2], l2[3], h2[0], h2[1], h2[2], h2[3]}, o[d0], 0, 0, 0);   \
        o[d0] = __builtin_amdgcn_mfma_f32_32x32x16_bf16(pa3, (bf16x8){l3[0], l3[1], l3[2], l3[3], h3[0], h3[1], h3[2], h3[3]}, o[d0], 0, 0, 0); } while (0)
    PV_D0(0); PV_D0(1); PV_D0(2); PV_D0(3);
#undef PV_D0
#undef TRRD
}

template <int CTRL> __device__ __forceinline__ float dppq(float v) { return __builtin_bit_cast(float, __builtin_amdgcn_update_dpp(0, __builtin_bit_cast(int, v), CTRL, 0xF, 0xF, true)); }
template <class TIn, class TOut> struct BlockRef { unsigned Q, K, V; TOut* O; int P0; int jlo; };
typedef __amdgpu_buffer_rsrc_t rsrc_t;
#define BL8(soff, voff) __builtin_bit_cast(bf16x8, __builtin_amdgcn_raw_buffer_load_b128(rs, (int)(voff), (int)(soff), 0))
template <class TIn> struct Seam {
    bf16x8 qr[8];
    bf16x8 st_v0, st_v1, st_k0, st_k1; f32x4 sf0, sf1, sf2, sf3;
    f32x4 tq[16];
};
__device__ __forceinline__ int swa_jlo(int P0, int W) { const int lowk = P0 - W + 1; return lowk > 0 ? lowk / KVBLK : 0; }
#define ROW(p, k0, rr) ((const TIn*)((const char*)((p) + (size_t)(k0) * D) + (unsigned)(((rr) * D + sc) * (int)sizeof(TIn))))
#define VMW() asm volatile("s_waitcnt vmcnt(0)" ::: "memory")
#define VMWN(n) asm volatile("s_waitcnt vmcnt(%0)" :: "i"(n) : "memory")
#define SLOAD_H(Kp, Vp, k0) do { S.st_v0 = BL8((Vp) + (unsigned)(k0) * 256u, vo); S.st_v1 = BL8((Vp) + (unsigned)(k0) * 256u + 8192u, vo);              \
                         S.st_k0 = BL8((Kp) + (unsigned)(k0) * 256u, vo); S.st_k1 = BL8((Kp) + (unsigned)(k0) * 256u + 8192u, vo); } while (0)
#define SWRITE_HK(bf) do { *(bf16x8*)(K_lds + (bf) * SHM_K + kws) = S.st_k0; *(bf16x8*)(K_lds + (bf) * SHM_K + kws + 32 * 256) = S.st_k1; } while (0)
#define SWRITE_HV(bf) do { *(bf16x8*)(V_lds + (bf) * SHM_V + vst0) = S.st_v0; *(bf16x8*)(V_lds + (bf) * SHM_V + vst1) = S.st_v1; } while (0)
#define SWRITE_H(bf) do { SWRITE_HV(bf); SWRITE_HK(bf); } while (0)
#define SLOAD_F(p, k0) do { S.sf0 = *(const f32x4*)ROW(p, k0, sr); S.sf1 = *(const f32x4*)(ROW(p, k0, sr) + 4);                \
                            S.sf2 = *(const f32x4*)ROW(p, k0, 32 + sr); S.sf3 = *(const f32x4*)(ROW(p, k0, 32 + sr) + 4); } while (0)
#define SWRITE_KF(bf) do { *(bf16x8*)(K_lds + (bf) * SHM_K + kws) = pack8(S.sf0, S.sf1); *(bf16x8*)(K_lds + (bf) * SHM_K + kws + 32 * 256) = pack8(S.sf2, S.sf3); } while (0)
#define SWRITE_VF(bf) do { *(bf16x8*)(V_lds + (bf) * SHM_V + vst0) = pack8(S.sf0, S.sf1); *(bf16x8*)(V_lds + (bf) * SHM_V + vst1) = pack8(S.sf2, S.sf3); } while (0)
template <class TIn, class TOut>
__device__ __forceinline__ void causal_swa_prime(const rsrc_t rs, const BlockRef<TIn, TOut>& cur, int W, char* lds, Seam<TIn>& S) {
    constexpr bool F32 = false; static_assert(!same_t<TIn, float>::v, "bf16 q/k/v only in this build");
    int tid = threadIdx.x; asm volatile("" : "+v"(tid));
    const int wid = __builtin_amdgcn_readfirstlane(tid >> 6), lane = tid & 63, r32 = lane & 31, hi = lane >> 5;
    const int sr = tid >> 4, sc = (tid & 15) * 8, kws = KSWZ(sr, sc * 2), vo = (sr * D + sc) * 2; char* K_lds = lds + 2 * SHM_V;
    const int kb0 = cur.jlo * KVBLK;
    for (int d0 = 0; d0 < 8; ++d0) S.qr[d0] = BL8(cur.Q + (unsigned)(wid * QBLK * 256 + d0 * 32), (r32 * D + hi * 8) * 2);
    if constexpr (F32) { SLOAD_F((const float*)nullptr, kb0); VMW(); SWRITE_KF(0); SBAR(); SLOAD_F((const float*)nullptr, kb0); }
    else { SLOAD_H(cur.K, cur.V, kb0); VMW(); SWRITE_HK(0); }
    __syncthreads();
}
template <class TIn, class TOut>
__device__ __forceinline__ void causal_swa_block(const rsrc_t rs, const BlockRef<TIn, TOut>& cur, const BlockRef<TIn, TOut>& nxt, int skv, int W, char* lds, Seam<TIn>& S) {
    constexpr bool F32 = false; static_assert(!same_t<TIn, float>::v, "bf16 q/k/v only in this build");
    int tid = threadIdx.x; asm volatile("" : "+v"(tid));
    const int wid = __builtin_amdgcn_readfirstlane(tid >> 6), lane = tid & 63, r32 = lane & 31, hi = lane >> 5;
    const int j_lo = cur.jlo;
    int j_hi = (cur.P0 + QB - 1) / KVBLK + 1; if (j_hi > skv / KVBLK) j_hi = skv / KVBLK;
    const int NT = j_hi - j_lo;
    const int kbn = nxt.jlo * KVBLK;
    const int qlo = cur.P0 + wid * QBLK, qm = qlo + r32 - 4 * hi;
    char* V_lds = lds; char* K_lds = lds + 2 * SHM_V;
    float* ws = (float*)(lds + 2 * SHM_V + 2 * SHM_K) + wid * 64; float* li_l = ws, * al_l = ws + 32;
    const float* kbl = (const float*)(lds + LDS_KB) + 4 * hi;
    float m_reg = -1e30f, l_reg = 0; f32x16 o[4] = {};
    const int sr = tid >> 4, sc = (tid & 15) * 8, vst0 = v_st(sr, sc), vst1 = v_st(32 + sr, sc), kws = KSWZ(sr, sc * 2), vo = (sr * D + sc) * 2;
    const int vb0 = (int)(uintptr_t)V_lds + v_rd_base(lane);
    const unsigned Kh = cur.K, Vh = cur.V;
#define RESC(a) do { if (__any((a) < 1.f)) { if (hi == 0) al_l[r32] = (a); asm volatile("s_waitcnt lgkmcnt(0)" ::: "memory");              \
                     for (int d_ = 0; d_ < 4; ++d_) for (int r = 0; r < 16; ++r) o[d_][r] *= al_l[crow(r, hi)]; } } while (0)
#define KBASE(t) ((j_lo + (t)) * KVBLK)
#define ACT(t) (KBASE(t) <= qlo + QBLK - 1 && KBASE(t) + KVBLK - 1 >= qlo - W + 1)
#define MASKT(P0_, P1_, t) do { const int kb_ = KBASE(t); if ((!SK || ACT(t)) && (kb_ + KVBLK - 1 > qlo || kb_ <= qlo + QBLK - 1 - W)) mask_tile(P0_, P1_, qm - kb_, (unsigned)W); } while (0)
    constexpr int NQL = F32 ? 16 : 8;
    constexpr bool SK = WSKIP && !F32;
#define SEAM_K0() do { VMWN(NQL); if constexpr (F32) { SWRITE_KF(0); SBAR(); SLOAD_F((const float*)nullptr, kbn); } else { SWRITE_HK(0); } SBAR(); } while (0)
    f32x16 pA0, pA1, pB0, pB1; float mnA, mnB, alA, alB; bf16x8 pa0, pa1, pa2, pa3;
    if constexpr (F32) { VMW(); SWRITE_VF(0); SBAR(); } else { SWRITE_HV(0); SBAR(); }
    if (NT > 1) { if constexpr (F32) SLOAD_F((const float*)nullptr, KBASE(1)); else SLOAD_H(Kh, Vh, KBASE(1)); }
    SBAR(); qkt<0, SK>(pA0, pA1, K_lds, r32, hi, S.qr, ACT(0), kbl + KBASE(0));
    if constexpr (F32) { if (NT > 1) { VMW(); SWRITE_KF(1); SBAR(); SLOAD_F((const float*)nullptr, KBASE(1)); } }
    MASKT(pA0, pA1, 0); partialSM(pA0, pA1, m_reg, mnA, alA);
    if (NT > 1) { VMW(); if constexpr (F32) { SWRITE_VF(1); SBAR(); if (NT > 2) SLOAD_F((const float*)nullptr, KBASE(2)); } else SWRITE_H(1); }
    __syncthreads();
#define HALF_STEP(PX0, PX1, mnX, alX, PY0, PY1, alY, t, KB, VB, SB) do {                                                      \
        SBAR(); qkt<KB, SK>(PX0, PX1, K_lds, r32, hi, S.qr, ACT(t), kbl + KBASE(t));                                             \
        finishSM(PY0, PY1, alY, l_reg, pa0, pa1, pa2, pa3); SBAR();                                                           \
        if ((t) + 1 < NT) { if constexpr (F32) { VMW(); SWRITE_KF(SB); SBAR(); SLOAD_F((const float*)nullptr, KBASE((t) + 1)); }  \
                            else { SLOAD_H(Kh, Vh, KBASE((t) + 1)); } SBAR(); }                                               \
        pv_tile<VB, SK>(o, vb0, pa0, pa1, pa2, pa3, ACT((t) - 1)); MASKT(PX0, PX1, (t)); partialSM(PX0, PX1, m_reg, mnX, alX);                                        \
        __syncthreads();                                                                                                      \
        if ((t) + 1 < NT) { VMW(); if constexpr (F32) { SWRITE_VF(SB); SBAR(); if ((t) + 2 < NT) SLOAD_F((const float*)nullptr, KBASE((t) + 2)); } \
                            else { SWRITE_H(SB); } }                                                                          \
        RESC(alX); __syncthreads(); } while (0)
    for (int t = 1; t + 1 < NT; t += 2) {
        HALF_STEP(pB0, pB1, mnB, alB, pA0, pA1, alA, t, 1, 0, 0);
        HALF_STEP(pA0, pA1, mnA, alA, pB0, pB1, alB, t + 1, 0, 1, 1);
    }
    const bool even = (NT & 1) == 0;
    if (even) { SBAR(); qkt<1, SK>(pB0, pB1, K_lds, r32, hi, S.qr, ACT(NT - 1), kbl + KBASE(NT - 1)); SBAR(); }
#define QROW(e) ((const float*)nullptr + (size_t)(wid * QBLK + r32) * D + ((e) >> 1) * 16 + hi * 8 + ((e) & 1) * 4)
    if constexpr (F32) { SLOAD_F((const float*)nullptr, kbn); SBAR();
#pragma unroll
        for (int e = 0; e < 8; ++e) S.tq[e] = *(const f32x4*)QROW(e); }
    else { SLOAD_H(nxt.K, nxt.V, kbn); SBAR();
#pragma unroll
        for (int d0 = 0; d0 < 8; ++d0) S.qr[d0] = BL8(nxt.Q + (unsigned)(wid * QBLK * 256 + d0 * 32), (r32 * D + hi * 8) * 2); }
    SBAR();
    finishSM(pA0, pA1, alA, l_reg, pa0, pa1, pa2, pa3); SBAR();
    if constexpr (F32) {
#pragma unroll
        for (int e = 8; e < 16; ++e) S.tq[e] = *(const f32x4*)QROW(e); SBAR(); }
#undef QROW
    pv_tile<0, SK>(o, vb0, pa0, pa1, pa2, pa3, ACT(even ? NT - 2 : NT - 1));
    if (even) { MASKT(pB0, pB1, NT - 1); partialSM(pB0, pB1, m_reg, mnB, alB); __syncthreads(); RESC(alB);
        finishSM(pB0, pB1, alB, l_reg, pa0, pa1, pa2, pa3); SBAR(); pv_tile<1, SK>(o, vb0, pa0, pa1, pa2, pa3, ACT(NT - 1)); }
    SBAR(); SEAM_K0();
    if (hi == 0) li_l[r32] = l_reg; asm volatile("s_waitcnt lgkmcnt(0)" ::: "memory");
    float rli[16];
#pragma unroll
    for (int r = 0; r < 16; ++r) rli[r] = __builtin_amdgcn_rcpf(li_l[crow(r, hi)]);
    TOut* Ow = cur.O + (size_t)(wid * QBLK) * OSTRIDE;
#pragma unroll
    for (int r = 0; r < 16; ++r) { const int orow = crow(r, hi);
#pragma unroll
        for (int d0 = 0; d0 < 4; ++d0) { const float v = o[d0][r] * rli[r];
            if constexpr (same_t<TOut, float>::v) { Ow[(size_t)orow * OSTRIDE + d0 * 32 + r32] = v; }
            else if constexpr (same_t<TOut, unsigned char>::v) { const float v16 = 16.f * v, v1 = dppq<0xB1>(v16), v2 = dppq<0x4E>(v16), v3 = dppq<0x1B>(v16);
                   if ((r32 & 3) == 0) *(unsigned*)(Ow + (size_t)orow * OSTRIDE + d0 * 32 + r32) = pg8::pk4_fp8(v16, v1, v2, v3); }
            else { const float vn = dppq<0xB1>(v);
                   if ((r32 & 1) == 0) *(unsigned*)(Ow + (size_t)orow * OSTRIDE + d0 * 32 + r32) = cvtpk(v, vn); } } }
    if constexpr (F32) {
#pragma unroll
        for (int d0 = 0; d0 < 8; ++d0) S.qr[d0] = pack8(S.tq[2 * d0], S.tq[2 * d0 + 1]); }
    __syncthreads();
#undef RESC
#undef KBASE
#undef ACT
#undef MASKT
#undef SEAM_K0
#undef HALF_STEP
}
#undef ROW
#undef VMW
#undef VMWN
#undef SLOAD_H
#undef SWRITE_HK
#undef SWRITE_HV
#undef SWRITE_H
#undef SLOAD_F
#undef SWRITE_KF
#undef SWRITE_VF

}

struct Frame {
    LAS unsigned char* lds;
    volatile LAS unsigned* MISC;
    gu32* ctl;
    unsigned char* ws;
    int tid, lane, wave;
    int vcu, G;
    const float* const* in;
    float* out;
};

__device__ __forceinline__ void cvt_load(f32x4 (&v)[16], const float* src  , size_t ld, int rq, int nq) {
#pragma unroll
    for (int i = 0; i < 8; ++i) { const float* p = src + (size_t)(8 * i + 2 * rq) * ld + 4 * nq; v[2 * i] = __builtin_nontemporal_load((const f32x4*)p); v[2 * i + 1] = __builtin_nontemporal_load((const f32x4*)(p + ld)); }
}
__device__ __forceinline__ void cvt_store(const f32x4 (&v)[16], const f32x2v (&sc)[8], bool scaled, LAS unsigned* tile, bf16* dst  , int K, int lane, int rq, int nq) {
#pragma unroll
    for (int i = 0; i < 8; ++i) { f32x4 a = v[2 * i], b = v[2 * i + 1]; if (scaled) { a = a * sc[i].x; b = b * sc[i].y; }
#pragma unroll
        for (int j = 0; j < 4; ++j) tile[(4 * nq + j) * 33 + 4 * i + rq] = pk2(a[j], b[j]); }
    LDS_WAIT(); asm volatile("" ::: "memory");
    const int nr = lane >> 3, ch = lane & 7;
#pragma unroll
    for (int q = 0; q < 8; ++q) { const LAS unsigned* s = tile + (8 * q + nr) * 33 + 4 * ch; v4u o; o.x = s[0]; o.y = s[1]; o.z = s[2]; o.w = s[3];
        *(v4u*)(dst + (size_t)(8 * q + nr) * K + 8 * ch) = o; }
    LDS_WAIT(); asm volatile("" ::: "memory");
}
__device__ __forceinline__ void cvt_item(const float* src0, const float* src1, size_t ld_src, bf16* dst, int K, const float* scale  , LAS unsigned* tile, int lane) {
    const int rq = lane >> 4, nq = lane & 15;
    f32x2v sc[8];
    if (scale) {
#pragma unroll
        for (int i = 0; i < 8; ++i) sc[i] = *(const f32x2v*)(scale + 8 * i + 2 * rq);
    }
    f32x4 va[16], vb[16];
    cvt_load(va, src0, ld_src, rq, nq);
    cvt_load(vb, src0 + 64, ld_src, rq, nq);
    cvt_store(va, sc, scale != nullptr, tile, dst, K, lane, rq, nq);
    cvt_load(va, src1, ld_src, rq, nq);
    cvt_store(vb, sc, scale != nullptr, tile, dst + (size_t)64 * K, K, lane, rq, nq);
    cvt_load(vb, src1 + 64, ld_src, rq, nq);
    cvt_store(va, sc, scale != nullptr, tile, dst + (size_t)128 * K, K, lane, rq, nq);
    cvt_store(vb, sc, scale != nullptr, tile, dst + (size_t)192 * K, K, lane, rq, nq);
}
__device__ __forceinline__ void cvt8_load(f32x4 (&v)[16], const float* src  , size_t ld, int rq, int nq) {
#pragma unroll
    for (int i = 0; i < 4; ++i)
#pragma unroll
        for (int r = 0; r < 4; ++r) v[4 * i + r] = __builtin_nontemporal_load((const f32x4*)(src + (size_t)(16 * i + 4 * rq + r) * ld + 4 * nq));
}
__device__ __forceinline__ void cvt8_pack(const f32x4 (&v)[16], const LAS float* scl  , LAS unsigned* tile, int hh, int rq, int nq) {
#pragma unroll
    for (int i = 0; i < 4; ++i) { const f32x4 s4 = *(const LAS f32x4*)(scl + 64 * hh + 16 * i + 4 * rq);
#pragma unroll
        for (int j = 0; j < 4; ++j) tile[(4 * nq + j) * 33 + 16 * hh + 4 * i + rq] = pg8::pk4_fp8(v[4 * i][j] * s4.x, v[4 * i + 1][j] * s4.y, v[4 * i + 2][j] * s4.z, v[4 * i + 3][j] * s4.w); }
}
__device__ __forceinline__ void cvt8_flush(LAS unsigned* tile, unsigned char* dst  , int Kb, int lane, bool stream = false  ) {
    LDS_WAIT(); asm volatile("" ::: "memory");
    const int nr = lane >> 3, ch = lane & 7;
#pragma unroll
    for (int q = 0; q < 8; ++q) { const LAS unsigned* s = tile + (8 * q + nr) * 33 + 4 * ch; v4u o; o.x = s[0]; o.y = s[1]; o.z = s[2]; o.w = s[3];
        if (stream) __builtin_nontemporal_store(o, (v4u*)(dst + (size_t)(8 * q + nr) * Kb + 16 * ch)); else *(v4u*)(dst + (size_t)(8 * q + nr) * Kb + 16 * ch) = o; }
    LDS_WAIT(); asm volatile("" ::: "memory");
}
__device__ __forceinline__ void cvt8_item(const float* src0, const float* src1, size_t ld_src, unsigned char* dst, int Kb, const float* scale, LAS unsigned* tile, LAS float* scl  , int lane, int nsub  ) {
    const int rq = lane >> 4, nq = lane & 15;
    if (lane < 32) { f32x4 s4 = {256.f, 256.f, 256.f, 256.f}; if (scale) s4 = *(const f32x4*)(scale + 4 * lane) * 256.f; *(LAS f32x4*)(scl + 4 * lane) = s4; }
    LDS_WAIT(); asm volatile("" ::: "memory");
    f32x4 va[16], vb[16];
    cvt8_load(va, src0, ld_src, rq, nq); cvt8_load(vb, src0 + 64 * ld_src, ld_src, rq, nq);
#pragma unroll 1
    for (int s = 0; s + 1 < nsub; ++s) {
        const float* nsrc = (s + 1 < 2 ? src0 : src1) + 64 * ((s + 1) & 1);
        cvt8_pack(va, scl, tile, 0, rq, nq); __builtin_amdgcn_sched_barrier(0);
        cvt8_load(va, nsrc, ld_src, rq, nq); __builtin_amdgcn_sched_barrier(0);
        cvt8_pack(vb, scl, tile, 1, rq, nq); __builtin_amdgcn_sched_barrier(0);
        cvt8_load(vb, nsrc + 64 * ld_src, ld_src, rq, nq); __builtin_amdgcn_sched_barrier(0);
        cvt8_flush(tile, dst + (size_t)(64 * s) * Kb, Kb, lane, nsub == 4);
    }
    cvt8_pack(va, scl, tile, 0, rq, nq);
    cvt8_pack(vb, scl, tile, 1, rq, nq);
    cvt8_flush(tile, dst + (size_t)(64 * (nsub - 1)) * Kb, Kb, lane, nsub == 4);
}
constexpr int I_W13 = NEXP * 16 * 8, I_W2 = NEXP * 8 * 8;
__device__ __forceinline__ void cvt8_moe_item(const float* const* in, unsigned char* ws, int r, LAS unsigned* tile, LAS float* scl, int lane) {
    const float* s0; const float* s1; size_t ld; unsigned char* dst8; int K; const float* scale;
    if (r < I_W13) { const int e = r / 128, q = r % 128, kb = q / 8, nb = q % 8, k0 = 128 * kb;
        const size_t so = (size_t)e * DM * DFF + (size_t)k0 * DFF + 128 * nb;
        s0 = in[14] + so; s1 = in[15] + so; ld = DFF; dst8 = ws + WS_W13 + ((size_t)e * 2048 + 256 * nb) * DM + k0; K = DM; scale = in[9] + k0; }
    else { r -= I_W13; const int e = r / 64, q = r % 64, kb = q / 8, nb = q % 8, k0 = 128 * kb, n = 256 * nb;
        s0 = in[16] + (size_t)e * DFF * DM + (size_t)k0 * DM + n; s1 = s0 + 128; ld = DM; dst8 = ws + WS_W2 + ((size_t)e * 2048 + n) * DFF + k0; K = DFF; scale = nullptr; }
    cvt8_item(s0, s1, ld, dst8, K, scale, tile, scl, lane, 4);
}
__device__ __forceinline__ void p0_prologue(Frame& F) {
    const int gw = F.vcu * NWAVES + F.wave, NGW = F.G * NWAVES, lane = F.lane;
    const float* x = F.in[0]; const float* g1 = F.in[1]; const float* w_in = F.in[2]; const float* b_fg = F.in[3];
    LAS float* tb = (LAS float*)(F.lds + RING_OFF);
    for (int k = F.tid; k < DM; k += NWAVES * 64) { const int j = k >> 8, l = (k & 255) >> 2, i = k & 3; const float g = g1[k];
        const f32x4 a = *(const f32x4*)(w_in + (size_t)k * NCOLS + 3072), b = *(const f32x4*)(w_in + (size_t)k * NCOLS + 3076);
        LAS f32x4* d = (LAS f32x4*)(tb + ((j * 4 + i) * 64 + l) * 8); d[0] = a * g; d[1] = b * g; }
    __syncthreads();
    bf16* xb = (bf16*)(F.ws + WS_XB); float* rstd1 = (float*)(F.ws + WS_RSTD1); float* logf = (float*)(F.ws + WS_LOGF);
    for (int m = gw; m < T; m += NGW) {
        const GAS f32x4* xr = (const GAS f32x4*)(x + (size_t)m * DM) + lane;
        f32x4 v[8]; float ss = 0.f;
#pragma unroll
        for (int j = 0; j < 8; ++j) { v[j] = xr[64 * j]; ss += (v[j].x * v[j].x + v[j].y * v[j].y) + (v[j].z * v[j].z + v[j].w * v[j].w); }
        const float rstd = __builtin_amdgcn_rsqf(wave_sum(ss) * (1.0f / DM) + EPS);
        float fa[8];
#pragma unroll
        for (int h = 0; h < 8; ++h) fa[h] = 0.f;
#pragma unroll
        for (int j = 0; j < 8; ++j)
#pragma unroll
            for (int i = 0; i < 4; ++i) { const LAS f32x4* d = (const LAS f32x4*)(tb + ((j * 4 + i) * 64 + lane) * 8); const f32x4 a = d[0], b = d[1]; const float xv = v[j][i];
                fa[0] += xv * a.x; fa[1] += xv * a.y; fa[2] += xv * a.z; fa[3] += xv * a.w; fa[4] += xv * b.x; fa[5] += xv * b.y; fa[6] += xv * b.z; fa[7] += xv * b.w; }
        GAS v2u* o8 = (GAS v2u*)(xb + (size_t)m * DM) + lane; GAS unsigned* o4 = (GAS unsigned*)(F.ws + WS_X8 + (size_t)m * DM) + lane;
#pragma unroll
        for (int j = 0; j < 8; ++j) { v2u w; w.x = pk2(v[j].x, v[j].y); w.y = pk2(v[j].z, v[j].w); o8[64 * j] = w; o4[64 * j] = pg8::pk4_fp8(16.f * v[j].x, 16.f * v[j].y, 16.f * v[j].z, 16.f * v[j].w); }
        float mine = 0.f;
#pragma unroll
        for (int h = 0; h < 8; ++h) { const float s = wave_sum(fa[h]); if (lane == h) mine = s; }
        if (lane == 0) rstd1[m] = rstd;
        if (lane < 8) { const float z = mine * rstd + b_fg[lane];
            const float ez = __expf(-fabsf(z)); const float ls = fminf(z, 0.f) - (ez < 1e-4f ? ez * (1.0f - 0.5f * ez) : __logf(1.0f + ez));
            const int b = m >> 12, s = m & 4095; logf[(size_t)(b * 8 + lane) * SEQ + s] = ls; }
    }
    { bf16* wr = (bf16*)(F.ws + WS_WR); const float* g2 = F.in[9]; const float* wg = F.in[10]; const float* we = F.in[12];
      for (int idx = (F.vcu * NWAVES * 64 + F.tid); idx < 64 * DM; idx += F.G * NWAVES * 64) { const int r = idx >> 11, k = idx & 2047;
          float v = 0.f; if (r < 4) v = wg[k * 4 + r] * g2[k]; else if (r < 36) v = we[k * 32 + (r - 4)] * g2[k];
          wr[idx] = (bf16)(pk2(v, 0.f) & 0xffffu); } }
    __syncthreads();
    LAS unsigned* tile = (LAS unsigned*)(F.lds + RING_OFF) + F.wave * (64 * 33);
    constexpr int NT16 = 4 * PJ16.n, I_WIN = 32 * NT16, I_WIN8 = 16 * 16, H_X8 = 16 * 8 * PJ8.n, I_PA = P5_F8 ? 0 : 16 * 8, I_PB = P5_F8 ? 0 : 16 * 8, I_WOUT = P6_F8 ? 0 : 32 * 8;
    constexpr int H_PAB = P5_F8 ? 16 * 16 : 0, H_WOUT = P6_F8 ? 16 * 16 : 0;
    constexpr int NITEMS16 = I_WIN + I_PA + I_PB + I_WOUT;
#pragma unroll 1
    for (int it = gw; it < NITEMS16; it += NGW) {
        int r = it; const float* s0; size_t ld; bf16* dst; int K; const float* scale;
        if (r < I_WIN) { const int kb = r / NT16, nb = r % NT16, k0 = 64 * kb, n = 256 * nb, nsrc = pj_srccol(pj_kind16(nb >> 2)) + 256 * (nb & 3);
            s0 = w_in + (size_t)k0 * NCOLS + nsrc; ld = NCOLS; dst = (bf16*)(F.ws + WS_WIN) + (size_t)n * DM + k0; K = DM; scale = g1 + k0; }
        else if ((r -= I_WIN) < I_PA) { const int kb = r / 8, nb = r % 8, k0 = 64 * kb, n = 256 * nb;
            s0 = F.in[6] + (size_t)k0 * DM + n; ld = DM; dst = (bf16*)(F.ws + WS_PAB) + (size_t)n * DM + k0; K = DM; scale = nullptr; }
        else if ((r -= I_PA) < I_PB) { const int kb = r / 8, nb = r % 8, k0 = 64 * kb, n = 256 * nb;
            s0 = F.in[7] + (size_t)k0 * DM + n; ld = DM; dst = (bf16*)(F.ws + WS_PAB) + (size_t)n * DM + MW + k0; K = DM; scale = F.in[5] + k0; }
        else { r -= I_PB; const int kb = r / 8, nb = r % 8, k0 = 64 * kb, n = 256 * nb;
            s0 = F.in[8] + (size_t)k0 * DM + n; ld = DM; dst = (bf16*)(F.ws + WS_WOUT) + (size_t)n * DM + k0; K = DM; scale = nullptr; }
        cvt_item(s0, s0 + 128, ld, dst, K, scale, tile, lane);
    }
#pragma unroll 1
    for (int hi = (gw + NGW - NITEMS16 % NGW) % NGW; hi < 2 * I_WIN8 + H_X8 + H_PAB + H_WOUT; hi += NGW) {
        const float* s0; size_t ld; unsigned char* dst; const float* scale;
        if (hi < 2 * I_WIN8 + H_X8) { int kb, n, scol;
            if (hi < 2 * I_WIN8) { kb = hi / 32; const int nh = hi % 32; n = 128 * nh; scol = GATE_COL0 + (nh & 1) * DM + 128 * (nh >> 1); }
            else { const int r = hi - 2 * I_WIN8, per = 8 * PJ8.n; kb = r / (per > 0 ? per : 1); const int nh = r % (per > 0 ? per : 1); n = 4096 + 128 * nh; scol = pj_srccol(pj_kind8(nh >> 3)) + 128 * (nh & 7); }
            const int k0 = 128 * kb; s0 = w_in + (size_t)k0 * NCOLS + scol; ld = NCOLS; dst = F.ws + WS_WIN8 + (size_t)n * DM + k0; scale = g1 + k0; }
        else if (hi < 2 * I_WIN8 + H_X8 + H_PAB) { const int r = hi - (2 * I_WIN8 + H_X8), kb = r >> 4, n = 128 * (r & 15), k0 = 128 * kb;
            s0 = (kb < 8 ? F.in[6] + (size_t)k0 * DM : F.in[7] + (size_t)(k0 - MW) * DM) + n; ld = DM; dst = F.ws + WS_PAB + (size_t)n * DM + k0; scale = kb < 8 ? nullptr : F.in[5] + (k0 - MW); }
        else { const int r = hi - (2 * I_WIN8 + H_X8 + H_PAB), kb = r >> 4, n = 128 * (r & 15), k0 = 128 * kb;
            s0 = F.in[8] + (size_t)k0 * DM + n; ld = DM; dst = F.ws + WS_WOUT + (size_t)n * DM + k0; scale = nullptr; }
        cvt8_item(s0, s0, ld, dst, DM, scale, tile, (LAS float*)(F.lds + PARK_OFF) + F.wave * 128, lane, 2);
    }
}

__device__ __forceinline__ void naive_cumsum(Frame& F) {
    const float* logf = (const float*)(F.ws + WS_LOGF); float* cum = (float*)(F.ws + WS_CUM);
    LAS float* part = (LAS float*)(F.lds + RING_OFF);
    for (int bh = blockIdx.x; bh < BATCH * NH; bh += F.G) {
        const float* src = logf + (size_t)bh * SEQ + F.tid * 8; float v[8]; float s = 0.f;
#pragma unroll
        for (int i = 0; i < 8; ++i) { v[i] = src[i]; s += v[i]; v[i] = s; }
        part[F.tid] = s; __syncthreads();
        float pre = 0.f; for (int i = 0; i < F.tid; ++i) pre += part[i];
#pragma unroll
        for (int i = 0; i < 8; ++i) cum[(size_t)bh * SEQ + F.tid * 8 + i] = v[i] + pre;
        __syncthreads();
    }
}
__device__ __forceinline__ void naive_attention(Frame& F) {
    const bf16* Q = (const bf16*)(F.ws + WS_QKV); const bf16* Kt = Q + (size_t)T * MW; const bf16* V = Kt + (size_t)T * MW;
    const float* cum = (const float*)(F.ws + WS_CUM); bf16* oa = (bf16*)(F.ws + WS_OAB);
    const int qi = F.tid >> 4, part = F.tid & 15;
    for (int u = blockIdx.x; u < BATCH * NH * (SEQ / 32); u += F.G) {
        const int bh = u / (SEQ / 32), qb = u % (SEQ / 32), row = qb * 32 + qi;
        const bf16* kb = Kt + (size_t)bh * SEQ * HD + part * 8; const bf16* vb = V + (size_t)bh * SEQ * HD + part * 8;
        float q[8], o[8]; { const v4u w = *(const v4u*)(Q + ((size_t)bh * SEQ + row) * HD + part * 8);
            q[0] = bflo(w.x); q[1] = bfhi(w.x); q[2] = bflo(w.y); q[3] = bfhi(w.y); q[4] = bflo(w.z); q[5] = bfhi(w.z); q[6] = bflo(w.w); q[7] = bfhi(w.w); }
#pragma unroll
        for (int d = 0; d < 8; ++d) o[d] = 0.f;
        float m = -1e30f, l = 0.f; const float ci = cum[(size_t)bh * SEQ + row]; const float* cj = cum + (size_t)bh * SEQ;
        const int jend = qb * 32 + 32;
        for (int j0 = 0; j0 < jend; j0 += 4) {
            v4u kw[4], vw[4]; float cjv[4];
#pragma unroll
            for (int e = 0; e < 4; ++e) { kw[e] = *(const v4u*)(kb + (size_t)(j0 + e) * HD); vw[e] = *(const v4u*)(vb + (size_t)(j0 + e) * HD); cjv[e] = cj[j0 + e]; }
#pragma unroll
            for (int e = 0; e < 4; ++e) {
                float s = q[0] * bflo(kw[e].x) + q[1] * bfhi(kw[e].x) + q[2] * bflo(kw[e].y) + q[3] * bfhi(kw[e].y) + q[4] * bflo(kw[e].z) + q[5] * bfhi(kw[e].z) + q[6] * bflo(kw[e].w) + q[7] * bfhi(kw[e].w);
                s += __shfl_xor(s, 1); s += __shfl_xor(s, 2); s += __shfl_xor(s, 4); s += __shfl_xor(s, 8);
                s = s * ATT_SCALE + (ci - cjv[e]);
                if (j0 + e <= row) { const float mn = fmaxf(m, s), al = __expf(m - mn), p = __expf(s - mn); l = l * al + p; m = mn;
                    o[0] = o[0] * al + p * bflo(vw[e].x); o[1] = o[1] * al + p * bfhi(vw[e].x); o[2] = o[2] * al + p * bflo(vw[e].y); o[3] = o[3] * al + p * bfhi(vw[e].y);
                    o[4] = o[4] * al + p * bflo(vw[e].z); o[5] = o[5] * al + p * bfhi(vw[e].z); o[6] = o[6] * al + p * bflo(vw[e].w); o[7] = o[7] * al + p * bfhi(vw[e].w); }
            }
        }
        const float il = 1.0f / l; const int b = bh >> 3, h = bh & 7;
        v4u w; w.x = pk2(o[0] * il, o[1] * il); w.y = pk2(o[2] * il, o[3] * il); w.z = pk2(o[4] * il, o[5] * il); w.w = pk2(o[6] * il, o[7] * il);
        *(v4u*)(oa + ((size_t)(b * SEQ + row)) * (2 * MW) + h * HD + part * 8) = w;
    }
}
__device__ __forceinline__ void naive_hgrn(Frame& F) {
    const bf16* QB = (const bf16*)(F.ws + WS_HG); const bf16* FB = QB + (size_t)T * MW; const bf16* IB = FB + (size_t)T * MW;
    float* obf = (float*)(F.ws + WS_OBF); const float* lbl = F.in[4];
    const int gw = F.vcu * NWAVES + F.wave, NGW = F.G * NWAVES, lane = F.lane, vc = lane & 31, kh = lane >> 5;
    LAS f32x4* fq = (LAS f32x4*)(F.lds + RING_OFF + 65536) + F.wave * 64;
    for (int u = gw; u < BATCH * NH * 4; u += NGW) {
        const int bh = u >> 2, vg = u & 3, b = bh >> 3, h = bh & 7, vcol = vg * 32 + vc;
        const float lb0 = sigm(lbl[h * HD + 2 * lane] - lbl[MW + h * HD + 2 * lane]), lb1 = sigm(lbl[h * HD + 2 * lane + 1] - lbl[MW + h * HD + 2 * lane + 1]);
        float S[64];
#pragma unroll
        for (int k = 0; k < 64; ++k) S[k] = 0.f;
        const size_t base = (size_t)b * SEQ * MW + h * HD;
        unsigned fw = *(const unsigned*)(FB + base + 2 * lane), qw = *(const unsigned*)(QB + base + 2 * lane); bf16 vw = IB[base + vcol];
#pragma unroll 1
        for (int t = 0; t < SEQ; ++t) {
            const unsigned fc = fw, qc = qw; const float v = bf1(vw);
            if (t + 1 < SEQ) { const size_t nb_ = base + (size_t)(t + 1) * MW; fw = *(const unsigned*)(FB + nb_ + 2 * lane); qw = *(const unsigned*)(QB + nb_ + 2 * lane); vw = IB[nb_ + vcol]; }
            const float f0 = lb0 + (1.f - lb0) * sigm(bflo(fc)), f1 = lb1 + (1.f - lb1) * sigm(bfhi(fc));
            fq[lane] = (f32x4){f0, bflo(qc), f1, bfhi(qc)};
            LDS_WAIT(); asm volatile("" ::: "memory");
            float o = 0.f;
#pragma unroll
            for (int i = 0; i < 32; ++i) { const f32x4 w = fq[kh * 32 + i];
                S[2 * i] = w.x * S[2 * i] + (1.f - w.x) * v; o += S[2 * i] * w.y;
                S[2 * i + 1] = w.z * S[2 * i + 1] + (1.f - w.z) * v; o += S[2 * i + 1] * w.w; }
            o += __shfl_xor(o, 32);
            if (kh == 0) obf[base + (size_t)t * MW + vcol] = o;
            LDS_WAIT(); asm volatile("" ::: "memory");
        }
    }
}
__device__ __forceinline__ void naive_hgrn_norm(Frame& F) {
    const float* obf = (const float*)(F.ws + WS_OBF); const bf16* GB = (const bf16*)(F.ws + WS_HG) + (size_t)3 * T * MW; bf16* obn = (bf16*)(F.ws + WS_OAB) + MW;
    const int gw = F.vcu * NWAVES + F.wave, NGW = F.G * NWAVES, lane = F.lane;
    for (int u = gw; u < T * NH; u += NGW) {
        const size_t off = (size_t)u * HD + 2 * lane;
        const float a = obf[off], b = obf[off + 1]; const float ss = wave_sum(a * a + b * b);
        const float rs = 1.0f / sqrtf(ss * (1.0f / HD) + EPS); const unsigned gw_ = *(const unsigned*)(GB + off); const float g0 = bflo(gw_), g1 = bfhi(gw_);
        *(unsigned*)(obn + (size_t)(u >> 3) * (2 * MW) + (u & 7) * HD + 2 * lane) = pk2(a * rs * g0 * sigm(g0), b * rs * g1 * sigm(g1));
    }
}

__device__ __forceinline__ void router_phase(Frame& F) {
    const bf16* x1b = (const bf16*)(F.ws + WS_X1B); const bf16* wr = (const bf16*)(F.ws + WS_WR);
    int* tlist = (int*)(F.ws + WS_TLIST); float* slot_rs = (float*)(F.ws + WS_SLOTRS);
    float* rstd2 = (float*)(F.ws + WS_RSTD2); int* a_e = (int*)(F.ws + WS_AE); int* a_slot = (int*)(F.ws + WS_ASLOT); float* a_w = (float*)(F.ws + WS_AW);
    const float* bgp = F.in[11]; const float* bex = F.in[13];
    const int lane = F.lane, fr = lane & 15, fq = lane >> 4, sub = F.wave & 3, half = F.wave >> 2;
    LAS float* Lg = (LAS float*)(F.lds + RING_OFF) + (sub * 2 + half) * (16 * 48 + 16);
    for (int base = F.vcu * 4; base < T / 16; base += F.G * 4) {
        const int g = base + sub;
        const bf16* arow = x1b + (size_t)(g * 16 + fr) * DM + half * (DM / 2) + 8 * fq; const bf16* brow = wr + (size_t)fr * DM + half * (DM / 2) + 8 * fq;
        pg8::f32x4 acc[3]; for (int n = 0; n < 3; ++n) acc[n] = (pg8::f32x4){0.f, 0.f, 0.f, 0.f};
        float ss = 0.f;
#pragma unroll 8
        for (int k0 = 0; k0 < DM / 2; k0 += 32) {
            const v4u aw = *(const v4u*)(arow + k0);
            ss += bflo(aw.x) * bflo(aw.x) + bfhi(aw.x) * bfhi(aw.x) + bflo(aw.y) * bflo(aw.y) + bfhi(aw.y) * bfhi(aw.y) + bflo(aw.z) * bflo(aw.z) + bfhi(aw.z) * bfhi(aw.z) + bflo(aw.w) * bflo(aw.w) + bfhi(aw.w) * bfhi(aw.w);
            const bf16x8 a = __builtin_bit_cast(bf16x8, aw);
#pragma unroll
            for (int n = 0; n < 3; ++n) { const bf16x8 bfrag = *(const bf16x8*)(brow + (size_t)(n * 16) * DM + k0);
                acc[n] = __builtin_amdgcn_mfma_f32_16x16x32_bf16(a, bfrag, acc[n], 0, 0, 0); }
        }
        ss += __shfl_xor(ss, 16); ss += __shfl_xor(ss, 32);
#pragma unroll
        for (int n = 0; n < 3; ++n)
#pragma unroll
            for (int j = 0; j < 4; ++j) Lg[(4 * fq + j) * 48 + n * 16 + fr] = acc[n][j];
        if (fq == 0) Lg[16 * 48 + fr] = ss;
        __syncthreads();
        if (half == 0 && lane < 16) {
            const LAS float* l0 = Lg + lane * 48; const LAS float* l1 = l0 + (16 * 48 + 16);
            const int t = g * 16 + lane; const float r = __builtin_amdgcn_rsqf((Lg[16 * 48 + lane] + Lg[(16 * 48 + 16) + 16 * 48 + lane]) * (1.0f / DM) + EPS);
            float lg[4]; int gi = 0; float gm = -3.0e38f;
#pragma unroll
            for (int i = 0; i < 4; ++i) { lg[i] = (l0[i] + l1[i]) * r + bgp[i]; if (lg[i] > gm) { gm = lg[i]; gi = i; } }
            float gs = 0.f;
#pragma unroll
            for (int i = 0; i < 4; ++i) gs += __expf(lg[i] - gm);
            const float g_w = __builtin_amdgcn_rcpf(gs);
            float le[8]; int i1 = 0; float m1 = -3.0e38f;
#pragma unroll
            for (int i = 0; i < 8; ++i) { le[i] = (l0[4 + gi * 8 + i] + l1[4 + gi * 8 + i]) * r + bex[gi * 8 + i]; if (le[i] > m1) { m1 = le[i]; i1 = i; } }
            int i2 = 0; float m2 = -3.0e38f;
#pragma unroll
            for (int i = 0; i < 8; ++i) if (i != i1 && le[i] > m2) { m2 = le[i]; i2 = i; }
            const float p2 = __expf(m2 - m1), w1 = __builtin_amdgcn_rcpf(1.0f + p2), w2 = p2 * w1;
            const int e1 = gi * 8 + i1, e2 = gi * 8 + i2;
            const int s1 = (int)__hip_atomic_fetch_add(F.ctl + CW_CNT + e1, 1u, RLX_AGENT), s2 = (int)__hip_atomic_fetch_add(F.ctl + CW_CNT + e2, 1u, RLX_AGENT);
            a_e[2 * t] = e1; a_e[2 * t + 1] = e2; a_slot[2 * t] = s1; a_slot[2 * t + 1] = s2; a_w[2 * t] = g_w * w1; a_w[2 * t + 1] = g_w * w2; rstd2[t] = r;
            tlist[(size_t)e1 * 16384 + s1] = t; tlist[(size_t)e2 * 16384 + s2] = t; slot_rs[(size_t)e1 * 16384 + s1] = r; slot_rs[(size_t)e2 * 16384 + s2] = r;
        }
        __syncthreads();
    }
}
__device__ __forceinline__ void moe_tables(Frame& F) {
    LAS int* tab = (LAS int*)(F.lds + MOE_TAB_OFF);
    if (F.wave == 0) { const int lane = F.lane; const int e = lane & 31;
        const int c = (int)__hip_atomic_load(F.ctl + CW_CNT + e, RLX_AGENT); const int nb = (c + 255) >> 8; int incl = nb;
#pragma unroll
        for (int off = 1; off < 32; off <<= 1) { const int n = __shfl_up(incl, off, 32); if (e >= off) incl += n; }
        const int sb = incl - nb;
        if (lane < 32) { tab[e] = sb * 256; tab[194 + e] = c; for (int b = 0; b < nb; ++b) tab[34 + sb + b] = e; if (e == 31) { tab[32] = incl * 256; tab[33] = incl; } }
    }
    __syncthreads();
}
__device__ __forceinline__ void gather_phase(Frame& F) {
    LAS int* tab = (LAS int*)(F.lds + MOE_TAB_OFF);
    const bf16* x1b = (const bf16*)(F.ws + WS_X1B); bf16* xbuf = (bf16*)(F.ws + WS_XBUF);
    const float* rstd2 = (const float*)(F.ws + WS_RSTD2); const int* a_e = (const int*)(F.ws + WS_AE); const int* a_slot = (const int*)(F.ws + WS_ASLOT);
    int* tokrow = (int*)(F.ws + WS_TOKROW); float* rowscale = (float*)(F.ws + WS_ROWSCALE);
    const int gw = F.vcu * NWAVES + F.wave, NGW = F.G * NWAVES, lane = F.lane;
    for (int a = gw; a < 2 * T; a += NGW) {
        const int t = a >> 1, e = a_e[a], row = tab[e] + a_slot[a];
        const GAS v4u* src = (const GAS v4u*)(x1b + (size_t)t * DM) + lane; GAS v4u* dst = (GAS v4u*)(xbuf + (size_t)row * DM) + lane;
#pragma unroll
        for (int j = 0; j < 4; ++j) dst[64 * j] = src[64 * j];
        if (lane == 0) { tokrow[a] = row; rowscale[row] = rstd2[t]; }
    }
    for (int e = gw; e < NEXP; e += NGW) { const int c = tab[34 + 160 + e], r0 = tab[e] + c, r1 = tab[e] + ((c + 255) & ~255);
        for (int row = r0; row < r1; ++row) { GAS v4u* dst = (GAS v4u*)(xbuf + (size_t)row * DM) + lane;
#pragma unroll
            for (int j = 0; j < 4; ++j) dst[64 * j] = (v4u){0u, 0u, 0u, 0u};
            if (lane == 0) rowscale[row] = 0.f; } }
}
__device__ __forceinline__ void final_rows(const bf16* x1b, const unsigned char* ybuf, int t, int r0, int r1, int lane, v4u (&a)[4], v2u (&b)[4], v2u (&c)[4]) {
    const GAS v4u* xs = (const GAS v4u*)(x1b + (size_t)t * DM) + lane; const GAS v2u* y0 = (const GAS v2u*)(ybuf + (size_t)r0 * DM) + lane; const GAS v2u* y1 = (const GAS v2u*)(ybuf + (size_t)r1 * DM) + lane;
#pragma unroll
    for (int j = 0; j < 4; ++j) { a[j] = xs[64 * j]; b[j] = __builtin_nontemporal_load(y0 + 64 * j); c[j] = __builtin_nontemporal_load(y1 + 64 * j); }
}
typedef float f32x2q __attribute__((ext_vector_type(2)));
__device__ __forceinline__ void fp8x4_to_f32(unsigned w, float (&o)[4]) { const f32x2q lo = __builtin_amdgcn_cvt_pk_f32_fp8((int)w, false), hi = __builtin_amdgcn_cvt_pk_f32_fp8((int)w, true); o[0] = lo.x; o[1] = lo.y; o[2] = hi.x; o[3] = hi.y; }
__device__ __forceinline__ void final_token(float* out, const float* gF, int t, float w0, float w1, int lane, const v4u (&a)[4], const v2u (&b)[4], const v2u (&c)[4]) {
    float v[4][8]; float ss = 0.f;
#pragma unroll
    for (int j = 0; j < 4; ++j) {
        float y0[8], y1[8]; fp8x4_to_f32(b[j].x, *(float(*)[4])&y0[0]); fp8x4_to_f32(b[j].y, *(float(*)[4])&y0[4]); fp8x4_to_f32(c[j].x, *(float(*)[4])&y1[0]); fp8x4_to_f32(c[j].y, *(float(*)[4])&y1[4]);
        const float xx[8] = {bflo(a[j].x), bfhi(a[j].x), bflo(a[j].y), bfhi(a[j].y), bflo(a[j].z), bfhi(a[j].z), bflo(a[j].w), bfhi(a[j].w)};
#pragma unroll
        for (int i = 0; i < 8; ++i) { v[j][i] = xx[i] + w0 * y0[i] + w1 * y1[i]; ss += v[j][i] * v[j][i]; } }
    const float rs = __builtin_amdgcn_rsqf(wave_sum(ss) * (1.0f / DM) + EPS);
#pragma unroll
    for (int j = 0; j < 4; ++j) { const int c0 = 512 * j + 8 * lane; const f32x4 ga = *(const f32x4*)(gF + c0), gb = *(const f32x4*)(gF + c0 + 4);
        f32x4 o0 = {v[j][0] * rs * ga.x, v[j][1] * rs * ga.y, v[j][2] * rs * ga.z, v[j][3] * rs * ga.w}, o1 = {v[j][4] * rs * gb.x, v[j][5] * rs * gb.y, v[j][6] * rs * gb.z, v[j][7] * rs * gb.w};
        __builtin_nontemporal_store(o0, (f32x4*)(out + (size_t)t * DM + c0)); __builtin_nontemporal_store(o1, (f32x4*)(out + (size_t)t * DM + c0 + 4)); }
}
__device__ __forceinline__ void final_phase(Frame& F) {
    const bf16* x1b = (const bf16*)(F.ws + WS_X1B); const unsigned char* ybuf = F.ws + WS_YBUF;
    const int* a_e = (const int*)(F.ws + WS_AE); const int* a_slot = (const int*)(F.ws + WS_ASLOT); const LAS int* tab = (const LAS int*)(F.lds + MOE_TAB_OFF); const float* a_w = (const float*)(F.ws + WS_AW); const float* gF = F.in[17];
    const int gw = F.vcu * NWAVES + F.wave, NGW = F.G * NWAVES, lane = F.lane;
#pragma unroll 1
    for (int t = gw; t < T; t += 2 * NGW) {
        const int t2 = t + NGW; const bool has2 = t2 < T; const int tb = has2 ? t2 : t;
        const int ra0 = tab[a_e[2 * t]] + a_slot[2 * t], ra1 = tab[a_e[2 * t + 1]] + a_slot[2 * t + 1], rb0 = tab[a_e[2 * tb]] + a_slot[2 * tb], rb1 = tab[a_e[2 * tb + 1]] + a_slot[2 * tb + 1];
        const float wa0 = a_w[2 * t] * (1.0f / 32.0f), wa1 = a_w[2 * t + 1] * (1.0f / 32.0f), wb0 = a_w[2 * tb] * (1.0f / 32.0f), wb1 = a_w[2 * tb + 1] * (1.0f / 32.0f);
        v4u a[4], a2[4]; v2u b[4], c[4], b2[4], c2[4];
        final_rows(x1b, ybuf, t, ra0, ra1, lane, a, b, c); final_rows(x1b, ybuf, tb, rb0, rb1, lane, a2, b2, c2);
        final_token(F.out, gF, t, wa0, wa1, lane, a, b, c);
        if (has2) final_token(F.out, gF, t2, wb0, wb1, lane, a2, b2, c2);
    }
}
constexpr int HG_VT_STRIDE = 144, HG_QK_STRIDE = 272, HG_OL_STRIDE = 132;
typedef float f32x16 __attribute__((ext_vector_type(16)));
typedef __bf16 bf16m_t;
__device__ __forceinline__ bf16 f2bf_m(float x) { const bf16m_t b = (bf16m_t)x; return __builtin_bit_cast(bf16, b); }
__device__ __forceinline__ int crow32(int r, int hi) { return (r & 3) + 8 * (r >> 2) + 4 * hi; }
__device__ __forceinline__ float ex2(float x) { return __builtin_amdgcn_exp2f(x); }
__device__ __forceinline__ float sig2(float x) { return __builtin_amdgcn_rcpf(1.0f + __builtin_amdgcn_exp2f(-1.4426950408889634f * x)); }
__device__ __forceinline__ void hg_pre(const unsigned (&fw)[8], float lb0, float lb1, LAS float* tot, int wave, int lane, float (&bl)[8][2], float (&kk)[8][2], float (&blast)[2], float (&bmid)[2]) {
    float r0 = 0.f, r1 = 0.f;
#pragma unroll
    for (int i = 0; i < 8; ++i) { const float f0 = lb0 + (1.f - lb0) * sig2(bflo(fw[i])), f1 = lb1 + (1.f - lb1) * sig2(bfhi(fw[i]));
        kk[i][0] = 1.f - f0; kk[i][1] = 1.f - f1; r0 += __builtin_amdgcn_logf(f0); r1 += __builtin_amdgcn_logf(f1); bl[i][0] = r0; bl[i][1] = r1; }
    *(LAS f32x2v*)(tot + wave * 128 + 2 * lane) = (f32x2v){r0, r1};
    __syncthreads();
    float p0 = 0.f, p1 = 0.f, m0 = 0.f, m1 = 0.f, a0 = 0.f, a1 = 0.f;
#pragma unroll
    for (int w = 0; w < 8; ++w) { const f32x2v tv = *(const LAS f32x2v*)(tot + w * 128 + 2 * lane); if (w < wave) { p0 += tv.x; p1 += tv.y; } if (w < 4) { m0 += tv.x; m1 += tv.y; } a0 += tv.x; a1 += tv.y; }
#pragma unroll
    for (int i = 0; i < 8; ++i) { bl[i][0] += p0; bl[i][1] += p1; }
    blast[0] = a0; blast[1] = a1; bmid[0] = m0; bmid[1] = m1;
}
__device__ __forceinline__ v4u pack8col(const float (&x)[8][2], int j) { v4u o; o.x = pk2(x[0][j], x[1][j]); o.y = pk2(x[2][j], x[3][j]); o.z = pk2(x[4][j], x[5][j]); o.w = pk2(x[6][j], x[7][j]); return o; }
__device__ __forceinline__ float lb_of(const float* lbl, int idx) { return sig2(lbl[idx] - lbl[MW + idx]); }

__device__ __forceinline__ void hgrn_a1(Frame& F) {
    const bf16* FB = (const bf16*)(F.ws + WS_HG) + (size_t)T * MW; const bf16* IB = FB + (size_t)T * MW;
    bf16* UT = (bf16*)(F.ws + WS_U); float* dec = (float*)(F.ws + WS_DEC);
    LAS unsigned char* VT = F.lds + RING_OFF; LAS unsigned char* KET = VT + 128 * HG_VT_STRIDE; LAS float* tot = (LAS float*)(KET + 128 * HG_VT_STRIDE);
    const int wave = F.wave, lane = F.lane, c32 = lane & 31, hi = lane >> 5;
    unsigned fwn[8], vwn[8]; f32x2v lbn[2];
#define HG_A1_LOAD(uu) do { const int bh_ = (uu) >> 6, c_ = (uu) & 63; const size_t rb_ = ((size_t)(bh_ >> 3) * SEQ + 64 * c_) * MW + (bh_ & 7) * HD + (size_t)(8 * wave) * MW + 2 * lane; \
        lbn[0] = *(const f32x2v*)(F.in[4] + (bh_ & 7) * HD + 2 * lane); lbn[1] = *(const f32x2v*)(F.in[4] + MW + (bh_ & 7) * HD + 2 * lane); \
        _Pragma("unroll") for (int i = 0; i < 8; ++i) { fwn[i] = *(const unsigned*)(FB + rb_ + (size_t)i * MW); vwn[i] = *(const unsigned*)(IB + rb_ + (size_t)i * MW); } } while (0)
    if (F.vcu < BATCH * NH * 64) HG_A1_LOAD(F.vcu);
    for (int u = F.vcu; u < BATCH * NH * 64; u += F.G) {
        const int bh = u >> 6, c = u & 63, b = bh >> 3, h = bh & 7;
        const float lb0 = sig2(lbn[0].x - lbn[1].x), lb1 = sig2(lbn[0].y - lbn[1].y);
        unsigned vw[8], fw[8];
#pragma unroll
        for (int i = 0; i < 8; ++i) { vw[i] = vwn[i]; fw[i] = fwn[i]; }
        if (u + F.G < BATCH * NH * 64) HG_A1_LOAD(u + F.G);
        float bl[8][2], kk[8][2], blast[2], bmid[2];
        hg_pre(fw, lb0, lb1, tot, wave, lane, bl, kk, blast, bmid);
        float ke[8][2], vv[8][2];
#pragma unroll
        for (int i = 0; i < 8; ++i) { ke[i][0] = kk[i][0] * ex2(blast[0] - bl[i][0]); ke[i][1] = kk[i][1] * ex2(blast[1] - bl[i][1]); vv[i][0] = bflo(vw[i]); vv[i][1] = bfhi(vw[i]); }
#pragma unroll
        for (int j = 0; j < 2; ++j) { *(LAS v4u*)(KET + (2 * lane + j) * HG_VT_STRIDE + 16 * wave) = pack8col(ke, j); *(LAS v4u*)(VT + (2 * lane + j) * HG_VT_STRIDE + 16 * wave) = pack8col(vv, j); }
        if (wave == 0) *(f32x2v*)(dec + (size_t)u * 128 + 2 * lane) = (f32x2v){ex2(blast[0]), ex2(blast[1])};
        __syncthreads();
        const int vt = wave >> 1, kt0 = 2 * (wave & 1);
        bf16x8 a[4];
#pragma unroll
        for (int ks = 0; ks < 4; ++ks) a[ks] = *(const LAS bf16x8*)(VT + (32 * vt + c32) * HG_VT_STRIDE + (16 * ks + 8 * hi) * 2);
        LAS bf16* stg = (LAS bf16*)(F.lds + RING_OFF + 40960 + wave * 4608);
#pragma unroll
        for (int kq = 0; kq < 2; ++kq) { const int kt = kt0 + kq; f32x16 acc = {};
#pragma unroll
            for (int ks = 0; ks < 4; ++ks) { const bf16x8 bq = *(const LAS bf16x8*)(KET + (32 * kt + c32) * HG_VT_STRIDE + (16 * ks + 8 * hi) * 2); acc = __builtin_amdgcn_mfma_f32_32x32x16_bf16(a[ks], bq, acc, 0, 0, 0); }
#pragma unroll
            for (int r = 0; r < 16; ++r) stg[crow32(r, hi) * 72 + 32 * kq + c32] = f2bf_m(acc[r]); }
        LDS_WAIT(); asm volatile("" ::: "memory");
        { bf16* dst = UT + (size_t)u * 16384 + (size_t)(32 * vt) * 128 + 64 * (wave & 1); const int row = lane >> 3, ch = lane & 7;
#pragma unroll
          for (int q = 0; q < 4; ++q) { const v4u o = *(const LAS v4u*)((LAS unsigned char*)stg + (8 * q + row) * 144 + 16 * ch); *(v4u*)(dst + (size_t)(8 * q + row) * 128 + 8 * ch) = o; } }
        __syncthreads();
    }
}
__device__ __forceinline__ void hgrn_scan(Frame& F) {
    const bf16* UT = (const bf16*)(F.ws + WS_U); bf16* ST = (bf16*)(F.ws + WS_S); const float* dec = (const float*)(F.ws + WS_DEC);
    for (int g = F.vcu * NWAVES * 64 + F.tid; g < BATCH * NH * 4096; g += F.G * NWAVES * 64) {
        const int bh = g >> 12, e = g & 4095, k0 = (e * 4) & 127;
        const bf16* up = UT + (size_t)bh * 64 * 16384 + e * 4; bf16* sp = ST + (size_t)bh * 64 * 16384 + e * 4; const float* dp = dec + (size_t)bh * 64 * 128 + k0;
        float s0 = 0.f, s1 = 0.f, s2 = 0.f, s3 = 0.f;
#pragma unroll 1
        for (int c0 = 0; c0 < 64; c0 += 16) {
            v2u uw[16]; f32x4 d[16];
#pragma unroll
            for (int j = 0; j < 16; ++j) { uw[j] = *(const v2u*)(up + (size_t)(c0 + j) * 16384); d[j] = *(const f32x4*)(dp + (c0 + j) * 128); }
            __builtin_amdgcn_sched_barrier(0);
#pragma unroll
            for (int j = 0; j < 16; ++j) {
                v2u sw; sw.x = pk2(s0, s1); sw.y = pk2(s2, s3); *(v2u*)(sp + (size_t)(c0 + j) * 16384) = sw;
                s0 = d[j].x * s0 + bflo(uw[j].x); s1 = d[j].y * s1 + bfhi(uw[j].x); s2 = d[j].z * s2 + bflo(uw[j].y); s3 = d[j].w * s3 + bfhi(uw[j].y); }
        }
    }
}
__device__ __forceinline__ void hgrn_scan_item(Frame& F, int it, unsigned* cnt) {
    const bf16* UT = (const bf16*)(F.ws + WS_U); const float* dec = (const float*)(F.ws + WS_DEC);
    const __amdgpu_buffer_rsrc_t rsS = __builtin_amdgcn_make_buffer_rsrc((void*)(F.ws + WS_S), 0, 64 * 1024 * 1024, 0x00020000);
    int tid = F.tid; asm volatile("" : "+v"(tid));
    const int g = it * (NWAVES * 64) + tid, bh = g >> 12, e = g & 4095, k0 = (e * 4) & 127;
    const bf16* up = UT + (size_t)bh * 64 * 16384 + e * 4; const float* dp = dec + (size_t)bh * 64 * 128 + k0; const int sbyte = (bh * 64 * 16384 + e * 4) * 2;
    float s0 = 0.f, s1 = 0.f, s2 = 0.f, s3 = 0.f;
#pragma unroll 1
    for (int c0 = 0; c0 < 64; c0 += 16) {
        v2u uw[16]; f32x4 d[16];
#pragma unroll
        for (int j = 0; j < 16; ++j) { uw[j] = *(const v2u*)(up + (size_t)(c0 + j) * 16384); d[j] = *(const f32x4*)(dp + (c0 + j) * 128); }
        __builtin_amdgcn_sched_barrier(0);
#pragma unroll
        for (int j = 0; j < 16; ++j) {
            v2u sw; sw.x = pk2(s0, s1); sw.y = pk2(s2, s3); __builtin_amdgcn_raw_buffer_store_b64(sw, rsS, sbyte + (c0 + j) * 32768, 0, 16);
            s0 = d[j].x * s0 + bflo(uw[j].x); s1 = d[j].y * s1 + bfhi(uw[j].x); s2 = d[j].z * s2 + bflo(uw[j].y); s3 = d[j].w * s3 + bfhi(uw[j].y); }
    }
    asm volatile("s_waitcnt vmcnt(0)" ::: "memory");
    if ((tid & 63) == 0) __hip_atomic_fetch_add(cnt + 64 * bh, 1u, __ATOMIC_RELAXED, __HIP_MEMORY_SCOPE_AGENT);
}
__device__ __forceinline__ void hgrn_a2(Frame& F, int u0, int ustep, int uend) {
    const bf16* QB = (const bf16*)(F.ws + WS_HG); const bf16* FB = QB + (size_t)T * MW; const bf16* IB = FB + (size_t)T * MW; const bf16* GB = IB + (size_t)T * MW;
    const bf16* ST = (const bf16*)(F.ws + WS_S); OAB_t* obn = (OAB_t*)(F.ws + WS_OAB) + MW;
    LAS unsigned char* QE = F.lds + RING_OFF; LAS unsigned char* KD = QE + 64 * HG_QK_STRIDE; LAS unsigned char* QBL = KD + 64 * HG_QK_STRIDE; LAS unsigned char* VT = QBL + 64 * HG_QK_STRIDE;
    LAS unsigned char* AL = VT + 128 * HG_VT_STRIDE; LAS float* OL = (LAS float*)(AL + 64 * HG_VT_STRIDE); LAS float* tot = OL + 64 * HG_OL_STRIDE;
    const int wave = F.wave;
#pragma unroll 1
    for (int u = u0; u < uend; u += ustep) {
        int tid_ = F.tid; asm volatile("" : "+v"(tid_)); const int lane = tid_ & 63, c32 = lane & 31, hi = lane >> 5;
        const int bh = u >> 6, c = u & 63, b = bh >> 3, h = bh & 7; const size_t rowbase = ((size_t)b * SEQ + 64 * c) * MW + h * HD;
        const float lb0 = lb_of(F.in[4], h * HD + 2 * lane), lb1 = lb_of(F.in[4], h * HD + 2 * lane + 1);
        const int tt = wave >> 2, vt = wave & 3;
        bf16x8 st[8];
#pragma unroll
        for (int ks = 0; ks < 8; ++ks) st[ks] = *(const bf16x8*)(ST + (size_t)u * 16384 + (size_t)(32 * vt + c32) * 128 + 16 * ks + 8 * hi);
        unsigned qw[8], vw[8], gw[8], fw[8];
#pragma unroll
        for (int i = 0; i < 8; ++i) { const size_t o = rowbase + (size_t)(8 * wave + i) * MW + 2 * lane; fw[i] = *(const unsigned*)(FB + o); qw[i] = *(const unsigned*)(QB + o); vw[i] = *(const unsigned*)(IB + o); gw[i] = *(const unsigned*)(GB + o); }
        float bl[8][2], kk[8][2], blast[2], bmid[2];
        hg_pre(fw, lb0, lb1, tot, wave, lane, bl, kk, blast, bmid);
        { float vv[8][2];
#pragma unroll
          for (int i = 0; i < 8; ++i) { const int t = 8 * wave + i; const float q0 = bflo(qw[i]), q1 = bfhi(qw[i]);
              *(LAS unsigned*)(QE + t * HG_QK_STRIDE + 4 * lane) = pk2(q0 * ex2(bl[i][0] - bmid[0]), q1 * ex2(bl[i][1] - bmid[1]));
              *(LAS unsigned*)(KD + t * HG_QK_STRIDE + 4 * lane) = pk2(kk[i][0] * ex2(bmid[0] - bl[i][0]), kk[i][1] * ex2(bmid[1] - bl[i][1]));
              *(LAS unsigned*)(QBL + t * HG_QK_STRIDE + 4 * lane) = pk2(q0 * ex2(bl[i][0]), q1 * ex2(bl[i][1]));
              vv[i][0] = bflo(vw[i]); vv[i][1] = bfhi(vw[i]); }
#pragma unroll
          for (int j = 0; j < 2; ++j) *(LAS v4u*)(VT + (2 * lane + j) * HG_VT_STRIDE + 16 * wave) = pack8col(vv, j); }
        __syncthreads();
        if (wave < 3) { const int ta = wave >= 1, sa = wave == 2; f32x16 acc = {};
#pragma unroll
            for (int ks = 0; ks < 8; ++ks) { const bf16x8 a = *(const LAS bf16x8*)(QE + (32 * ta + c32) * HG_QK_STRIDE + (16 * ks + 8 * hi) * 2), bq = *(const LAS bf16x8*)(KD + (32 * sa + c32) * HG_QK_STRIDE + (16 * ks + 8 * hi) * 2);
                acc = __builtin_amdgcn_mfma_f32_32x32x16_bf16(a, bq, acc, 0, 0, 0); }
#pragma unroll
            for (int r = 0; r < 16; ++r) { const int tl = crow32(r, hi); float v = acc[r]; if (ta == sa && c32 > tl) v = 0.f;
                *(LAS bf16*)(AL + (32 * ta + tl) * HG_VT_STRIDE + (32 * sa + c32) * 2) = f2bf_m(v); }
        } else if (wave == 3) { const int row = lane >> 1, half = lane & 1; LAS v4u* p = (LAS v4u*)(AL + row * HG_VT_STRIDE + 64 + half * 32); p[0] = (v4u){0u, 0u, 0u, 0u}; p[1] = (v4u){0u, 0u, 0u, 0u}; }
        __syncthreads();
        { f32x16 acc = {};
#pragma unroll
          for (int ks = 0; ks < 4; ++ks) { const bf16x8 a = *(const LAS bf16x8*)(AL + (32 * tt + c32) * HG_VT_STRIDE + (16 * ks + 8 * hi) * 2), bq = *(const LAS bf16x8*)(VT + (32 * vt + c32) * HG_VT_STRIDE + (16 * ks + 8 * hi) * 2);
              acc = __builtin_amdgcn_mfma_f32_32x32x16_bf16(a, bq, acc, 0, 0, 0); }
#pragma unroll
          for (int ks = 0; ks < 8; ++ks) { const bf16x8 a = *(const LAS bf16x8*)(QBL + (32 * tt + c32) * HG_QK_STRIDE + (16 * ks + 8 * hi) * 2); acc = __builtin_amdgcn_mfma_f32_32x32x16_bf16(a, st[ks], acc, 0, 0, 0); }
#pragma unroll
          for (int r = 0; r < 16; ++r) OL[(32 * tt + crow32(r, hi)) * HG_OL_STRIDE + 32 * vt + c32] = acc[r]; }
        __syncthreads();
        f32x2v o2a[8]; float ssq[8];
#pragma unroll
        for (int i = 0; i < 8; ++i) { o2a[i] = *(const LAS f32x2v*)(OL + (8 * wave + i) * HG_OL_STRIDE + 2 * lane); ssq[i] = o2a[i].x * o2a[i].x + o2a[i].y * o2a[i].y; }
#pragma unroll
        for (int i = 0; i < 8; ++i) { ssq[i] += dpp_f<0xB1>(ssq[i]); ssq[i] += dpp_f<0x4E>(ssq[i]); ssq[i] += dpp_f<0x141>(ssq[i]); ssq[i] += dpp_f<0x140>(ssq[i]); }
#pragma unroll
        for (int i = 0; i < 8; ++i) ssq[i] += __shfl_xor(ssq[i], 16);
#pragma unroll
        for (int i = 0; i < 8; ++i) ssq[i] += __shfl_xor(ssq[i], 32);
#pragma unroll
        for (int i = 0; i < 8; ++i) { const int t = 8 * wave + i; const f32x2v o2 = o2a[i];
            const float rs = __builtin_amdgcn_rsqf(ssq[i] * (1.0f / HD) + EPS); const float g0 = bflo(gw[i]), g1 = bfhi(gw[i]);
            const float y0 = o2.x * rs * g0 * sig2(g0), y1 = o2.y * rs * g1 * sig2(g1);
#if P5_F8
            { const float z0 = 16.f * y0, z1 = 16.f * y1, n0 = dpp_f<0xB1>(z0), n1 = dpp_f<0xB1>(z1);
              if ((lane & 1) == 0) *(unsigned*)(obn + ((size_t)b * SEQ + 64 * c + t) * (2 * MW) + h * HD + 2 * lane) = pg8::pk4_fp8(z0, z1, n0, n1); }
#else
            *(unsigned*)(obn + ((size_t)b * SEQ + 64 * c + t) * (2 * MW) + h * HD + 2 * lane) = pk2(y0, y1);
#endif
            }
    }
}
__device__ __forceinline__ void attn_phase_fast(Frame& F, char* lds) {
    fox::bf16* O = (fox::bf16*)(F.ws + WS_OAB);
    const float* logf = (const float*)(F.ws + WS_LOGF);
    float* cumL = (float*)(lds + fox::LDS_CUM); float* kbL = (float*)(lds + fox::LDS_KB); float* wsum = (float*)(lds + 2 * fox::SHM_V + 2 * fox::SHM_K);
    const int wave = F.wave;
    fox::Seam<fox::bf16> S;
    const fox::rsrc_t rs = __builtin_amdgcn_make_buffer_rsrc((void*)(F.ws + WS_QKV), 0, (int)(3u * (unsigned)T * MW * 2u), 0x00020000);
    for (int L = F.vcu; L < BATCH * NH * 8; L += F.G) {
        const int bh = L >> 3, y = L & 7, b = bh >> 3, h = bh & 7;
        {
            int tid = F.tid; asm volatile("" : "+v"(tid)); const int lane = tid & 63;
            const float* src = logf + (size_t)bh * SEQ + tid * 8; const f32x4 a = *(const f32x4*)src, c = *(const f32x4*)(src + 4);
            float v[8] = {a.x, a.y, a.z, a.w, c.x, c.y, c.z, c.w};
#pragma unroll
            for (int i = 1; i < 8; ++i) v[i] += v[i - 1];
            const float tot = v[7]; float inc = tot;
#pragma unroll
            for (int off = 1; off < 64; off <<= 1) { const float n = __shfl_up(inc, off); if (lane >= off) inc += n; }
            if (lane == 63) wsum[wave] = inc;
            __syncthreads();
            float pre = 0.f; for (int w = 0; w < wave; ++w) pre += wsum[w];
            const float excl = inc - tot + pre;
#pragma unroll
            for (int i = 0; i < 8; ++i) cumL[tid * 8 + i] = v[i] + excl;
            __syncthreads();
        }
        const unsigned TB = (unsigned)T * MW * 2u, hb = (unsigned)bh * SEQ * HD * 2u;
        int jlo0, jlo1;
        {   const float* nq = (const float*)(F.ctl + CW_NRM) + (size_t)bh * 4; const float* nk = nq + 32 * 4;
            const float q2 = (nq[0] + nq[1]) + (nq[2] + nq[3]), k2 = (nk[0] + nk[1]) + (nk[2] + nk[3]);
            const float thrsk = 30.0f + 2.0f * 1.02f * fox::SCALE * sqrtf(q2) * sqrtf(k2);
            int tid = F.tid; asm volatile("" : "+v"(tid)); const int lane = tid & 63;
            const int P0 = y * 256, P1 = (15 - y) * 256; const float c0 = cumL[P0], c1 = cumL[P1]; int n0 = 0, n1 = 0;
#pragma unroll
            for (int i = 0; i < 8; ++i) { const int j = tid * 8 + i; const float cj = cumL[j]; n0 += (j < P0 && cj - c0 >= thrsk) ? 1 : 0; n1 += (j < P1 && cj - c1 >= thrsk) ? 1 : 0; }
#pragma unroll
            for (int o = 1; o < 64; o <<= 1) { n0 += __shfl_xor(n0, o); n1 += __shfl_xor(n1, o); }
            int* wcnt = (int*)wsum + 8;
            if (lane == 0) { wcnt[2 * wave] = n0; wcnt[2 * wave + 1] = n1; }
            __syncthreads();
            int t0 = 0, t1 = 0;
#pragma unroll
            for (int w = 0; w < 8; ++w) { t0 += wcnt[2 * w]; t1 += wcnt[2 * w + 1]; }
            jlo0 = __builtin_amdgcn_readfirstlane(t0) >> 6; jlo1 = __builtin_amdgcn_readfirstlane(t1) >> 6;
        }
        fox::BlockRef<fox::bf16, fox::bf16> cur, nxt;
        { const int P0 = y * 256; cur.Q = hb + (unsigned)P0 * 256u; cur.K = TB + hb; cur.V = 2u * TB + hb; cur.O = O + ((size_t)(b * SEQ + P0)) * (2 * MW) + h * HD; cur.P0 = P0; cur.jlo = jlo0; }
        { const int P1 = (15 - y) * 256; nxt.Q = hb + (unsigned)P1 * 256u; nxt.K = TB + hb; nxt.V = 2u * TB + hb; nxt.O = O + ((size_t)(b * SEQ + P1)) * (2 * MW) + h * HD; nxt.P0 = P1; nxt.jlo = jlo1; }
        fox::causal_swa_prime<fox::bf16, fox::bf16>(rs, cur, SEQ, lds, S);
#pragma unroll 1
        for (int pass = 0; pass < 2; ++pass) {
            {
                int tid = F.tid; asm volatile("" : "+v"(tid));
                const float cref = cumL[cur.P0]; const int j0 = tid * 8;
                if (j0 < cur.P0 + 256) {
#pragma unroll
                    for (int i = 0; i < 8; ++i) kbL[j0 + i] = (cref - cumL[j0 + i]) * (1.0f / fox::SCALE);
                }
                __syncthreads();
            }
            fox::causal_swa_block<fox::bf16, fox::bf16>(rs, cur, nxt, SEQ, SEQ, lds, S);
            cur = nxt;
        }
    }
}

constexpr int QSLOT_OFF = MISC_OFF + 64;
__device__ __forceinline__ void mixer_queue_phase(Frame& F, char* lds) {
    constexpr int NATT = BATCH * NH * 16, NCONV = (I_W13 + I_W2) / NWAVES, NMIX = NATT + NCONV, NA2 = BATCH * NH * 32, NSCAN = BATCH * NH * 8, NQ = NMIX + NA2 + NSCAN + 256;
    static_assert(NCONV * 2 == NATT * 3 && NA2 == 2 * NATT && NATT == 2 * NSCAN, "the item interleave");
    gu32* qctr = F.ctl + CW_QUEUE; volatile LAS int* qslot = (volatile LAS int*)(F.lds + QSLOT_OFF);
    OAB_t* O = (OAB_t*)(F.ws + WS_OAB);
    const float* logf = (const float*)(F.ws + WS_LOGF);
    float* cumL = (float*)(lds + fox::LDS_CUM); float* kbL = (float*)(lds + fox::LDS_KB); float* wsum = (float*)(lds + 2 * fox::SHM_V + 2 * fox::SHM_K);
    const int wave = F.wave;
    fox::Seam<fox::bf16> S;
    const fox::rsrc_t rs = __builtin_amdgcn_make_buffer_rsrc((void*)(F.ws + WS_QKV), 0, (int)(3u * (unsigned)T * MW * 2u), 0x00020000);
    int cached_bh = -1; unsigned scan_mask = 0u; bool conv_done = false;
    unsigned mine = 0u;
    if (F.tid == 0) mine = __hip_atomic_fetch_add(qctr, 1u, RLX_AGENT);
#pragma unroll 1
    for (;;) {
        { int tid = F.tid; asm volatile("" : "+v"(tid)); if (tid == 0) qslot[0] = (int)mine; }
        __syncthreads();
        const int idx = __builtin_amdgcn_readfirstlane(qslot[0]);
        __syncthreads();
        if (idx >= NQ) break;
        { int tid = F.tid; asm volatile("" : "+v"(tid)); if (tid == 0) mine = __hip_atomic_fetch_add(qctr, 1u, RLX_AGENT); }
        int kind, sub, a2u0 = 0, a2u1 = 0;
        if (idx < 4 * NSCAN) { const int per = idx >> 2, sl = idx & 3; kind = sl == 0 ? 3 : (sl == 2 ? 1 : 0); sub = sl == 0 ? per : (sl == 1 ? 2 * per : 2 * per + 1); }
        else if (idx < 4 * NSCAN + 1152) { const int r = idx - 4 * NSCAN, per = r / 3, sl = r - 3 * per; kind = sl == 0 ? 1 : 2; sub = 2 * per + (sl - 1); a2u0 = 2 * sub; a2u1 = a2u0 + 2; }
        else { const int r = idx - (4 * NSCAN + 1152), per = r / 5, sl = r - 5 * per; kind = sl == 0 ? 1 : 2; a2u0 = 1536 + 4 * per + (sl - 1); a2u1 = a2u0 + 1; sub = a2u0 >> 1; }
        if (kind == 3) { hgrn_scan_item(F, sub, (unsigned*)(F.ctl + CW_SCAN)); continue; }
        if (kind == 2) {
            const int bh2 = sub >> 5;
            if (!((scan_mask >> bh2) & 1u)) {
                int tid = F.tid; asm volatile("" : "+v"(tid));
                if (tid < 64) { unsigned polls = 0, m;
                    for (;;) { const unsigned v = (tid < 32) ? __hip_atomic_load(F.ctl + CW_SCAN + 64 * tid, RLX_AGENT) : 0u; m = (unsigned)__ballot(tid < 32 && v >= 64u);
                        if (((m >> bh2) & 1u) || ++polls > (1u << 18)) break; __builtin_amdgcn_s_sleep(8); }
                    __builtin_amdgcn_fence(__ATOMIC_ACQUIRE, "agent");
                    asm volatile("s_waitcnt vmcnt(0)" ::: "memory");
                    if (tid == 0) qslot[2] = (int)m; }
                __syncthreads(); scan_mask |= (unsigned)__builtin_amdgcn_readfirstlane(qslot[2]) | (1u << bh2); __syncthreads();
            }
            hgrn_a2(F, a2u0, 1, a2u1); cached_bh = -1; continue; }
        if (kind == 1) {
            if (conv_done) continue;
            int tid = F.tid; asm volatile("" : "+v"(tid));
            if (tid == 0) qslot[1] = (int)__hip_atomic_fetch_add(F.ctl + CW_CONVQ, 1u, RLX_AGENT);
            __syncthreads(); const int ci = __builtin_amdgcn_readfirstlane(qslot[1]); __syncthreads();
            conv_done = ci >= NCONV;
            if (ci < NCONV) cvt8_moe_item(F.in, F.ws, ci * NWAVES + wave, (LAS unsigned*)(F.lds + RING_OFF) + wave * (64 * 33), (LAS float*)(F.lds + PARK_OFF) + wave * 128, tid & 63);
            continue; }
        const int ai = sub;
        const int bh = ai & 31, qb = 15 - (ai >> 5), b = bh >> 3, h = bh & 7, P0 = qb * 256;
        if (bh != cached_bh) {
            cached_bh = bh;
            int tid = F.tid; asm volatile("" : "+v"(tid)); const int lane = tid & 63;
            const float* src = logf + (size_t)bh * SEQ + tid * 8; const f32x4 a = *(const f32x4*)src, c = *(const f32x4*)(src + 4);
            float v[8] = {a.x, a.y, a.z, a.w, c.x, c.y, c.z, c.w};
#pragma unroll
            for (int i = 1; i < 8; ++i) v[i] += v[i - 1];
            const float tot = v[7]; float inc = tot;
#pragma unroll
            for (int off = 1; off < 64; off <<= 1) { const float n = __shfl_up(inc, off); if (lane >= off) inc += n; }
            if (lane == 63) wsum[wave] = inc;
            __syncthreads();
            float pre = 0.f; for (int w = 0; w < wave; ++w) pre += wsum[w];
            const float excl = inc - tot + pre;
#pragma unroll
            for (int i = 0; i < 8; ++i) cumL[tid * 8 + i] = v[i] + excl;
            __syncthreads();
        }
        const unsigned TB = (unsigned)T * MW * 2u, hb = (unsigned)bh * SEQ * HD * 2u;
        int jlo0;
        {
            const float* nk = (const float*)(F.ctl + CW_NRM) + (size_t)(32 + bh) * 4; const float k2 = (nk[0] + nk[1]) + (nk[2] + nk[3]);
            int tid = F.tid; asm volatile("" : "+v"(tid)); const int lane = tid & 63;
            const float c0 = cumL[P0];
            float amax;
            {   const int row = tid >> 1, half = tid & 1;
                const v4u* qp = (const v4u*)(F.ws + WS_QKV + hb + (size_t)(P0 + row) * 256 + half * 128); const v4u* kp = (const v4u*)((const unsigned char*)qp + TB);
                float qq = 0.f, qk = 0.f;
#pragma unroll
                for (int i = 0; i < 8; ++i) { const v4u a = qp[i], k = kp[i];
                    qq += (bflo(a.x) * bflo(a.x) + bfhi(a.x) * bfhi(a.x)) + (bflo(a.y) * bflo(a.y) + bfhi(a.y) * bfhi(a.y)) + (bflo(a.z) * bflo(a.z) + bfhi(a.z) * bfhi(a.z)) + (bflo(a.w) * bflo(a.w) + bfhi(a.w) * bfhi(a.w));
                    qk += (bflo(a.x) * bflo(k.x) + bfhi(a.x) * bfhi(k.x)) + (bflo(a.y) * bflo(k.y) + bfhi(a.y) * bfhi(k.y)) + (bflo(a.z) * bflo(k.z) + bfhi(a.z) * bfhi(k.z)) + (bflo(a.w) * bflo(k.w) + bfhi(a.w) * bfhi(k.w)); }
                qq += dpp_f<0xB1>(qq); qk += dpp_f<0xB1>(qk);
                float a = 1.02f * fox::SCALE * __builtin_amdgcn_sqrtf(qq) * __builtin_amdgcn_sqrtf(k2) - fox::SCALE * qk + (cumL[P0 + row] - c0);
                a = wave_fmax(a);
                if (lane == 0) wsum[16 + wave] = a;
                __syncthreads();
                amax = wsum[16];
#pragma unroll
                for (int w = 1; w < 8; ++w) amax = fmaxf(amax, wsum[16 + w]);
            }
            const float thrsk = SKIP_T0 + amax;
            int n0 = 0;
#pragma unroll
            for (int i = 0; i < 8; ++i) { const int j = tid * 8 + i; n0 += (j < P0 && cumL[j] - c0 >= thrsk) ? 1 : 0; }
            n0 = wave_isum(n0);
            int* wcnt = (int*)wsum + 8;
            if (lane == 0) wcnt[wave] = n0;
            __syncthreads();
            int t0 = 0;
#pragma unroll
            for (int w = 0; w < 8; ++w) t0 += wcnt[w];
            jlo0 = __builtin_amdgcn_readfirstlane(t0) >> 6;
        }
        fox::BlockRef<fox::bf16, OAB_t> cur;
        cur.Q = hb + (unsigned)P0 * 256u; cur.K = TB + hb; cur.V = 2u * TB + hb; cur.O = O + ((size_t)(b * SEQ + P0)) * (2 * MW) + h * HD; cur.P0 = P0; cur.jlo = jlo0;
        fox::causal_swa_prime<fox::bf16, OAB_t>(rs, cur, SEQ, lds, S);
        {
            int tid = F.tid; asm volatile("" : "+v"(tid));
            const float cref = cumL[P0]; const int j0 = tid * 8;
            if (j0 < P0 + 256) {
#pragma unroll
                for (int i = 0; i < 8; ++i) kbL[j0 + i] = (cref - cumL[j0 + i]) * (1.0f / fox::SCALE);
            }
            __syncthreads();
        }
        fox::causal_swa_block<fox::bf16, OAB_t>(rs, cur, cur, SEQ, SEQ, lds, S);
    }
}

__device__ __forceinline__ void p1_converter(Frame& F) {
    constexpr int NCONV = (I_W13 + I_W2) / NWAVES; volatile LAS int* qslot = (volatile LAS int*)(F.lds + MISC_OFF + 64);
#pragma unroll 1
    for (;;) {
        int tid = F.tid; asm volatile("" : "+v"(tid));
        if (tid == 0) { const unsigned stop = __hip_atomic_load(F.ctl + CW_P1STOP, RLX_AGENT); qslot[1] = stop ? NCONV : (int)__hip_atomic_fetch_add(F.ctl + CW_CONVQ, 1u, RLX_AGENT); }
        __syncthreads(); const int ci = __builtin_amdgcn_readfirstlane(qslot[1]); __syncthreads();
        if (ci >= NCONV) break;
        cvt8_moe_item(F.in, F.ws, ci * NWAVES + F.wave, (LAS unsigned*)(F.lds + RING_OFF) + F.wave * (64 * 33), (LAS float*)(F.lds + PARK_OFF) + F.wave * 128, tid & 63);
    }
}

#ifndef MK_N_LAUNCHES
#define MK_N_LAUNCHES 1
#endif
constexpr int PER_PHASE = 12;
constexpr int N_LAUNCHES = MK_N_LAUNCHES;
static_assert(N_LAUNCHES == 1 || N_LAUNCHES == PER_PHASE, "MK_N_LAUNCHES is 1 or 12");
__device__ __forceinline__ bool fresh(Frame& F) { int t_ = threadIdx.x; asm volatile("" : "+v"(t_)); F.tid = t_; F.lane = t_ & 63; return true; }
struct Args { const float* in[18]; float* out; unsigned char* ws; int ph_lo, ph_hi, li, pad; };
__global__ void __launch_bounds__(NWAVES * 64, 2) fwd_kernel(Args args) {
    extern __shared__ __attribute__((aligned(16))) unsigned char lds[];
    Frame F;
    F.lds = (LAS unsigned char*)lds;
    F.MISC = (volatile LAS unsigned*)(F.lds + MISC_OFF);
    F.tid = threadIdx.x; F.lane = F.tid & 63; F.wave = __builtin_amdgcn_readfirstlane(F.tid >> 6);
    F.G = gridDim.x; { const int bx = blockIdx.x; F.vcu = (F.G % 8 == 0) ? (bx % 8) * (F.G / 8) + bx / 8 : bx; }
    F.ws = args.ws; F.ctl = (gu32*)(args.ws + WS_CTL); F.out = args.out;
    F.in = args.in;
    for (int u = F.tid; u < (LDS_BYTES - LDSCTL_OFF) / 4; u += NWAVES * 64) ((LAS unsigned*)(F.lds + LDSCTL_OFF))[u] = 0u;
    __syncthreads();
    XcdBarrier bar; bar.bar = (unsigned*)(F.ctl + CW_BAR); bar.x = 0; bar.st = nullptr;
    if (N_LAUNCHES != PER_PHASE) bar = xcd_barrier_post((unsigned*)(F.ctl + CW_BAR), F.MISC + 8);
#define GRID_BAR() do { if (N_LAUNCHES != PER_PHASE) xcd_barrier(bar); } while (0)
    const int lo = args.ph_lo, hi = args.ph_hi;
#ifndef PHASE_MASK
#define PHASE_MASK 0xfff
#endif
#define IN(k) (((PHASE_MASK >> (k)) & 1) && lo <= (k) && (k) < hi && fresh(F))
#ifndef DUP_MASK
#define DUP_MASK 0
#endif
#define REP(k) for (int rep_ = 0; rep_ < (((DUP_MASK >> (k)) & 1) ? 2 : 1); ++rep_)
    unsigned char* ws = args.ws;
    bf16* const HG = (bf16*)(ws + WS_HG); bf16* const GT = (bf16*)(ws + WS_GT);

    if (IN(0)) REP(0) { p0_prologue(F); GRID_BAR(); }
    if (IN(1)) REP(1) {
        const int GC = (F.G >= 128 && F.G % 8 == 0) ? P1_CONV_WGS : 0, Gg = F.G - GC;
        if ((int)blockIdx.x < Gg) {
            { pg8::Gemm g{(const bf16*)(ws + WS_XB), (const bf16*)(ws + WS_WIN), T, NPROJ16, DM, ws}; pg8::StaticOrder S; S.init(T, NPROJ16, Gg, (int)blockIdx.x);
              pg8::EpiProj E{(bf16*)(ws + WS_QKV), HG, GT, (const float*)(ws + WS_RSTD1), (unsigned*)(F.ctl + CW_NRM)};
              pg8::gemm_phase<pg8::EpiProj, pg8::StaticOrder, true, true>(F.lds + RING_OFF, g, S, E); }
            { pg8::Gemm g{(const bf16*)(ws + WS_X8), (const bf16*)(ws + WS_WIN8), T, NPROJ8, DM / 2, ws}; pg8::StaticOrderSig S; S.init_sig(T, NPROJ8, Gg, (int)blockIdx.x, (unsigned*)(F.ctl + CW_P1STOP));
              pg8::EpiProjG8 E{GT, (const float*)(ws + WS_RSTD1), (bf16*)(ws + WS_QKV), HG};
              pg8::gemm_phase<pg8::EpiProjG8, pg8::StaticOrderSig, true, true, false, true>(F.lds + RING_OFF, g, S, E); }
        } else p1_converter(F);
        GRID_BAR();
    }
    if (IN(2)) REP(2) { hgrn_a1(F); GRID_BAR(); }
    if (IN(4)) { mixer_queue_phase(F, (char*)lds); GRID_BAR(); }
    if (IN(5)) REP(5) {
        pg8::Gemm g{(const bf16*)(ws + WS_OAB), (const bf16*)(ws + WS_PAB), T, DM, P5_F8 ? DM / 2 : DM, ws}; pg8::StaticOrder S; S.init(T, DM, F.G, (int)blockIdx.x);
        typedef pg8::EpiGate2T<P5_F8 != 0, P6_F8 != 0> EG; EG E{(bf16*)(ws + WS_MRG), GT, GT + (size_t)T * DM};
        pg8::gemm_phase<EG, pg8::StaticOrder, true, true, false, P5_F8 != 0>(F.lds + RING_OFF, g, S, E);
        GRID_BAR();
    }
    if (IN(6)) REP(6) {
        pg8::Gemm g{(const bf16*)(ws + WS_MRG), (const bf16*)(ws + WS_WOUT), T, DM, P6_F8 ? DM / 2 : DM, ws}; pg8::StaticOrder S; S.init(T, DM, F.G, (int)blockIdx.x);
        typedef pg8::EpiResid8T<P6_F8 != 0> ER; ER E{(bf16*)(ws + WS_X1B), (const bf16*)(ws + WS_XB), ws + WS_X1F8};
        pg8::gemm_phase<ER, pg8::StaticOrder, true, true, false, P6_F8 != 0>(F.lds + RING_OFF, g, S, E);
        GRID_BAR();
    }
    if (IN(7)) { router_phase(F); GRID_BAR(); }
#ifdef MOE_XBUF
    if (IN(8)) REP(8) { moe_tables(F); gather_phase(F); GRID_BAR(); }
#endif
    if (IN(9)) REP(9) {
        moe_tables(F);
        const LAS int* tab = (const LAS int*)(F.lds + MOE_TAB_OFF);
#ifdef MOE_XBUF
        pg8::Gemm g{(const bf16*)(ws + WS_XBUF), (const bf16*)(ws + WS_W13), MAXROWS, 2048, DM, ws};
        pg8::MoeOrder S{tab[33], F.G, (int)blockIdx.x, 8, tab + 34};
        pg8::EpiMoe1 E{(bf16*)(ws + WS_HBUF), (const float*)(ws + WS_ROWSCALE)};
        pg8::gemm_phase<pg8::EpiMoe1, pg8::MoeOrder, true, true>(F.lds + RING_OFF, g, S, E);
#else
        pg8::Gemm g{(const bf16*)(ws + WS_X1F8), (const bf16*)(ws + WS_W13), T, 2048, DM / 2, ws};
        pg8::MoeGatherOrder S{tab[33], F.G, (int)blockIdx.x, 8, tab, (const int*)(ws + WS_TLIST), (LAS unsigned*)(F.lds + PARK_OFF), (unsigned*)(F.ctl + CW_HB), -1};
        pg8::EpiMoe1G8 E{ws + WS_HBUF, (const float*)(ws + WS_SLOTRS), tab};
        pg8::gemm_phase<pg8::EpiMoe1G8, pg8::MoeGatherOrder, true, true, true, true>(F.lds + RING_OFF, g, S, E);
        S.flush();
#endif
    }
    if (IN(10)) REP(10) {
        if (N_LAUNCHES == PER_PHASE) moe_tables(F);
        const LAS int* tab = (const LAS int*)(F.lds + MOE_TAB_OFF);
        pg8::Gemm g{(const bf16*)(ws + WS_HBUF), (const bf16*)(ws + WS_W2), MAXROWS, 2048, DFF / 2, ws};
        const int n1 = tab[33] * 8, cb = (int)blockIdx.x, i0 = cb < n1 ? (n1 - cb + F.G - 1) / F.G : 0;
        pg8::MoeCountedOrder S{tab[33], F.G, cb, i0, n1, 8, tab + 34, (const unsigned*)(F.ctl + CW_HB), (volatile LAS int*)(F.lds + QSLOT_OFF) + 3, 0u};
        pg8::EpiPlainS8 E{ws + WS_YBUF, DM, 32.0f / 2048.0f};
        pg8::gemm_phase<pg8::EpiPlainS8, pg8::MoeCountedOrder, true, true, false, true>(F.lds + RING_OFF, g, S, E);
        GRID_BAR();
    }
    if (IN(11)) REP(11) { if (N_LAUNCHES == PER_PHASE) moe_tables(F); final_phase(F); }
#undef IN
}

extern "C" void kernel_launch(void* const* d_in, const int* in_sizes, int n_in, void* d_out, int out_size, void* d_ws, size_t ws_size, hipStream_t stream) {
    static int grid = 0;
    if (grid == 0) {
        if (n_in != 18 || in_sizes[0] != T * DM || out_size != T * DM || ws_size < WS_END) { fprintf(stderr, "kernel_launch: unexpected shapes (n_in %d, in0 %d, out %d, ws %zu)\n", n_in, n_in > 0 ? in_sizes[0] : -1, out_size, ws_size); grid = -1; return; }
        int dev = 0, cus = 0, per_cu = 0;
        if (hipGetDevice(&dev) != hipSuccess || hipDeviceGetAttribute(&cus, hipDeviceAttributeMultiprocessorCount, dev) != hipSuccess) { grid = -1; return; }
        if (hipFuncSetAttribute((const void*)fwd_kernel, hipFuncAttributeMaxDynamicSharedMemorySize, LDS_BYTES) != hipSuccess) { fprintf(stderr, "kernel_launch: hipFuncSetAttribute failed\n"); grid = -1; return; }
        if (hipOccupancyMaxActiveBlocksPerMultiprocessor(&per_cu, (const void*)fwd_kernel, NWAVES * 64, LDS_BYTES) != hipSuccess || per_cu < 1) fprintf(stderr, "kernel_launch: occupancy query says %d\n", per_cu);
        (void)hipGetLastError();
        grid = cus - (cus % 8);
        if (grid <= 0) grid = 8;
    }
    if (grid < 0) return;
    if (hipMemsetAsync((char*)d_ws + WS_CTL, 0, CTL_ZERO_BYTES, stream) != hipSuccess) return;
    Args a{};
    for (int i = 0; i < 18; ++i) a.in[i] = (const float*)d_in[i];
    a.out = (float*)d_out; a.ws = (unsigned char*)d_ws;
    for (int li = 0; li < N_LAUNCHES; ++li) {
        a.ph_lo = (N_LAUNCHES == PER_PHASE) ? li : 0; a.ph_hi = (N_LAUNCHES == PER_PHASE) ? li + 1 : PER_PHASE; a.li = li; a.pad = 0;
        hipLaunchKernelGGL(fwd_kernel, dim3(grid), dim3(NWAVES * 64), LDS_BYTES, stream, a);
    }
}
```

```cpp
#include <hip/hip_runtime.h>
#include <cstdio>
#include <cstdint>
#ifndef PJ_V8
#define PJ_V8 1
#endif
#ifndef PJ_IB8
#define PJ_IB8 0
#endif
#ifndef PJ_GB8
#define PJ_GB8 1
#endif
#ifndef P5_F8
#define P5_F8 0
#endif
#ifndef P6_F8
#define P6_F8 1
#endif
#ifndef P1_CONV_WGS
#define P1_CONV_WGS 32
#endif
#ifndef SKIP_T0
#define SKIP_T0 20.0f
#endif
#ifndef GT_AUX
#define GT_AUX 0
#endif
struct PjList { int k[7]; int n; };
constexpr PjList pj_make(bool f8) { PjList r{}; r.n = 0; for (int kind = 0; kind < 7; ++kind) { const bool is8 = (kind == 2 && PJ_V8) || (kind == 5 && PJ_IB8) || (kind == 6 && PJ_GB8); if (is8 == f8) r.k[r.n++] = kind; } return r; }
constexpr PjList PJ16 = pj_make(false), PJ8 = pj_make(true);
__host__ __device__ __forceinline__ int pj_kind16(int g) { int kind = 0;
#pragma unroll
    for (int i = 0; i < PJ16.n; ++i) if (g == i) kind = PJ16.k[i];
    return kind; }
__host__ __device__ __forceinline__ int pj_kind8(int g) { int kind = 0;
#pragma unroll
    for (int i = 0; i < PJ8.n; ++i) if (g == i) kind = PJ8.k[i];
    return kind; }
__host__ __device__ __forceinline__ int pj_srccol(int kind) { return kind < 3 ? 1024 * kind : 3080 + 1024 * (kind - 3); }
namespace pg8 {
#define PG8_LAS __attribute__((address_space(3)))
typedef unsigned short bf16_t;
typedef short bf16x8 __attribute__((ext_vector_type(8)));
typedef float f32x4 __attribute__((ext_vector_type(4)));
typedef unsigned u32x4 __attribute__((ext_vector_type(4)));
typedef int v4i_t __attribute__((ext_vector_type(4)));
typedef int v8i_t __attribute__((ext_vector_type(8)));
constexpr int BM = 256, BK = 64, HALF = 128, HTB = HALF * BK * 2  , STAGE_BYTES = 8 * HTB, NXCD = 8, WGM = 8;

__host__ __device__ __forceinline__ int lds_byte(int r, int c) { const int st = (r >> 4) * 2 + (c >> 5), rr = r & 15, cc = c & 31, ob = rr * 64 + cc * 2; return st * 1024 + (ob ^ (((ob >> 9) & 1) << 5)); }
__host__ __device__ __forceinline__ void stage_rc(int b, int& R, int& C) { const int st = b / 1024, sb = b % 1024, swz = sb ^ (((sb >> 9) & 1) << 5); R = (st >> 1) * 16 + swz / 64; C = (st & 1) * 32 + (swz % 64) / 2; }
__host__ __device__ __forceinline__ int perm32(int rho) { const int n = rho >> 4, i = rho & 15; return 8 * (i >> 2) + 4 * n + (i & 3); }

struct Unit { int pm, pn, pb; };
struct Gemm { const bf16_t* A; const bf16_t* Bt; int M, N, K; const void* base; };

struct StaticOrder {
    int nM, nN, nwg, G, c;
    __host__ __device__ void init(int M, int N, int G_, int c_) { nM = M / BM; nN = N / BM; nwg = nM * nN; G = G_; c = c_; }
    __host__ __device__ bool next(int i, Unit& u) const {
        const long L = (long)i * G + c; if (L >= nwg) return false;
        int wgid = (int)L; { const int q = nwg / NXCD, r = nwg % NXCD, xcd = wgid % NXCD, off = wgid / NXCD; wgid = (xcd < r ? xcd * (q + 1) : r * (q + 1) + (xcd - r) * q) + off; }
        const int nig = WGM * nN, gid = wgid / nig, fm = gid * WGM, gsz = (nM - fm) < WGM ? (nM - fm) : WGM;
        u.pm = fm + ((wgid % nig) % gsz); u.pn = (wgid % nig) / gsz; u.pb = u.pn; return true;
    }
    __device__ __forceinline__ void a_ready(const Unit&) const {}
    __device__ __forceinline__ void done(const Unit&) const {}
};

struct StaticOrderSig : StaticOrder {
    unsigned* flag; Unit lastu;
    __device__ void init_sig(int M, int N, int G_, int c_, unsigned* flag_) { init(M, N, G_, c_); flag = flag_; const int n = (nwg - c_ + G_ - 1) / G_, nmax = (nwg + G_ - 1) / G_; lastu.pm = -1; lastu.pn = -1; lastu.pb = -1; if (n > 0 && n == nmax) next(n - 1, lastu); }
    __device__ __forceinline__ void a_ready(const Unit& u) const { if (u.pm == lastu.pm && u.pn == lastu.pn && threadIdx.x == 0) __hip_atomic_store(flag, 1u, __ATOMIC_RELAXED, __HIP_MEMORY_SCOPE_AGENT); }
};
typedef float f32x2c_t __attribute__((ext_vector_type(2))); typedef __bf16 bf16x2c_t __attribute__((ext_vector_type(2)));
__device__ __forceinline__ unsigned cvt_pk_bf16(float lo, float hi) { const f32x2c_t v = {lo, hi}; const bf16x2c_t b = __builtin_convertvector(v, bf16x2c_t); return __builtin_bit_cast(unsigned, b); }
typedef float f32x2 __attribute__((ext_vector_type(2)));

__device__ __forceinline__ float bf_lo(unsigned u) { return __uint_as_float(u << 16); }
__device__ __forceinline__ float bf_hi(unsigned u) { return __uint_as_float(u & 0xffff0000u); }
__device__ __forceinline__ float sigmoidf_(float x) { return __builtin_amdgcn_rcpf(1.0f + __builtin_amdgcn_exp2f(-1.4426950408889634f * x)); }
__device__ __forceinline__ u32x4 pack8f(const f32x4 a, const f32x4 b) { u32x4 w; w.x = cvt_pk_bf16(a[0], a[1]); w.y = cvt_pk_bf16(a[2], a[3]); w.z = cvt_pk_bf16(b[0], b[1]); w.w = cvt_pk_bf16(b[2], b[3]); return w; }
__device__ __forceinline__ void unpack8f(const u32x4 w, f32x4& a, f32x4& b) { a = (f32x4){bf_lo(w.x), bf_hi(w.x), bf_lo(w.y), bf_hi(w.y)}; b = (f32x4){bf_lo(w.z), bf_hi(w.z), bf_lo(w.w), bf_hi(w.w)}; }

struct EpiProj {
    static constexpr bool PERM = true, AFTER_DRAIN = false;
    bf16_t* qkv;
    bf16_t* hg;
    bf16_t* gt;
    const float* rstd; unsigned* nrm;
    __device__ __forceinline__ void operator()(const f32x4 (&acc)[2][2][4][2], const Unit& u, int wr, int wc, int fr, int fq) const {
        const int row0 = u.pm * BM + wr * 64 + fr; const int lanecol = wc * 32 + 8 * fq; float mx0 = 0.f, mx1 = 0.f; float ssv[2][4][2];
        bf16_t* base; size_t ld, bjoff; size_t rowbase;
        const int kind = pj_kind16(u.pn >> 2), sub = u.pn & 3;
        if (kind < 3) { const int which = kind, hp = sub, b = u.pm >> 4; base = qkv + (size_t)which * ((size_t)16384 * 1024) + ((size_t)(b * 8 + 2 * hp) * 4096) * 128; ld = 128; bjoff = (size_t)4096 * 128; rowbase = (size_t)(row0 & 4095); }
        else { base = hg + (size_t)(kind - 3) * ((size_t)16384 * 1024) + sub * 256; ld = 1024; bjoff = 128; rowbase = (size_t)row0; }
        float rsv[2][4];
#pragma unroll
        for (int ai = 0; ai < 2; ++ai)
#pragma unroll
            for (int m = 0; m < 4; ++m) rsv[ai][m] = rstd[row0 + ai * HALF + m * 16];
        __builtin_amdgcn_sched_barrier(0);
#pragma unroll
        for (int ai = 0; ai < 2; ++ai)
#pragma unroll
            for (int m = 0; m < 4; ++m) { const int r = ai * HALF + m * 16; const float rs = rsv[ai][m]; bf16_t* rowp = base + (rowbase + r) * ld + lanecol;
#pragma unroll
                for (int bj = 0; bj < 2; ++bj) { const f32x4 v0 = acc[ai][bj][m][0] * rs, v1 = acc[ai][bj][m][1] * rs; *(u32x4*)(rowp + bj * bjoff) = pack8f(v0, v1);
                    ssv[ai][m][bj] = (v0[0] * v0[0] + v0[1] * v0[1]) + (v0[2] * v0[2] + v0[3] * v0[3]) + (v1[0] * v1[0] + v1[1] * v1[1]) + (v1[2] * v1[2] + v1[3] * v1[3]); } }
        if (kind < 2) {
#pragma unroll
            for (int ai = 0; ai < 2; ++ai)
#pragma unroll
                for (int m = 0; m < 4; ++m)
#pragma unroll
                    for (int bj = 0; bj < 2; ++bj) ssv[ai][m][bj] += __shfl_xor(ssv[ai][m][bj], 16);
#pragma unroll
            for (int ai = 0; ai < 2; ++ai)
#pragma unroll
                for (int m = 0; m < 4; ++m)
#pragma unroll
                    for (int bj = 0; bj < 2; ++bj) ssv[ai][m][bj] += __shfl_xor(ssv[ai][m][bj], 32);
#pragma unroll
            for (int ai = 0; ai < 2; ++ai)
#pragma unroll
                for (int m = 0; m < 4; ++m) { mx0 = fmaxf(mx0, ssv[ai][m][0]); mx1 = fmaxf(mx1, ssv[ai][m][1]); }
#pragma unroll
            for (int o = 1; o < 16; o <<= 1) { mx0 = fmaxf(mx0, __shfl_xor(mx0, o)); mx1 = fmaxf(mx1, __shfl_xor(mx1, o)); }
            if (fr == 0 && fq == 0) { const int which = kind, hp = sub, b = u.pm >> 4; unsigned* p = nrm + ((which * 32 + b * 8 + 2 * hp) * 4 + wc);
                atomicMax(p, __float_as_uint(mx0)); atomicMax(p + 4, __float_as_uint(mx1)); } }
    }
};
__device__ __forceinline__ float clamp448(float x) { return fminf(fmaxf(x, -448.f), 448.f); }
__device__ __forceinline__ unsigned pk4_fp8(float a, float b, float c, float d) { int w = 0; w = __builtin_amdgcn_cvt_pk_fp8_f32(clamp448(a), clamp448(b), w, false); w = __builtin_amdgcn_cvt_pk_fp8_f32(clamp448(c), clamp448(d), w, true); return (unsigned)w; }
typedef unsigned u32x2 __attribute__((ext_vector_type(2)));
__device__ __forceinline__ float cl43(float x) { return fminf(fmaxf(x, -43.f), 43.f); }
struct EpiProjG8 {
    static constexpr bool PERM = true, AFTER_DRAIN = false;
    bf16_t* gt; const float* rstd; bf16_t* qkv; bf16_t* hg;
    __device__ __forceinline__ void operator()(const f32x4 (&acc)[2][2][4][2], const Unit& u, int wr, int wc, int fr, int fq) const {
        if (u.pn >= 16) {
            const int row0 = u.pm * BM + wr * 64 + fr; const int lanecol = wc * 32 + 8 * fq; const int kind = pj_kind8((u.pn - 16) >> 2), sub = u.pn & 3;
            bf16_t* base; size_t ld, bjoff; size_t rowbase;
            if (kind < 3) { const int b = u.pm >> 4; base = qkv + (size_t)kind * ((size_t)16384 * 1024) + ((size_t)(b * 8 + 2 * sub) * 4096) * 128; ld = 128; bjoff = (size_t)4096 * 128; rowbase = (size_t)(row0 & 4095); }
            else { base = hg + (size_t)(kind - 3) * ((size_t)16384 * 1024) + sub * 256; ld = 1024; bjoff = 128; rowbase = (size_t)row0; }
            float rsv[2][4];
#pragma unroll
            for (int ai = 0; ai < 2; ++ai)
#pragma unroll
                for (int m = 0; m < 4; ++m) rsv[ai][m] = rstd[row0 + ai * HALF + m * 16];
            __builtin_amdgcn_sched_barrier(0);
#pragma unroll
            for (int ai = 0; ai < 2; ++ai)
#pragma unroll
                for (int m = 0; m < 4; ++m) { const int r = ai * HALF + m * 16; const float rs = rsv[ai][m] * (1.0f / 4096.0f); bf16_t* rowp = base + (rowbase + r) * ld + lanecol;
#pragma unroll
                    for (int bj = 0; bj < 2; ++bj) *(u32x4*)(rowp + bj * bjoff) = pack8f(acc[ai][bj][m][0] * rs, acc[ai][bj][m][1] * rs); }
            return;
        }
        const __amdgpu_buffer_rsrc_t rg = __builtin_amdgcn_make_buffer_rsrc((void*)gt, 0, 16384 * 2048 * 2, 0x00020000), rg2 = __builtin_amdgcn_make_buffer_rsrc((void*)(gt + (size_t)16384 * 2048), 0, 16384 * 2048 * 2, 0x00020000);
        const __amdgpu_buffer_rsrc_t rr = __builtin_amdgcn_make_buffer_rsrc((void*)rstd, 0, 16384 * 4, 0x00020000);
        const int row0 = u.pm * BM + wr * 64 + fr; const int colb = (u.pn * HALF + wc * 32 + 8 * fq) * 2;
        float rsv[2][4];
#pragma unroll
        for (int ai = 0; ai < 2; ++ai)
#pragma unroll
            for (int m = 0; m < 4; ++m) rsv[ai][m] = __builtin_bit_cast(float, __builtin_amdgcn_raw_buffer_load_b32(rr, (row0 + ai * HALF + m * 16) * 4, 0, 0));
        __builtin_amdgcn_sched_barrier(0);
#pragma unroll
        for (int ai = 0; ai < 2; ++ai)
#pragma unroll
            for (int m = 0; m < 4; ++m) { const int r = row0 + ai * HALF + m * 16; const float rs = rsv[ai][m] * (-1.4426950408889634f / 4096.0f);
                f32x4 q0, q1, s0, s1;
#pragma unroll
                for (int i = 0; i < 4; ++i) { const float ea0 = fminf(1.0f + __builtin_amdgcn_exp2f(acc[ai][0][m][0][i] * rs), 1e13f), eb0 = fminf(1.0f + __builtin_amdgcn_exp2f(acc[ai][1][m][0][i] * rs), 1e13f);
                    const float ea1 = fminf(1.0f + __builtin_amdgcn_exp2f(acc[ai][0][m][1][i] * rs), 1e13f), eb1 = fminf(1.0f + __builtin_amdgcn_exp2f(acc[ai][1][m][1][i] * rs), 1e13f);
                    q0[i] = eb0 * __builtin_amdgcn_rcpf(ea0); q1[i] = eb1 * __builtin_amdgcn_rcpf(ea1); s0[i] = __builtin_amdgcn_rcpf(eb0); s1[i] = __builtin_amdgcn_rcpf(eb1); }
                const int gidx = (((((u.pm * 16 + u.pn) * 2 + ai) * 4 + m) * 8 + (wr * 4 + wc)) * 64 + (fr + 16 * fq)) * 16;
                __builtin_amdgcn_raw_buffer_store_b128(pack8f(q0, q1), rg, gidx, 0, GT_AUX);
                __builtin_amdgcn_raw_buffer_store_b128(pack8f(s0, s1), rg2, gidx, 0, GT_AUX); }
    }
};
struct EpiPlain {
    static constexpr bool PERM = true, AFTER_DRAIN = false;
    bf16_t* O; int ldc;
    __device__ __forceinline__ void operator()(const f32x4 (&acc)[2][2][4][2], const Unit& u, int wr, int wc, int fr, int fq) const {
        const int row0 = u.pm * BM + wr * 64 + fr, col0 = u.pn * BM + wc * 32 + 8 * fq;
#pragma unroll
        for (int ai = 0; ai < 2; ++ai)
#pragma unroll
            for (int m = 0; m < 4; ++m) { bf16_t* rowp = O + (size_t)(row0 + ai * HALF + m * 16) * ldc + col0;
#pragma unroll
                for (int bj = 0; bj < 2; ++bj) *(u32x4*)(rowp + bj * HALF) = pack8f(acc[ai][bj][m][0], acc[ai][bj][m][1]); }
    }
};
struct EpiPlainS {
    static constexpr bool PERM = true, AFTER_DRAIN = false;
    bf16_t* O; int ldc; float s;
    __device__ __forceinline__ void operator()(const f32x4 (&acc)[2][2][4][2], const Unit& u, int wr, int wc, int fr, int fq) const {
        const int row0 = u.pm * BM + wr * 64 + fr, col0 = u.pn * BM + wc * 32 + 8 * fq;
#pragma unroll
        for (int ai = 0; ai < 2; ++ai)
#pragma unroll
            for (int m = 0; m < 4; ++m) { bf16_t* rowp = O + (size_t)(row0 + ai * HALF + m * 16) * ldc + col0;
#pragma unroll
                for (int bj = 0; bj < 2; ++bj) *(u32x4*)(rowp + bj * HALF) = pack8f(acc[ai][bj][m][0] * s, acc[ai][bj][m][1] * s); }
    }
};
struct EpiPlainS8 {
    static constexpr bool PERM = true, AFTER_DRAIN = false;
    unsigned char* O; int ldc; float s;
    __device__ __forceinline__ void operator()(const f32x4 (&acc)[2][2][4][2], const Unit& u, int wr, int wc, int fr, int fq) const {
        const int row0 = u.pm * BM + wr * 64 + fr, col0 = u.pn * BM + wc * 32 + 8 * fq;
#pragma unroll
        for (int ai = 0; ai < 2; ++ai)
#pragma unroll
            for (int m = 0; m < 4; ++m) { unsigned char* rowp = O + (size_t)(row0 + ai * HALF + m * 16) * ldc + col0;
#pragma unroll
                for (int bj = 0; bj < 2; ++bj) { const f32x4 v0 = acc[ai][bj][m][0] * s, v1 = acc[ai][bj][m][1] * s; u32x2 w; w.x = pk4_fp8(v0[0], v0[1], v0[2], v0[3]); w.y = pk4_fp8(v1[0], v1[1], v1[2], v1[3]); *(u32x2*)(rowp + bj * HALF) = w; } }
    }
};
template <bool ADD> struct EpiGate {
    static constexpr bool PERM = true, AFTER_DRAIN = false;
    bf16_t* O; const bf16_t* gate; const bf16_t* prev;
    __device__ __forceinline__ void operator()(const f32x4 (&acc)[2][2][4][2], const Unit& u, int wr, int wc, int fr, int fq) const {
        const int row0 = u.pm * BM + wr * 64 + fr, col0 = u.pn * BM + wc * 32 + 8 * fq;
#pragma unroll
        for (int ai = 0; ai < 2; ++ai)
#pragma unroll
            for (int m = 0; m < 4; ++m) { const size_t off = (size_t)(row0 + ai * HALF + m * 16) * 2048 + col0;
#pragma unroll
                for (int bj = 0; bj < 2; ++bj) { f32x4 g0, g1; unpack8f(*(const u32x4*)(gate + off + bj * HALF), g0, g1);
                    f32x4 v0, v1;
#pragma unroll
                    for (int i = 0; i < 4; ++i) { v0[i] = sigmoidf_(g0[i]) * acc[ai][bj][m][0][i]; v1[i] = sigmoidf_(g1[i]) * acc[ai][bj][m][1][i]; }
                    if (ADD) { f32x4 p0, p1; unpack8f(*(const u32x4*)(prev + off + bj * HALF), p0, p1); v0 += p0; v1 += p1; }
                    *(u32x4*)(O + off + bj * HALF) = pack8f(v0, v1); } }
    }
};
template <bool IN8, bool OUT8> struct EpiGate2T {
    static constexpr bool PERM = true, AFTER_DRAIN = false, MID = true;
    bf16_t* O; const bf16_t* rat; const bf16_t* sb;
    __device__ __forceinline__ void mid(f32x4 (&acc)[2][2][4][2], const Unit& u, int wr, int wc, int fr, int fq) const {
        const int row0 = u.pm * BM + wr * 64 + fr, col0 = u.pn * BM + wc * 32 + 8 * fq;
#pragma unroll
        for (int ai = 0; ai < 2; ++ai)
#pragma unroll
            for (int m = 0; m < 4; ++m) { const size_t off = (size_t)(row0 + ai * HALF + m * 16) * 2048 + col0;
#pragma unroll
                for (int bj = 0; bj < 2; ++bj) { f32x4 a0, a1; unpack8f(*(const u32x4*)(rat + (size_t)((((((u.pm * 16 + 2 * u.pn + bj) * 2 + ai) * 4 + m) * 8 + (wr * 4 + wc)) * 64 + (fr + 16 * fq)) * 8)), a0, a1); acc[ai][bj][m][0] *= a0; acc[ai][bj][m][1] *= a1; } }
    }
    __device__ __forceinline__ void operator()(const f32x4 (&acc)[2][2][4][2], const Unit& u, int wr, int wc, int fr, int fq) const {
        const int row0 = u.pm * BM + wr * 64 + fr, col0 = u.pn * BM + wc * 32 + 8 * fq;
        constexpr float sc = (IN8 ? 1.0f / 4096.0f : 1.0f) * (OUT8 ? 16.0f : 1.0f);
#pragma unroll
        for (int ai = 0; ai < 2; ++ai) {
            u32x4 gv[4][2];
#pragma unroll
            for (int m = 0; m < 4; ++m)
#pragma unroll
                for (int bj = 0; bj < 2; ++bj) gv[m][bj] = *(const u32x4*)(sb + (size_t)((((((u.pm * 16 + 2 * u.pn + bj) * 2 + ai) * 4 + m) * 8 + (wr * 4 + wc)) * 64 + (fr + 16 * fq)) * 8));
            __builtin_amdgcn_sched_barrier(0);
#pragma unroll
            for (int m = 0; m < 4; ++m) { const size_t off = (size_t)(row0 + ai * HALF + m * 16) * 2048 + col0;
#pragma unroll
                for (int bj = 0; bj < 2; ++bj) { f32x4 g0, g1; unpack8f(gv[m][bj], g0, g1); const f32x4 v0 = acc[ai][bj][m][0] * g0 * sc, v1 = acc[ai][bj][m][1] * g1 * sc;
                    if constexpr (OUT8) { u32x2 w; w.x = pk4_fp8(v0[0], v0[1], v0[2], v0[3]); w.y = pk4_fp8(v1[0], v1[1], v1[2], v1[3]); *(u32x2*)((unsigned char*)O + off + bj * HALF) = w; }
                    else *(u32x4*)(O + off + bj * HALF) = pack8f(v0, v1); } } }
    }
};
struct EpiResid {
    static constexpr bool PERM = true, AFTER_DRAIN = false;
    bf16_t* O; const float* X;
    __device__ __forceinline__ void operator()(const f32x4 (&acc)[2][2][4][2], const Unit& u, int wr, int wc, int fr, int fq) const {
        const int row0 = u.pm * BM + wr * 64 + fr, col0 = u.pn * BM + wc * 32 + 8 * fq;
#pragma unroll
        for (int ai = 0; ai < 2; ++ai)
#pragma unroll
            for (int m = 0; m < 4; ++m) { const size_t off = (size_t)(row0 + ai * HALF + m * 16) * 2048 + col0;
#pragma unroll
                for (int bj = 0; bj < 2; ++bj) { const f32x4 x0 = *(const f32x4*)(X + off + bj * HALF), x1 = *(const f32x4*)(X + off + bj * HALF + 4);
                    *(u32x4*)(O + off + bj * HALF) = pack8f(acc[ai][bj][m][0] + x0, acc[ai][bj][m][1] + x1); } }
    }
};
template <bool IN8> struct EpiResid8T {
    static constexpr bool PERM = true, AFTER_DRAIN = false;
    bf16_t* O; const bf16_t* X; unsigned char* O8;
    __device__ __forceinline__ void operator()(const f32x4 (&acc)[2][2][4][2], const Unit& u, int wr, int wc, int fr, int fq) const {
        const int row0 = u.pm * BM + wr * 64 + fr, col0 = u.pn * BM + wc * 32 + 8 * fq;
#pragma unroll
        for (int ai = 0; ai < 2; ++ai) {
            u32x4 xv[4][2];
#pragma unroll
            for (int m = 0; m < 4; ++m)
#pragma unroll
                for (int bj = 0; bj < 2; ++bj) xv[m][bj] = *(const u32x4*)(X + (size_t)(row0 + ai * HALF + m * 16) * 2048 + col0 + bj * HALF);
            __builtin_amdgcn_sched_barrier(0);
#pragma unroll
            for (int m = 0; m < 4; ++m) { const size_t off = (size_t)(row0 + ai * HALF + m * 16) * 2048 + col0;
#pragma unroll
                for (int bj = 0; bj < 2; ++bj) { f32x4 x0, x1; unpack8f(xv[m][bj], x0, x1); const f32x4 v0 = acc[ai][bj][m][0] * (IN8 ? 1.0f / 4096.0f : 1.0f) + x0, v1 = acc[ai][bj][m][1] * (IN8 ? 1.0f / 4096.0f : 1.0f) + x1;
                    *(u32x4*)(O + off + bj * HALF) = pack8f(v0, v1);
                    u32x2 w; w.x = pk4_fp8(16.f * v0[0], 16.f * v0[1], 16.f * v0[2], 16.f * v0[3]); w.y = pk4_fp8(16.f * v1[0], 16.f * v1[1], 16.f * v1[2], 16.f * v1[3]); *(u32x2*)(O8 + off + bj * HALF) = w; } } }
    }
};
struct EpiMoe1 {
    static constexpr bool PERM = true, AFTER_DRAIN = false;
    bf16_t* Hb; const float* rowscale;
    __device__ __forceinline__ void operator()(const f32x4 (&acc)[2][2][4][2], const Unit& u, int wr, int wc, int fr, int fq) const {
        const int row0 = u.pm * BM + wr * 64 + fr, col0 = u.pn * HALF + wc * 32 + 8 * fq;
#pragma unroll
        for (int ai = 0; ai < 2; ++ai)
#pragma unroll
            for (int m = 0; m < 4; ++m) { const int row = row0 + ai * HALF + m * 16; const float rs = rowscale[row]; f32x4 v0, v1;
#pragma unroll
                for (int i = 0; i < 4; ++i) { const float a0 = acc[ai][0][m][0][i] * rs, b0 = acc[ai][1][m][0][i] * rs, a1 = acc[ai][0][m][1][i] * rs, b1 = acc[ai][1][m][1][i] * rs;
                    v0[i] = a0 * sigmoidf_(a0) * b0; v1[i] = a1 * sigmoidf_(a1) * b1; }
                *(u32x4*)(Hb + (size_t)row * 1024 + col0) = pack8f(v0, v1); }
    }
};
struct EpiMoe1G {
    static constexpr bool PERM = true, AFTER_DRAIN = false;
    bf16_t* Hb; const float* slot_rs; const PG8_LAS int* tab;
    __device__ __forceinline__ void operator()(const f32x4 (&acc)[2][2][4][2], const Unit& u, int wr, int wc, int fr, int fq) const {
        const int row0 = u.pm * BM + wr * 64 + fr, col0 = u.pn * HALF + wc * 32 + 8 * fq; const int e = tab[34 + u.pm], ps = tab[e], cn = tab[194 + e];
#pragma unroll
        for (int ai = 0; ai < 2; ++ai)
#pragma unroll
            for (int m = 0; m < 4; ++m) { const int row = row0 + ai * HALF + m * 16, slot = row - ps; const float rs = slot < cn ? slot_rs[(size_t)e * 16384 + slot] : 0.f; f32x4 v0, v1;
#pragma unroll
                for (int i = 0; i < 4; ++i) { const float a0 = acc[ai][0][m][0][i] * rs, b0 = acc[ai][1][m][0][i] * rs, a1 = acc[ai][0][m][1][i] * rs, b1 = acc[ai][1][m][1][i] * rs;
                    v0[i] = a0 * sigmoidf_(a0) * b0; v1[i] = a1 * sigmoidf_(a1) * b1; }
                *(u32x4*)(Hb + (size_t)row * 1024 + col0) = pack8f(v0, v1); }
    }
};
struct EpiMoe1G8 {
    static constexpr bool PERM = true, AFTER_DRAIN = false;
    unsigned char* Hb; const float* slot_rs; const PG8_LAS int* tab;
    __device__ __forceinline__ void operator()(const f32x4 (&acc)[2][2][4][2], const Unit& u, int wr, int wc, int fr, int fq) const {
        const int e = tab[34 + u.pm], ps = tab[e], cn = tab[194 + e];
        const int slot0 = u.pm * BM + wr * 64 + fr - ps; const float* rsp = slot_rs + (size_t)e * 16384 + slot0; const int hoff = (u.pm * BM + wr * 64 + fr) * 1024 + (u.pn * HALF + wc * 32 + 8 * fq);
        const __amdgpu_buffer_rsrc_t rh = __builtin_amdgcn_make_buffer_rsrc((void*)Hb, 0, 160 * 256 * 1024, 0x00020000);
#pragma unroll
        for (int ai = 0; ai < 2; ++ai) {
            float rsv[4];
#pragma unroll
            for (int m = 0; m < 4; ++m) { const int dr = ai * HALF + m * 16; rsv[m] = (slot0 + dr) < cn ? rsp[dr] : 0.f; }
            __builtin_amdgcn_sched_barrier(0);
#pragma unroll
            for (int m = 0; m < 4; ++m) { const int dr = ai * HALF + m * 16; const float rs = rsv[m] * (1.0f / 4096.0f); f32x4 v0, v1;
#pragma unroll
                for (int i = 0; i < 4; ++i) { const float a0 = acc[ai][0][m][0][i] * rs, b0 = acc[ai][1][m][0][i] * rs, a1 = acc[ai][0][m][1][i] * rs, b1 = acc[ai][1][m][1][i] * rs;
                    v0[i] = 8.f * a0 * sigmoidf_(a0) * b0; v1[i] = 8.f * a1 * sigmoidf_(a1) * b1; }
                u32x2 w; w.x = pk4_fp8(v0[0], v0[1], v0[2], v0[3]); w.y = pk4_fp8(v1[0], v1[1], v1[2], v1[3]); __builtin_amdgcn_raw_buffer_store_b64(w, rh, hoff + dr * 1024, 0, 16);
                }
            asm volatile("" ::: "memory"); }
    }
};
struct MoeGatherOrder {
    int nblk, G, c, tiles_per_e; const PG8_LAS int* tab; const int* tlist; PG8_LAS unsigned* park; unsigned* cnt; mutable int pend;
    __device__ __forceinline__ bool next(int i, Unit& u) const {
        const long L = (long)i * G + c; const int idx = (int)(L >> 3); if (idx >= nblk) return false;
        u.pm = idx; u.pn = (int)(L & 7); u.pb = tab[34 + idx] * tiles_per_e + u.pn; return true;
    }
    __device__ __forceinline__ int arow(const Unit& u, int r) const { const int e = tab[34 + u.pm], slot = u.pm * BM + r - tab[e], cm = tab[194 + e] - 1; return tlist[(size_t)e * 16384 + (slot < cm ? slot : cm)]; }
    __device__ __forceinline__ void a_ready(const Unit&) const {}
    __device__ __forceinline__ void publish(int blk) const { if ((threadIdx.x & 63) == 0) __hip_atomic_fetch_add(cnt + 64 * blk, 1u, __ATOMIC_RELAXED, __HIP_MEMORY_SCOPE_AGENT); }
    __device__ __forceinline__ void done(const Unit& u) const { if (pend >= 0) publish(pend); pend = u.pm; }
    __device__ __forceinline__ void flush() const { asm volatile("s_waitcnt vmcnt(0)" ::: "memory"); if (pend >= 0) publish(pend); pend = -1; }
};
struct MoeCountedOrder {
    int nblk, G, c, i0, n1, tiles_per_e; const PG8_LAS int* blk_e; const unsigned* cnt; volatile PG8_LAS int* bc; mutable unsigned ahead;
    __device__ __forceinline__ bool next(int i, Unit& u) const {
        const long L = (long)(i + i0) * G + c - n1; const int idx = (int)(L >> 3); if (idx >= nblk) return false;
        u.pm = idx; u.pn = (int)(L & 7); u.pb = blk_e[idx] * tiles_per_e + u.pn; return true;
    }
    __device__ __forceinline__ void a_ready(const Unit& u) const {
        if (ahead & 1u) { ahead >>= 1; return; }
        if (threadIdx.x < 64) { unsigned polls = 0, m;
            const int step = G >> 3, bj = u.pm + step * (int)threadIdx.x;
            for (;;) { const unsigned v = (threadIdx.x < 8 && bj < nblk) ? __hip_atomic_load(cnt + 64 * bj, __ATOMIC_RELAXED, __HIP_MEMORY_SCOPE_AGENT) : 64u;
                m = (unsigned)__ballot(v >= 64u) & 0xffu;
                if ((m & 1u) || ++polls > (1u << 20)) break; __builtin_amdgcn_s_sleep(2); }
            __builtin_amdgcn_fence(__ATOMIC_ACQUIRE, "agent");
            asm volatile("s_waitcnt vmcnt(0)" ::: "memory");
            if (threadIdx.x == 0) bc[0] = (int)m; asm volatile("s_waitcnt lgkmcnt(0)" ::: "memory"); }
        asm volatile("" ::: "memory"); __builtin_amdgcn_s_barrier(); asm volatile("" ::: "memory");
        ahead = ((unsigned)__builtin_amdgcn_readfirstlane(bc[0])) >> 1;
    }
    __device__ __forceinline__ void done(const Unit&) const {}
};
struct MoeOrder {
    int nblk, G, c, tiles_per_e; const PG8_LAS int* blk_e;
    __device__ __forceinline__ bool next(int i, Unit& u) const {
        const long L = (long)i * G + c; const int idx = (int)(L >> 3); if (idx >= nblk) return false;
        u.pm = idx; u.pn = (int)(L & 7); u.pb = blk_e[idx] * tiles_per_e + u.pn; return true;
    }
    __device__ __forceinline__ void a_ready(const Unit&) const {}
    __device__ __forceinline__ void done(const Unit&) const {}
};
template <class E_, class = void> struct epi_has_mid { static constexpr bool v = false; };
template <class E_> struct epi_has_mid<E_, decltype((void)E_::MID)> { static constexpr bool v = E_::MID; };
template <class Epi, class Sched, bool ALIGN_EPI = false, bool SP2 = false, bool GATHER = false, bool F8 = false>
__device__ __forceinline__ void gemm_phase(PG8_LAS unsigned char* lds, const Gemm g, const Sched& S, const Epi& E) {
    const int tid = threadIdx.x, wid = __builtin_amdgcn_readfirstlane(tid >> 6), lane = tid & 63, wr = wid >> 2, wc = wid & 3, fr = lane & 15, fq = lane >> 4;
    const int K = g.K, nt = K / BK;
    unsigned voffA[2], voffB[2];
#pragma unroll
    for (int i = 0; i < 2; ++i) { int R, C; stage_rc(tid * 16 + i * 8192, R, C); const int Rb = Epi::PERM ? ((R & ~31) + perm32(R & 31)) : R;
        voffA[i] = (unsigned)(R * K + C) * 2u; voffB[i] = (unsigned)(Rb * K + C) * 2u; }
    static_assert(!GATHER || SP2, "GATHER is implemented for the SP2 loop");
    unsigned cvA[2][2] = {{0u, 0u}, {0u, 0u}}; const unsigned svA[2][2] = {{0u, 0u}, {0u, 0u}};
    const unsigned kstep = (unsigned)(BK * 2);
    const unsigned hstep = (unsigned)HALF * (unsigned)K * 2u;
    const unsigned tstep = 2u * hstep;
    const unsigned qstep = 64u * (unsigned)K * 2u;
    const unsigned ldsw = (unsigned)wid * 1024u;
    const int aoff = F8 ? (lds_byte(wr * 64 + fr, fq * 16) + 16 * (fq & 1)) : lds_byte(wr * 64 + fr, fq * 8), boff = F8 ? (lds_byte(wc * 32 + fr, fq * 16) + 16 * (fq & 1)) : lds_byte(wc * 32 + fr, fq * 8);
    static_assert(!F8 || SP2, "F8 is implemented for the SP2 loop");
#define PG8_SA(b, h) (((b) * 2 + (h)) * HTB)
#define PG8_SB(b, h) ((4 + (b) * 2 + (h)) * HTB)
#define PG8_STAGE(bufoff, gbase, voff) do { _Pragma("unroll") for (int _i = 0; _i < 2; ++_i) \
        __builtin_amdgcn_raw_ptr_buffer_load_lds(rsw, (PG8_LAS void*)(lds + (bufoff) + ldsw + _i * 8192), 16, (int)(voff)[_i], (int)(gbase), 0, 0); } while (0)
#define PG8_STAGE1(bufoff, gbase, voff0) do { _Pragma("unroll") for (int _i = 0; _i < 2; ++_i) \
        __builtin_amdgcn_raw_ptr_buffer_load_lds(rsw, (PG8_LAS void*)(lds + (bufoff) + ldsw + _i * 8192), 16, (int)(voff0), (int)((gbase) + (unsigned)_i * qstep), 0, 0); } while (0)
#define PG8_STAGE_A(bufoff, ptr, h, nx) do { if constexpr (GATHER) { unsigned vo_[2]; vo_[0] = (nx) ? svA[h][0] : cvA[h][0]; vo_[1] = (nx) ? svA[h][1] : cvA[h][1]; PG8_STAGE(bufoff, ptr, vo_); } \
        else { PG8_STAGE1(bufoff, (ptr) + (h) * hstep, voffA[0]); } } while (0)
#define PG8_GOFF(dst, u) do { int t_ = threadIdx.x; asm volatile("" : "+v"(t_)); _Pragma("unroll") for (int i_ = 0; i_ < 2; ++i_) { int R_, C_; stage_rc(t_ * 16 + i_ * 8192, R_, C_); _Pragma("unroll") for (int h_ = 0; h_ < 2; ++h_) dst[h_][i_] = (unsigned)S.arow(u, h_ * HALF + R_) * (unsigned)(K * 2) + (unsigned)C_ * 2u; } } while (0)
#define PG8_LDA(dst, b, h) do { if constexpr (F8) { _Pragma("unroll") for (int m = 0; m < 4; ++m) { const v4i_t lo_ = *(const PG8_LAS v4i_t*)(lds + PG8_SA(b, h) + aoff + m * 2048), hi_ = *(const PG8_LAS v4i_t*)(lds + PG8_SA(b, h) + (aoff ^ 16) + m * 2048); \
            dst##8[m] = __builtin_shufflevector(lo_, hi_, 0, 1, 2, 3, 4, 5, 6, 7); } } \
        else { _Pragma("unroll") for (int m = 0; m < 4; ++m) _Pragma("unroll") for (int k = 0; k < 2; ++k) dst[m][k] = *(const PG8_LAS bf16x8*)(lds + PG8_SA(b, h) + aoff + m * 2048 + k * 1024); } } while (0)
#define PG8_LDB(dst, b, h) do { if constexpr (F8) { _Pragma("unroll") for (int n = 0; n < 2; ++n) { const v4i_t lo_ = *(const PG8_LAS v4i_t*)(lds + PG8_SB(b, h) + boff + n * 2048), hi_ = *(const PG8_LAS v4i_t*)(lds + PG8_SB(b, h) + (boff ^ 16) + n * 2048); \
            dst##8[n] = __builtin_shufflevector(lo_, hi_, 0, 1, 2, 3, 4, 5, 6, 7); } } \
        else { _Pragma("unroll") for (int n = 0; n < 2; ++n) _Pragma("unroll") for (int k = 0; k < 2; ++k) dst[n][k] = *(const PG8_LAS bf16x8*)(lds + PG8_SB(b, h) + boff + n * 2048 + k * 1024); } } while (0)
#define PG8_MMA(ai, bj, At, Bt) do { __builtin_amdgcn_s_setprio(1); if constexpr (F8) { _Pragma("unroll") for (int m = 0; m < 4; ++m) _Pragma("unroll") for (int n = 0; n < 2; ++n) \
            acc[ai][bj][m][n] = __builtin_amdgcn_mfma_scale_f32_16x16x128_f8f6f4(Bt##8[n], At##8[m], acc[ai][bj][m][n], 0, 0, 0, 0, 0, 0); } \
        else { _Pragma("unroll") for (int m = 0; m < 4; ++m) _Pragma("unroll") for (int n = 0; n < 2; ++n) _Pragma("unroll") for (int k = 0; k < 2; ++k) \
            acc[ai][bj][m][n] = __builtin_amdgcn_mfma_f32_16x16x32_bf16(Bt[n][k], At[m][k], acc[ai][bj][m][n], 0, 0, 0); } __builtin_amdgcn_s_setprio(0); } while (0)
#define PG8_WAIT_V(n) asm volatile("s_waitcnt vmcnt(" #n ")" ::: "memory")
#define PG8_WAIT_L(n) asm volatile("s_waitcnt lgkmcnt(" #n ")" ::: "memory")
#define PG8_BAR __builtin_amdgcn_s_barrier()
#define PG8_SCHED __builtin_amdgcn_sched_barrier(0)
    Unit cur, nxt; int ui = 0;
    if (!S.next(0, cur)) return;
    f32x4 acc[2][2][4][2];
#pragma unroll
    for (int a = 0; a < 2; ++a)
#pragma unroll
        for (int b = 0; b < 2; ++b)
#pragma unroll
            for (int m = 0; m < 4; ++m)
#pragma unroll
                for (int n = 0; n < 2; ++n) acc[a][b][m][n] = (f32x4){0.f, 0.f, 0.f, 0.f};
    bf16x8 At[4][2], B0[2][2], B1[2][2]; v8i_t At8[4], B08[2], B18[2];
    const __amdgpu_buffer_rsrc_t rsw = __builtin_amdgcn_make_buffer_rsrc((void*)g.base, 0, 0x7ffffff0, 0x00020000);
    const unsigned oA0 = (unsigned)((const char*)g.A - (const char*)g.base), oB0 = (unsigned)((const char*)g.Bt - (const char*)g.base);
    unsigned cA = oA0 + (GATHER ? 0u : (unsigned)cur.pm * tstep); unsigned cB = oB0 + (unsigned)cur.pb * tstep;
    if constexpr (GATHER) PG8_GOFF(cvA, cur);
    S.a_ready(cur);
    if constexpr (SP2) {
        PG8_STAGE1(PG8_SB(0, 0), cB, voffB[0]); PG8_STAGE1(PG8_SB(0, 1), cB + hstep, voffB[0]); PG8_STAGE_A(PG8_SA(0, 0), cA, 0, false); PG8_STAGE_A(PG8_SA(0, 1), cA, 1, false);
        if (wr == 1) PG8_BAR;
        PG8_WAIT_V(2); PG8_BAR;
        PG8_STAGE1(PG8_SB(1, 0), cB + kstep, voffB[0]); PG8_STAGE_A(PG8_SA(1, 0), cA + kstep, 0, false); PG8_STAGE1(PG8_SB(1, 1), cB + hstep + kstep, voffB[0]);
        PG8_WAIT_V(6); PG8_BAR;
    } else {
        PG8_STAGE1(PG8_SB(0, 0), cB, voffB[0]); PG8_STAGE(PG8_SA(0, 0), cA, voffA); PG8_STAGE1(PG8_SB(0, 1), cB + hstep, voffB[0]); PG8_STAGE(PG8_SA(0, 1), cA + hstep, voffA);
        if (wr == 1) PG8_BAR;
        PG8_WAIT_V(4); PG8_BAR;
        PG8_STAGE1(PG8_SB(1, 0), cB + kstep, voffB[0]); PG8_STAGE(PG8_SA(1, 0), cA + kstep, voffA); PG8_STAGE1(PG8_SB(1, 1), cB + hstep + kstep, voffB[0]);
        PG8_WAIT_V(6); PG8_BAR;
    }
    for (;;) {
        const bool has_next = S.next(ui + 1, nxt);
        if constexpr (GATHER) { if (ui == 0) { unsigned tv_[2][2]; if (has_next) PG8_GOFF(tv_, nxt); else { tv_[0][0] = cvA[0][0]; tv_[0][1] = cvA[0][1]; tv_[1][0] = cvA[1][0]; tv_[1][1] = cvA[1][1]; }
            { int t_ = threadIdx.x; asm volatile("" : "+v"(t_)); *(PG8_LAS u32x4*)(S.park + t_ * 4) = (u32x4){tv_[0][0], tv_[0][1], tv_[1][0], tv_[1][1]}; } } }
        const unsigned nA = (has_next && !GATHER) ? oA0 + (unsigned)nxt.pm * tstep : cA; const unsigned nB = has_next ? oB0 + (unsigned)nxt.pb * tstep : cB;
#pragma unroll 1
        for (int t = 0; t < nt; t += 2) {
            const bool last = (t == nt - 2);
            const unsigned a1 = cA + (unsigned)(t + 1) * kstep;
            const unsigned a2 = last ? nA : cA + (unsigned)(t + 2) * kstep; const unsigned b2 = last ? nB : cB + (unsigned)(t + 2) * kstep;
            const unsigned a3 = a2 + kstep; const unsigned b3 = b2 + kstep;
            if (last && has_next) S.a_ready(nxt);
            if constexpr (epi_has_mid<Epi>::v) { if (t == (nt >> 1)) { int t_ = threadIdx.x; asm volatile("" : "+v"(t_)); const int l_ = t_ & 63, w_ = __builtin_amdgcn_readfirstlane(t_ >> 6); E.mid(acc, cur, w_ >> 2, w_ & 3, l_ & 15, l_ >> 4); } }
            unsigned svA[2][2] = {{cvA[0][0], cvA[0][1]}, {cvA[1][0], cvA[1][1]}};
            if constexpr (GATHER) { if (last) { int t_ = threadIdx.x; asm volatile("" : "+v"(t_)); const u32x4 pv_ = *(const PG8_LAS u32x4*)(S.park + t_ * 4); svA[0][0] = pv_.x; svA[0][1] = pv_.y; svA[1][0] = pv_.z; svA[1][1] = pv_.w; } }
            if constexpr (SP2) {
            PG8_LDB(B0, 0, 0); PG8_LDB(B1, 0, 1); PG8_SCHED; PG8_LDA(At, 0, 0); PG8_STAGE_A(PG8_SA(1, 1), a1, 1, false);
            PG8_WAIT_V(8); PG8_WAIT_L(0); PG8_BAR; PG8_MMA(0, 0, At, B0); PG8_MMA(0, 1, At, B1); PG8_BAR; PG8_SCHED;
            PG8_LDA(At, 0, 1); PG8_STAGE1(PG8_SB(0, 0), b2, voffB[0]); PG8_STAGE1(PG8_SB(0, 1), b2 + hstep, voffB[0]); PG8_STAGE_A(PG8_SA(0, 0), a2, 0, last);
            PG8_WAIT_V(8); PG8_WAIT_L(0); PG8_BAR; PG8_MMA(1, 0, At, B0); PG8_MMA(1, 1, At, B1); PG8_BAR; PG8_SCHED;
            PG8_LDB(B0, 1, 0); PG8_LDB(B1, 1, 1); PG8_SCHED; PG8_LDA(At, 1, 0); PG8_STAGE_A(PG8_SA(0, 1), a2, 1, last);
            PG8_WAIT_V(8); PG8_WAIT_L(0); PG8_BAR; PG8_MMA(0, 0, At, B0); PG8_MMA(0, 1, At, B1); PG8_BAR; PG8_SCHED;
            PG8_LDA(At, 1, 1); PG8_STAGE1(PG8_SB(1, 0), b3, voffB[0]); PG8_STAGE1(PG8_SB(1, 1), b3 + hstep, voffB[0]); PG8_STAGE_A(PG8_SA(1, 0), a3, 0, last);
            PG8_WAIT_V(8); PG8_WAIT_L(0); PG8_BAR; PG8_MMA(1, 0, At, B0); PG8_MMA(1, 1, At, B1); PG8_BAR; PG8_SCHED;
            } else {
            PG8_LDB(B0, 0, 0); PG8_SCHED; PG8_LDA(At, 0, 0); PG8_STAGE(PG8_SA(1, 1), a1 + hstep, voffA);
            PG8_WAIT_L(8); PG8_BAR; PG8_WAIT_L(0); PG8_MMA(0, 0, At, B0); PG8_BAR; PG8_SCHED;
            PG8_LDB(B1, 0, 1); PG8_STAGE1(PG8_SB(0, 0), b2, voffB[0]);
            PG8_BAR; PG8_WAIT_L(0); PG8_MMA(0, 1, At, B1); PG8_BAR;
            PG8_LDA(At, 0, 1); PG8_STAGE(PG8_SA(0, 0), a2, voffA);
            PG8_BAR; PG8_WAIT_L(0); PG8_MMA(1, 0, At, B0); PG8_BAR; PG8_SCHED;
            PG8_STAGE1(PG8_SB(0, 1), b2 + hstep, voffB[0]);
            PG8_WAIT_V(6); PG8_BAR; PG8_MMA(1, 1, At, B1); PG8_BAR;
            PG8_LDB(B0, 1, 0); PG8_SCHED; PG8_LDA(At, 1, 0); PG8_STAGE(PG8_SA(0, 1), a2 + hstep, voffA);
            PG8_WAIT_L(8); PG8_BAR; PG8_WAIT_L(0); PG8_MMA(0, 0, At, B0); PG8_BAR; PG8_SCHED;
            PG8_LDB(B1, 1, 1); PG8_STAGE1(PG8_SB(1, 0), b3, voffB[0]);
            PG8_BAR; PG8_WAIT_L(0); PG8_MMA(0, 1, At, B1); PG8_BAR;
            PG8_LDA(At, 1, 1); PG8_STAGE(PG8_SA(1, 0), a3, voffA);
            PG8_BAR; PG8_WAIT_L(0); PG8_MMA(1, 0, At, B0); PG8_BAR; PG8_SCHED;
            PG8_STAGE1(PG8_SB(1, 1), b3 + hstep, voffB[0]);
            PG8_WAIT_V(6); PG8_BAR; PG8_MMA(1, 1, At, B1); PG8_BAR;
            }
        }
        Unit nn2; bool has_nn = false; unsigned tv2[2][2] = {{0u, 0u}, {0u, 0u}};
        if constexpr (GATHER) { has_nn = has_next && S.next(ui + 2, nn2); if (has_nn) PG8_GOFF(tv2, nn2); }
        if constexpr (ALIGN_EPI) { if (wr == 0) PG8_BAR; }
        if constexpr (!Epi::AFTER_DRAIN) { int t_ = threadIdx.x; asm volatile("" : "+v"(t_));
            const int l_ = t_ & 63, w_ = __builtin_amdgcn_readfirstlane(t_ >> 6); E(acc, cur, w_ >> 2, w_ & 3, l_ & 15, l_ >> 4); S.done(cur); }
        if (!has_next) break;
#pragma unroll
        for (int a = 0; a < 2; ++a)
#pragma unroll
            for (int b = 0; b < 2; ++b)
#pragma unroll
                for (int m = 0; m < 4; ++m)
#pragma unroll
                    for (int n = 0; n < 2; ++n) acc[a][b][m][n] = (f32x4){0.f, 0.f, 0.f, 0.f};
        cur = nxt; cA = nA; cB = nB; ++ui;
        if constexpr (GATHER) { int t_ = threadIdx.x; asm volatile("" : "+v"(t_)); const u32x4 pv_ = *(const PG8_LAS u32x4*)(S.park + t_ * 4); cvA[0][0] = pv_.x; cvA[0][1] = pv_.y; cvA[1][0] = pv_.z; cvA[1][1] = pv_.w;
            *(PG8_LAS u32x4*)(S.park + t_ * 4) = has_nn ? (u32x4){tv2[0][0], tv2[0][1], tv2[1][0], tv2[1][1]} : pv_; }
        if constexpr (ALIGN_EPI) { if (wr == 1) PG8_BAR; }
    }
    PG8_WAIT_V(0);
    if constexpr (!ALIGN_EPI) { if (wr == 0) PG8_BAR; }
    PG8_BAR;
    if constexpr (Epi::AFTER_DRAIN) { E.fused(acc, cur, wr, wc, fr, fq, lds, wid, lane); S.done(cur); }
#undef PG8_SA
#undef PG8_SB
#undef PG8_STAGE
#undef PG8_STAGE_A
#undef PG8_GOFF
#undef PG8_LDA
#undef PG8_LDB
#undef PG8_MMA
#undef PG8_WAIT_V
#undef PG8_WAIT_L
#undef PG8_BAR
#undef PG8_SCHED
}
}

constexpr int NWAVES = 8;
constexpr int BATCH = 4, SEQ = 4096, DM = 2048, T = BATCH * SEQ;
constexpr int NCOLS = 11272, NPROJ = 11264, NPROJ16 = 1024 * PJ16.n, NPROJ8 = 4096 + 1024 * PJ8.n, GATE_COL0 = 7176;
constexpr int NH = 8, HD = 128, MW = NH * HD;
constexpr int NEXP = 32, NGRP = 4, EPG = 8, DFF = 1024;
constexpr int MAXBLK = 160, MAXROWS = MAXBLK * 256;
constexpr float EPS = 1e-6f;
constexpr float ATT_SCALE = 0.08838834764831845f;

constexpr size_t MiB = 1u << 20, KiB = 1u << 10;
constexpr size_t WS_CTL = 0, CTL_ZERO_BYTES = 128 * KiB;
constexpr size_t WS_RSTD1 = 1 * MiB, WS_LOGF = WS_RSTD1 + 64 * KiB, WS_CUM = WS_LOGF + 512 * KiB, WS_RSTD2 = WS_CUM + 512 * KiB,
                 WS_AE = WS_RSTD2 + 64 * KiB, WS_ASLOT = WS_AE + 128 * KiB, WS_AW = WS_ASLOT + 128 * KiB, WS_TOKROW = WS_AW + 128 * KiB, WS_ROWSCALE = WS_TOKROW + 128 * KiB;
static_assert(WS_ROWSCALE + MAXROWS * 4 <= 4 * MiB, "small arrays");
constexpr size_t WS_DEC = 5 * MiB;
constexpr size_t WS_TLIST = 6 * MiB, WS_SLOTRS = 8 * MiB;
constexpr size_t WS_WR = 4 * MiB;
constexpr size_t WS_WIN = 16 * MiB, WS_PAB = 60 * MiB, WS_WOUT = 68 * MiB, WS_W13 = 76 * MiB, WS_W2 = 204 * MiB, WS_ARENA = 268 * MiB;
constexpr size_t AR(size_t m) { return WS_ARENA + m * MiB; }
constexpr size_t WS_GT = AR(0);
constexpr size_t WS_HG = AR(128);
constexpr size_t WS_QKV = AR(256);
constexpr size_t WS_OAB = AR(512);
constexpr size_t WS_U = AR(384), WS_S = AR(448);
constexpr size_t WS_X8 = AR(448);
constexpr size_t WS_WIN8 = AR(480);
constexpr size_t WS_XB = AR(576);
constexpr size_t WS_OBF = AR(384);
constexpr size_t WS_MRG = AR(384);
constexpr size_t WS_X1B = AR(0);
constexpr size_t WS_X1F8 = AR(64);
constexpr size_t WS_XBUF = AR(64);
constexpr size_t WS_HBUF = AR(224);
constexpr size_t WS_YBUF = AR(304);
constexpr size_t WS_END = AR(640);
static_assert(WS_END <= 1024 * MiB, "d_ws map");
constexpr int CW_TMO = 0, CW_CODE = 1, CW_BAR = 4096, CW_CNT = 16384, CW_NRM = 16512, CW_QUEUE = 16832, CW_CONVQ = 16896, CW_P1STOP = 16960, CW_HB = 17408, CW_SCAN = 28672;

constexpr int RING_OFF = 0, RING_BYTES = 131072;
constexpr int LDSCTL_OFF = RING_BYTES, MISC_OFF = LDSCTL_OFF + 320;
constexpr int MOE_TAB_OFF = MISC_OFF + 128;
constexpr int PARK_OFF = MOE_TAB_OFF + 1024;
constexpr int LDS_BYTES = 147456;
static_assert(PARK_OFF % 16 == 0 && PARK_OFF + 8192 <= LDS_BYTES, "LDS map");
static_assert(MOE_TAB_OFF + (33 + 1 + 160 + 32) * 4 <= LDS_BYTES, "LDS map");

#define GAS __attribute__((address_space(1)))
#define LAS __attribute__((address_space(3)))
typedef unsigned short bf16;
#if P5_F8
typedef unsigned char OAB_t;
#else
typedef unsigned short OAB_t;
#endif
typedef unsigned v4u __attribute__((ext_vector_type(4)));
typedef unsigned v2u __attribute__((ext_vector_type(2)));
typedef float f32x4 __attribute__((ext_vector_type(4)));
typedef float f32x2v __attribute__((ext_vector_type(2)));
typedef short bf16x8 __attribute__((ext_vector_type(8)));
typedef GAS unsigned gu32;
#define RLX_AGENT __ATOMIC_RELAXED, __HIP_MEMORY_SCOPE_AGENT
#define LDS_WAIT() asm volatile("s_waitcnt lgkmcnt(0)" ::: "memory")
#define VM_WAIT() asm volatile("s_waitcnt vmcnt(0)" ::: "memory")
__device__ __forceinline__ float bflo(unsigned u) { return __uint_as_float(u << 16); }
__device__ __forceinline__ float bfhi(unsigned u) { return __uint_as_float(u & 0xffff0000u); }
__device__ __forceinline__ float bf1(bf16 h) { return __uint_as_float((unsigned)h << 16); }
__device__ __forceinline__ unsigned pk2(float lo, float hi) { unsigned r; asm volatile("v_cvt_pk_bf16_f32 %0, %1, %2" : "=v"(r) : "v"(lo), "v"(hi)); return r; }
__device__ __forceinline__ float sigm(float x) { return 1.0f / (1.0f + __expf(-x)); }
template <int CTRL> __device__ __forceinline__ float dpp_f(float v) { return __builtin_bit_cast(float, __builtin_amdgcn_update_dpp(0, __builtin_bit_cast(int, v), CTRL, 0xF, 0xF, true)); }
__device__ __forceinline__ float wave_sum(float v) {
    v += dpp_f<0xB1>(v); v += dpp_f<0x4E>(v); v += dpp_f<0x141>(v); v += dpp_f<0x140>(v);
    v += __shfl_xor(v, 16); v += __shfl_xor(v, 32);
    return v;
}
template <int CTRL> __device__ __forceinline__ int dpp_i(int v) { return __builtin_amdgcn_update_dpp(0, v, CTRL, 0xF, 0xF, true); }
__device__ __forceinline__ int wave_isum(int v) { v += dpp_i<0xB1>(v); v += dpp_i<0x4E>(v); v += dpp_i<0x141>(v); v += dpp_i<0x140>(v); v += __shfl_xor(v, 16); v += __shfl_xor(v, 32); return v; }
__device__ __forceinline__ float wave_fmax(float v) { v = fmaxf(v, dpp_f<0xB1>(v)); v = fmaxf(v, dpp_f<0x4E>(v)); v = fmaxf(v, dpp_f<0x141>(v)); v = fmaxf(v, dpp_f<0x140>(v)); v = fmaxf(v, __shfl_xor(v, 16)); v = fmaxf(v, __shfl_xor(v, 32)); return v; }
#define XB_TMO      128
#define XB_XCNT(j)  (256  + 64 * (j))
#define XB_XSUB(j)  (1280 + 64 * (j))
#define XB_XGEN(j)  (2304 + 64 * (j))
#define XB_TOP      3328
#define XB_TOPGEN   3392
#define XCD_BAR_WORDS 3456
#define XB_SPIN_CAP (1u << 18)

__device__ __forceinline__ unsigned xb_ld(unsigned* p)              { return __hip_atomic_load(p, __ATOMIC_RELAXED, __HIP_MEMORY_SCOPE_AGENT); }
__device__ __forceinline__ unsigned xb_add(unsigned* p, unsigned v) { return __hip_atomic_fetch_add(p, v, __ATOMIC_RELAXED, __HIP_MEMORY_SCOPE_AGENT); }
__device__ __forceinline__ unsigned xb_xcc_id() { return (unsigned)__builtin_amdgcn_s_getreg((3 << 11) | 20) & 0xFu; }
#define XB_SPIN(cond, bar) do { unsigned _sp = 0; while (cond) { __builtin_amdgcn_s_sleep(1); \
    if ((++_sp & 255u) == 0u) { if (xb_ld(&(bar)[XB_TMO])) break; if (_sp > XB_SPIN_CAP) { atomicAdd(&(bar)[XB_TMO], 1u); break; } } } } while (0)

struct XcdBarrier {
    unsigned* bar; unsigned x;
    volatile LAS unsigned* st;
};

__device__ __forceinline__ XcdBarrier xcd_barrier_post(unsigned* bar, volatile LAS unsigned* st) {
    XcdBarrier b; b.bar = bar; b.x = xb_xcc_id(); b.st = st;
    if (threadIdx.x == 0) (void)xb_add(&bar[XB_XCNT(b.x)], 1u);
    return b;
}
__device__ __forceinline__ void xcd_barrier_complete(unsigned* bar, unsigned x, unsigned& nloc, unsigned& nx) {
    const unsigned G = gridDim.x * gridDim.y * gridDim.z;
    unsigned sum, cnt, mine, sp = 0u;
    for (;;) {
        sum = 0u; cnt = 0u; mine = 0u;
#pragma unroll
        for (unsigned j = 0; j < 16; ++j) { const unsigned c = xb_ld(&bar[XB_XCNT(j)]); sum += c; cnt += (c > 0u) ? 1u : 0u; mine = (j == x) ? c : mine; }
        if (sum == G) break;
        __builtin_amdgcn_s_sleep(1);
        if ((++sp & 255u) == 0u) { if (xb_ld(&bar[XB_TMO])) break; if (sp > XB_SPIN_CAP) { atomicAdd(&bar[XB_TMO], 1u); break; } }
    }
    nloc = mine > 0u ? mine : 1u; nx = cnt > 0u ? cnt : 1u;
}

__device__ __forceinline__ void xcd_barrier(const XcdBarrier& b) {
    asm volatile("s_waitcnt vmcnt(0)" ::: "memory");
    __syncthreads();
    if (threadIdx.x == 0) {
        unsigned* bar = b.bar;
        __builtin_amdgcn_s_waitcnt(0);
        unsigned nloc = b.st[0], nx = b.st[1];
        if (nloc == 0u) { xcd_barrier_complete(bar, b.x, nloc, nx); b.st[0] = nloc; b.st[1] = nx; }
        const unsigned old = xb_add(&bar[XB_XSUB(b.x)], 1u);
        const unsigned gen = old / nloc;
        if (old + 1u == (gen + 1u) * nloc) {
            __builtin_amdgcn_fence(__ATOMIC_RELEASE, "agent");
            asm volatile("s_waitcnt vmcnt(0)" ::: "memory");
            const unsigned og = xb_add(&bar[XB_TOP], 1u);
            const unsigned tg = og / nx;
            if (og + 1u == (tg + 1u) * nx) xb_add(&bar[XB_TOPGEN], 1u);
            else XB_SPIN(xb_ld(&bar[XB_TOPGEN]) == tg, bar);
            __builtin_amdgcn_fence(__ATOMIC_ACQUIRE, "agent");
            xb_add(&bar[XB_XGEN(b.x)], 1u);
            asm volatile("s_waitcnt vmcnt(0)" ::: "memory");
        } else {
            XB_SPIN(xb_ld(&bar[XB_XGEN(b.x)]) == gen, bar);
            __builtin_amdgcn_fence(__ATOMIC_ACQUIRE, "agent");
            asm volatile("s_waitcnt vmcnt(0)" ::: "memory");
        }
    }
    __syncthreads();
}

#include <hip/hip_bf16.h>
namespace fox {
constexpr int D = 128, OSTRIDE = 2048;
constexpr float THR = 8.f;
constexpr bool WSKIP = false;
constexpr float SCALE = 0.08838834764831845f;
constexpr int NW = 8, QBLK = 32, KVBLK = 64, QB = NW * QBLK;
constexpr int SHM_V = KVBLK * D * 2, SHM_K = KVBLK * D * 2;
constexpr int ATT_LDS = 2 * SHM_V + 2 * SHM_K + NW * 64 * 4;
constexpr int LDS_CUM = ATT_LDS, LDS_KB = ATT_LDS + 16384, ATT_LDS_TOTAL = ATT_LDS + 32768;

using bf16 = __hip_bfloat16;
typedef short bf16x8 __attribute__((ext_vector_type(8)));
typedef short s16x4 __attribute__((ext_vector_type(4)));
typedef float f32x16 __attribute__((ext_vector_type(16)));
typedef float f32x4 __attribute__((ext_vector_type(4)));
typedef unsigned u32x4 __attribute__((ext_vector_type(4)));
template <class A, class Bt> struct same_t { static constexpr bool v = false; };
template <class A> struct same_t<A, A> { static constexpr bool v = true; };

#define KSWZ(row, colB) ((row) * 256 + ((colB) ^ (((row) & 7) << 4)))
#define SBAR() __builtin_amdgcn_sched_barrier(0)
__device__ __forceinline__ int v_st(int k, int c) { const int kk = (k & ~0xC) | ((k & 4) << 1) | ((k & 8) >> 1); return ((kk >> 3) * 4 + (c >> 5)) * 512 + ((kk & 7) * 32 + (c & 31)) * 2; }
__device__ __forceinline__ int v_rd_base(int lane) { return ((lane & 3) << 3) | (((lane >> 2) & 3) << 6) | (((lane >> 4) & 1) << 5) | (((lane >> 5) & 1) << 8); }
constexpr int v_rd_off(int d0, int ks, int half) { return d0 * 512 + ks * 4096 + half * 2048; }
__device__ __forceinline__ int crow(int r, int hi) { return (r & 3) + 8 * (r >> 2) + 4 * hi; }
__device__ __forceinline__ unsigned cvtpk(float lo, float hi) {
    typedef float f2_t __attribute__((ext_vector_type(2))); typedef __bf16 b2_t __attribute__((ext_vector_type(2)));
    const f2_t v = {lo, hi}; const b2_t b = __builtin_convertvector(v, b2_t); return __builtin_bit_cast(unsigned, b);
}
__device__ __forceinline__ bf16x8 pack8(f32x4 a, f32x4 b) {
    u32x4 w = {cvtpk(a[0], a[1]), cvtpk(a[2], a[3]), cvtpk(b[0], b[1]), cvtpk(b[2], b[3])};
    return *reinterpret_cast<bf16x8*>(&w);
}
template <class T> __device__ __forceinline__ bf16x8 load8(const T* p) {
    if constexpr (same_t<T, float>::v) { return pack8(*(const f32x4*)p, *(const f32x4*)(p + 4)); }
    else { return *reinterpret_cast<const bf16x8*>(p); }
}
__device__ __forceinline__ void mask_tile(f32x16& p0, f32x16& p1, int dq, unsigned W) {
    const float NEG = -__builtin_inff();
#pragma unroll
    for (int r = 0; r < 16; ++r) {
        const int c = (r & 3) + 8 * (r >> 2);
        if ((unsigned)(dq - c) >= W) p0[r] = NEG;
        if ((unsigned)(dq - c - 32) >= W) p1[r] = NEG;
    }
}
__device__ __forceinline__ void partialSM(f32x16& p0, f32x16& p1, float& m_reg, float& mn, float& alpha) {
    float pmax = p0[0]; for (int r = 1; r < 16; ++r) pmax = fmaxf(pmax, p0[r]); for (int r = 0; r < 16; ++r) pmax = fmaxf(pmax, p1[r]);
    { auto rr = __builtin_amdgcn_permlane32_swap(__float_as_uint(pmax), __float_as_uint(pmax), false, false);
      pmax = fmaxf(__uint_as_float(rr[0]), __uint_as_float(rr[1])); }
    constexpr float C2 = 1.4426950408889634f * SCALE;
    if (__builtin_expect(__all((pmax - m_reg) * SCALE <= THR), 1)) { mn = m_reg; alpha = 1.f; }
    else { mn = fmaxf(m_reg, pmax); alpha = __builtin_amdgcn_exp2f((m_reg - mn) * C2); m_reg = mn; }
    const float mnL = -mn * C2;
    for (int r = 0; r < 16; ++r) p0[r] = fmaf(p0[r], C2, mnL); for (int r = 0; r < 16; ++r) p1[r] = fmaf(p1[r], C2, mnL);
    for (int r = 0; r < 16; ++r) p0[r] = __builtin_amdgcn_exp2f(p0[r]);
}
__device__ __forceinline__ void finishSM(f32x16& p0, f32x16& p1, float alpha, float& l_reg, bf16x8& pa0, bf16x8& pa1, bf16x8& pa2, bf16x8& pa3) {
    for (int r = 0; r < 16; ++r) p1[r] = __builtin_amdgcn_exp2f(p1[r]);
    float ps = 0; for (int r = 0; r < 16; ++r) ps += p0[r]; for (int r = 0; r < 16; ++r) ps += p1[r];
    { auto rr = __builtin_amdgcn_permlane32_swap(__float_as_uint(ps), __float_as_uint(ps), false, false);
      ps = __uint_as_float(rr[0]) + __uint_as_float(rr[1]); }
    l_reg = l_reg * alpha + ps;
#define PK4(P, B_, OUT) do { unsigned a0 = cvtpk(P[B_+0], P[B_+1]), a1 = cvtpk(P[B_+2], P[B_+3]);                          \
        unsigned b0 = cvtpk(P[B_+4], P[B_+5]), b1 = cvtpk(P[B_+6], P[B_+7]);                                             \
        auto r0 = __builtin_amdgcn_permlane32_swap(a0, b0, false, false); auto r1 = __builtin_amdgcn_permlane32_swap(a1, b1, false, false); \
        u32x4 w = {r0[0], r1[0], r0[1], r1[1]}; OUT = *reinterpret_cast<bf16x8*>(&w); } while (0)
    PK4(p0, 0, pa0); PK4(p0, 8, pa1); PK4(p1, 0, pa2); PK4(p1, 8, pa3);
#undef PK4
}
template <int KB, bool SK>
__device__ __forceinline__ void qkt(f32x16& p0, f32x16& p1, const char* K_lds, int r32, int hi, const bf16x8* qr, bool act, const float* kbt  ) {
    if (SK && !act) { const float NEG = -__builtin_inff();
#pragma unroll
        for (int r = 0; r < 16; ++r) { p0[r] = NEG; p1[r] = NEG; } return; }
#pragma unroll
    for (int g = 0; g < 4; ++g) { const f32x4 a = *(const f32x4*)(kbt + 8 * g), b = *(const f32x4*)(kbt + 32 + 8 * g);
        p0[4 * g] = a[0]; p0[4 * g + 1] = a[1]; p0[4 * g + 2] = a[2]; p0[4 * g + 3] = a[3]; p1[4 * g] = b[0]; p1[4 * g + 1] = b[1]; p1[4 * g + 2] = b[2]; p1[4 * g + 3] = b[3]; }
    const char* kb[4];
#pragma unroll
    for (int dd = 0; dd < 4; ++dd) kb[dd] = K_lds + KB * SHM_K + KSWZ(r32, (dd * 16 + hi * 8) * 2);
#pragma unroll
    for (int d0 = 0; d0 < 8; ++d0) { const char* a = kb[d0 & 3] + (d0 >> 2) * 128;
        bf16x8 b0 = *reinterpret_cast<const bf16x8*>(a);
        bf16x8 b1 = *reinterpret_cast<const bf16x8*>(a + 32 * 256);
        p0 = __builtin_amdgcn_mfma_f32_32x32x16_bf16(b0, qr[d0], p0, 0, 0, 0);
        p1 = __builtin_amdgcn_mfma_f32_32x32x16_bf16(b1, qr[d0], p1, 0, 0, 0); }
}
template <int VB, bool SK>
__device__ __forceinline__ void pv_tile(f32x16* o, int vb0, bf16x8 pa0, bf16x8 pa1, bf16x8 pa2, bf16x8 pa3, bool act) {
    if (SK && !act) return;
#define TRRD(dst, off) asm volatile("ds_read_b64_tr_b16 %0, %1 offset:%2" : "=&v"(dst) : "v"(vb0), "i"(off) : "memory")
#define PV_D0(d0) do { s16x4 l0, l1, l2, l3, h0, h1, h2, h3; constexpr int b_ = VB * SHM_V + v_rd_off(d0, 0, 0);     \
        TRRD(l0, b_); TRRD(h0, b_ + 2048); TRRD(l1, b_ + 4096); TRRD(h1, b_ + 6144); TRRD(l2, b_ + 8192); TRRD(h2, b_ + 10240); TRRD(l3, b_ + 12288); TRRD(h3, b_ + 14336); \
        asm volatile("s_waitcnt lgkmcnt(0)" ::: "memory"); SBAR();                 \
        o[d0] = __builtin_amdgcn_mfma_f32_32x32x16_bf16(pa0, (bf16x8){l0[0], l0[1], l0[2], l0[3], h0[0], h0[1], h0[2], h0[3]}, o[d0], 0, 0, 0);   \
        o[d0] = __builtin_amdgcn_mfma_f32_32x32x16_bf16(pa1, (bf16x8){l1[0], l1[1], l1[2], l1[3], h1[0], h1[1], h1[2], h1[3]}, o[d0], 0, 0, 0);   \
        o[d0] = __builtin_amdgcn_mfma_f32_32x32x16_bf16(pa2, (bf16x8){l2[0], l2[1], l2[2], l2[3], h2[0], h2[1], h2[2], h2[3]}, o[d0], 0, 0, 0);   \
        o[d0] = __builtin_amdgcn_mfma_f32_32x32x16_bf16(pa3, (bf16x8){l3[0], l3[1], l3[2], l3[3], h3[0], h3[1], h3[2], h3[3]}, o[d0], 0, 0, 0); } while (0)
    PV_D0(0); PV_D0(1); PV_D0(2); PV_D0(3);
#undef PV_D0
#undef TRRD
}

template <int CTRL> __device__ __forceinline__ float dppq(float v) { return __builtin_bit_cast(float, __builtin_amdgcn_update_dpp(0, __builtin_bit_cast(int, v), CTRL, 0xF, 0xF, true)); }
template <class TIn, class TOut> struct BlockRef { unsigned Q, K, V; TOut* O; int P0; int jlo; };
typedef __amdgpu_buffer_rsrc_t rsrc_t;
#define BL8(soff, voff) __builtin_bit_cast(bf16x8, __builtin_amdgcn_raw_buffer_load_b128(rs, (int)(voff), (int)(soff), 0))
template <class TIn> struct Seam {
    bf16x8 qr[8];
    bf16x8 st_v0, st_v1, st_k0, st_k1; f32x4 sf0, sf1, sf2, sf3;
    f32x4 tq[16];
};
__device__ __forceinline__ int swa_jlo(int P0, int W) { const int lowk = P0 - W + 1; return lowk > 0 ? lowk / KVBLK : 0; }
#define ROW(p, k0, rr) ((const TIn*)((const char*)((p) + (size_t)(k0) * D) + (unsigned)(((rr) * D + sc) * (int)sizeof(TIn))))
#define VMW() asm volatile("s_waitcnt vmcnt(0)" ::: "memory")
#define VMWN(n) asm volatile("s_waitcnt vmcnt(%0)" :: "i"(n) : "memory")
#define SLOAD_H(Kp, Vp, k0) do { S.st_v0 = BL8((Vp) + (unsigned)(k0) * 256u, vo); S.st_v1 = BL8((Vp) + (unsigned)(k0) * 256u + 8192u, vo);              \
                         S.st_k0 = BL8((Kp) + (unsigned)(k0) * 256u, vo); S.st_k1 = BL8((Kp) + (unsigned)(k0) * 256u + 8192u, vo); } while (0)
#define SWRITE_HK(bf) do { *(bf16x8*)(K_lds + (bf) * SHM_K + kws) = S.st_k0; *(bf16x8*)(K_lds + (bf) * SHM_K + kws + 32 * 256) = S.st_k1; } while (0)
#define SWRITE_HV(bf) do { *(bf16x8*)(V_lds + (bf) * SHM_V + vst0) = S.st_v0; *(bf16x8*)(V_lds + (bf) * SHM_V + vst1) = S.st_v1; } while (0)
#define SWRITE_H(bf) do { SWRITE_HV(bf); SWRITE_HK(bf); } while (0)
#define SLOAD_F(p, k0) do { S.sf0 = *(const f32x4*)ROW(p, k0, sr); S.sf1 = *(const f32x4*)(ROW(p, k0, sr) + 4);                \
                            S.sf2 = *(const f32x4*)ROW(p, k0, 32 + sr); S.sf3 = *(const f32x4*)(ROW(p, k0, 32 + sr) + 4); } while (0)
#define SWRITE_KF(bf) do { *(bf16x8*)(K_lds + (bf) * SHM_K + kws) = pack8(S.sf0, S.sf1); *(bf16x8*)(K_lds + (bf) * SHM_K + kws + 32 * 256) = pack8(S.sf2, S.sf3); } while (0)
#define SWRITE_VF(bf) do { *(bf16x8*)(V_lds + (bf) * SHM_V + vst0) = pack8(S.sf0, S.sf1); *(bf16x8*)(V_lds + (bf) * SHM_V + vst1) = pack8(S.sf2, S.sf3); } while (0)
template <class TIn, class TOut>
__device__ __forceinline__ void causal_swa_prime(const rsrc_t rs, const BlockRef<TIn, TOut>& cur, int W, char* lds, Seam<TIn>& S) {
    constexpr bool F32 = false; static_assert(!same_t<TIn, float>::v, "bf16 q/k/v only in this build");
    int tid = threadIdx.x; asm volatile("" : "+v"(tid));
    const int wid = __builtin_amdgcn_readfirstlane(tid >> 6), lane = tid & 63, r32 = lane & 31, hi = lane >> 5;
    const int sr = tid >> 4, sc = (tid & 15) * 8, kws = KSWZ(sr, sc * 2), vo = (sr * D + sc) * 2; char* K_lds = lds + 2 * SHM_V;
    const int kb0 = cur.jlo * KVBLK;
    for (int d0 = 0; d0 < 8; ++d0) S.qr[d0] = BL8(cur.Q + (unsigned)(wid * QBLK * 256 + d0 * 32), (r32 * D + hi * 8) * 2);
    if constexpr (F32) { SLOAD_F((const float*)nullptr, kb0); VMW(); SWRITE_KF(0); SBAR(); SLOAD_F((const float*)nullptr, kb0); }
    else { SLOAD_H(cur.K, cur.V, kb0); VMW(); SWRITE_HK(0); }
    __syncthreads();
}
template <class TIn, class TOut>
__device__ __forceinline__ void causal_swa_block(const rsrc_t rs, const BlockRef<TIn, TOut>& cur, const BlockRef<TIn, TOut>& nxt, int skv, int W, char* lds, Seam<TIn>& S) {
    constexpr bool F32 = false; static_assert(!same_t<TIn, float>::v, "bf16 q/k/v only in this build");
    int tid = threadIdx.x; asm volatile("" : "+v"(tid));
    const int wid = __builtin_amdgcn_readfirstlane(tid >> 6), lane = tid & 63, r32 = lane & 31, hi = lane >> 5;
    const int j_lo = cur.jlo;
    int j_hi = (cur.P0 + QB - 1) / KVBLK + 1; if (j_hi > skv / KVBLK) j_hi = skv / KVBLK;
    const int NT = j_hi - j_lo;
    const int kbn = nxt.jlo * KVBLK;
    const int qlo = cur.P0 + wid * QBLK, qm = qlo + r32 - 4 * hi;
    char* V_lds = lds; char* K_lds = lds + 2 * SHM_V;
    float* ws = (float*)(lds + 2 * SHM_V + 2 * SHM_K) + wid * 64; float* li_l = ws, * al_l = ws + 32;
    const float* kbl = (const float*)(lds + LDS_KB) + 4 * hi;
    float m_reg = -1e30f, l_reg = 0; f32x16 o[4] = {};
    const int sr = tid >> 4, sc = (tid & 15) * 8, vst0 = v_st(sr, sc), vst1 = v_st(32 + sr, sc), kws = KSWZ(sr, sc * 2), vo = (sr * D + sc) * 2;
    const int vb0 = (int)(uintptr_t)V_lds + v_rd_base(lane);
    const unsigned Kh = cur.K, Vh = cur.V;
#define RESC(a) do { if (__any((a) < 1.f)) { if (hi == 0) al_l[r32] = (a); asm volatile("s_waitcnt lgkmcnt(0)" ::: "memory");              \
                     for (int d_ = 0; d_ < 4; ++d_) for (int r = 0; r < 16; ++r) o[d_][r] *= al_l[crow(r, hi)]; } } while (0)
#define KBASE(t) ((j_lo + (t)) * KVBLK)
#define ACT(t) (KBASE(t) <= qlo + QBLK - 1 && KBASE(t) + KVBLK - 1 >= qlo - W + 1)
#define MASKT(P0_, P1_, t) do { const int kb_ = KBASE(t); if ((!SK || ACT(t)) && (kb_ + KVBLK - 1 > qlo || kb_ <= qlo + QBLK - 1 - W)) mask_tile(P0_, P1_, qm - kb_, (unsigned)W); } while (0)
    constexpr int NQL = F32 ? 16 : 8;
    constexpr bool SK = WSKIP && !F32;
#define SEAM_K0() do { VMWN(NQL); if constexpr (F32) { SWRITE_KF(0); SBAR(); SLOAD_F((const float*)nullptr, kbn); } else { SWRITE_HK(0); } SBAR(); } while (0)
    f32x16 pA0, pA1, pB0, pB1; float mnA, mnB, alA, alB; bf16x8 pa0, pa1, pa2, pa3;
    if constexpr (F32) { VMW(); SWRITE_VF(0); SBAR(); } else { SWRITE_HV(0); SBAR(); }
    if (NT > 1) { if constexpr (F32) SLOAD_F((const float*)nullptr, KBASE(1)); else SLOAD_H(Kh, Vh, KBASE(1)); }
    SBAR(); qkt<0, SK>(pA0, pA1, K_lds, r32, hi, S.qr, ACT(0), kbl + KBASE(0));
    if constexpr (F32) { if (NT > 1) { VMW(); SWRITE_KF(1); SBAR(); SLOAD_F((const float*)nullptr, KBASE(1)); } }
    MASKT(pA0, pA1, 0); partialSM(pA0, pA1, m_reg, mnA, alA);
    if (NT > 1) { VMW(); if constexpr (F32) { SWRITE_VF(1); SBAR(); if (NT > 2) SLOAD_F((const float*)nullptr, KBASE(2)); } else SWRITE_H(1); }
    __syncthreads();
#define HALF_STEP(PX0, PX1, mnX, alX, PY0, PY1, alY, t, KB, VB, SB) do {                                                      \
        SBAR(); qkt<KB, SK>(PX0, PX1, K_lds, r32, hi, S.qr, ACT(t), kbl + KBASE(t));                                             \
        finishSM(PY0, PY1, alY, l_reg, pa0, pa1, pa2, pa3); SBAR();                                                           \
        if ((t) + 1 < NT) { if constexpr (F32) { VMW(); SWRITE_KF(SB); SBAR(); SLOAD_F((const float*)nullptr, KBASE((t) + 1)); }  \
                            else { SLOAD_H(Kh, Vh, KBASE((t) + 1)); } SBAR(); }                                               \
        pv_tile<VB, SK>(o, vb0, pa0, pa1, pa2, pa3, ACT((t) - 1)); MASKT(PX0, PX1, (t)); partialSM(PX0, PX1, m_reg, mnX, alX);                                        \
        __syncthreads();                                                                                                      \
        if ((t) + 1 < NT) { VMW(); if constexpr (F32) { SWRITE_VF(SB); SBAR(); if ((t) + 2 < NT) SLOAD_F((const float*)nullptr, KBASE((t) + 2)); } \
                            else { SWRITE_H(SB); } }                                                                          \
        RESC(alX); __syncthreads(); } while (0)
    for (int t = 1; t + 1 < NT; t += 2) {
        HALF_STEP(pB0, pB1, mnB, alB, pA0, pA1, alA, t, 1, 0, 0);
        HALF_STEP(pA0, pA1, mnA, alA, pB0, pB1, alB, t + 1, 0, 1, 1);
    }
    const bool even = (NT & 1) == 0;
    if (even) { SBAR(); qkt<1, SK>(pB0, pB1, K_lds, r32, hi, S.qr, ACT(NT - 1), kbl + KBASE(NT - 1)); SBAR(); }
#define QROW(e) ((const float*)nullptr + (size_t)(wid * QBLK + r32) * D + ((e) >> 1) * 16 + hi * 8 + ((e) & 1) * 4)
    if constexpr (F32) { SLOAD_F((const float*)nullptr, kbn); SBAR();
#pragma unroll
        for (int e = 0; e < 8; ++e) S.tq[e] = *(const f32x4*)QROW(e); }
    else { SLOAD_H(nxt.K, nxt.V, kbn); SBAR();
#pragma unroll
        for (int d0 = 0; d0 < 8; ++d0) S.qr[d0] = BL8(nxt.Q + (unsigned)(wid * QBLK * 256 + d0 * 32), (r32 * D + hi * 8) * 2); }
    SBAR();
    finishSM(pA0, pA1, alA, l_reg, pa0, pa1, pa2, pa3); SBAR();
    if constexpr (F32) {
#pragma unroll
        for (int e = 8; e < 16; ++e) S.tq[e] = *(const f32x4*)QROW(e); SBAR(); }
#undef QROW
    pv_tile<0, SK>(o, vb0, pa0, pa1, pa2, pa3, ACT(even ? NT - 2 : NT - 1));
    if (even) { MASKT(pB0, pB1, NT - 1); partialSM(pB0, pB1, m_reg, mnB, alB); __syncthreads(); RESC(alB);
        finishSM(pB0, pB1, alB, l_reg, pa0, pa1, pa2, pa3); SBAR(); pv_tile<1, SK>(o, vb0, pa0, pa1, pa2, pa3, ACT(NT - 1)); }
    SBAR(); SEAM_K0();
    if (hi == 0) li_l[r32] = l_reg; asm volatile("s_waitcnt lgkmcnt(0)" ::: "memory");
    float rli[16];
#pragma unroll
    for (int r = 0; r < 16; ++r) rli[r] = __builtin_amdgcn_rcpf(li_l[crow(r, hi)]);
    TOut* Ow = cur.O + (size_t)(wid * QBLK) * OSTRIDE;
#pragma unroll
    for (int r = 0; r < 16; ++r) { const int orow = crow(r, hi);
#pragma unroll
        for (int d0 = 0; d0 < 4; ++d0) { const float v = o[d0][r] * rli[r];
            if constexpr (same_t<TOut, float>::v) { Ow[(size_t)orow * OSTRIDE + d0 * 32 + r32] = v; }
            else if constexpr (same_t<TOut, unsigned char>::v) { const float v16 = 16.f * v, v1 = dppq<0xB1>(v16), v2 = dppq<0x4E>(v16), v3 = dppq<0x1B>(v16);
                   if ((r32 & 3) == 0) *(unsigned*)(Ow + (size_t)orow * OSTRIDE + d0 * 32 + r32) = pg8::pk4_fp8(v16, v1, v2, v3); }
            else { const float vn = dppq<0xB1>(v);
                   if ((r32 & 1) == 0) *(unsigned*)(Ow + (size_t)orow * OSTRIDE + d0 * 32 + r32) = cvtpk(v, vn); } } }
    if constexpr (F32) {
#pragma unroll
        for (int d0 = 0; d0 < 8; ++d0) S.qr[d0] = pack8(S.tq[2 * d0], S.tq[2 * d0 + 1]); }
    __syncthreads();
#undef RESC
#undef KBASE
#undef ACT
#undef MASKT
#undef SEAM_K0
#undef HALF_STEP
}
#undef ROW
#undef VMW
#undef VMWN
#undef SLOAD_H
#undef SWRITE_HK
#undef SWRITE_HV
#undef SWRITE_H
#undef SLOAD_F
#undef SWRITE_KF
#undef SWRITE_VF

}

struct Frame {
    LAS unsigned char* lds;
    volatile LAS unsigned* MISC;
    gu32* ctl;
    unsigned char* ws;
    int tid, lane, wave;
    int vcu, G;
    const float* const* in;
    float* out;
};

__device__ __forceinline__ void cvt_load(f32x4 (&v)[16], const float* src  , size_t ld, int rq, int nq) {
#pragma unroll
    for (int i = 0; i < 8; ++i) { const float* p = src + (size_t)(8 * i + 2 * rq) * ld + 4 * nq; v[2 * i] = __builtin_nontemporal_load((const f32x4*)p); v[2 * i + 1] = __builtin_nontemporal_load((const f32x4*)(p + ld)); }
}
__device__ __forceinline__ void cvt_store(const f32x4 (&v)[16], const f32x2v (&sc)[8], bool scaled, LAS unsigned* tile, bf16* dst  , int K, int lane, int rq, int nq) {
#pragma unroll
    for (int i = 0; i < 8; ++i) { f32x4 a = v[2 * i], b = v[2 * i + 1]; if (scaled) { a = a * sc[i].x; b = b * sc[i].y; }
#pragma unroll
        for (int j = 0; j < 4; ++j) tile[(4 * nq + j) * 33 + 4 * i + rq] = pk2(a[j], b[j]); }
    LDS_WAIT(); asm volatile("" ::: "memory");
    const int nr = lane >> 3, ch = lane & 7;
#pragma unroll
    for (int q = 0; q < 8; ++q) { const LAS unsigned* s = tile + (8 * q + nr) * 33 + 4 * ch; v4u o; o.x = s[0]; o.y = s[1]; o.z = s[2]; o.w = s[3];
        *(v4u*)(dst + (size_t)(8 * q + nr) * K + 8 * ch) = o; }
    LDS_WAIT(); asm volatile("" ::: "memory");
}
__device__ __forceinline__ void cvt_item(const float* src0, const float* src1, size_t ld_src, bf16* dst, int K, const float* scale  , LAS unsigned* tile, int lane) {
    const int rq = lane >> 4, nq = lane & 15;
    f32x2v sc[8];
    if (scale) {
#pragma unroll
        for (int i = 0; i < 8; ++i) sc[i] = *(const f32x2v*)(scale + 8 * i + 2 * rq);
    }
    f32x4 va[16], vb[16];
    cvt_load(va, src0, ld_src, rq, nq);
    cvt_load(vb, src0 + 64, ld_src, rq, nq);
    cvt_store(va, sc, scale != nullptr, tile, dst, K, lane, rq, nq);
    cvt_load(va, src1, ld_src, rq, nq);
    cvt_store(vb, sc, scale != nullptr, tile, dst + (size_t)64 * K, K, lane, rq, nq);
    cvt_load(vb, src1 + 64, ld_src, rq, nq);
    cvt_store(va, sc, scale != nullptr, tile, dst + (size_t)128 * K, K, lane, rq, nq);
    cvt_store(vb, sc, scale != nullptr, tile, dst + (size_t)192 * K, K, lane, rq, nq);
}
__device__ __forceinline__ void cvt8_load(f32x4 (&v)[16], const float* src  , size_t ld, int rq, int nq) {
#pragma unroll
    for (int i = 0; i < 4; ++i)
#pragma unroll
        for (int r = 0; r < 4; ++r) v[4 * i + r] = __builtin_nontemporal_load((const f32x4*)(src + (size_t)(16 * i + 4 * rq + r) * ld + 4 * nq));
}
__device__ __forceinline__ void cvt8_pack(const f32x4 (&v)[16], const LAS float* scl  , LAS unsigned* tile, int hh, int rq, int nq) {
#pragma unroll
    for (int i = 0; i < 4; ++i) { const f32x4 s4 = *(const LAS f32x4*)(scl + 64 * hh + 16 * i + 4 * rq);
#pragma unroll
        for (int j = 0; j < 4; ++j) tile[(4 * nq + j) * 33 + 16 * hh + 4 * i + rq] = pg8::pk4_fp8(v[4 * i][j] * s4.x, v[4 * i + 1][j] * s4.y, v[4 * i + 2][j] * s4.z, v[4 * i + 3][j] * s4.w); }
}
__device__ __forceinline__ void cvt8_flush(LAS unsigned* tile, unsigned char* dst  , int Kb, int lane, bool stream = false  ) {
    LDS_WAIT(); asm volatile("" ::: "memory");
    const int nr = lane >> 3, ch = lane & 7;
#pragma unroll
    for (int q = 0; q < 8; ++q) { const LAS unsigned* s = tile + (8 * q + nr) * 33 + 4 * ch; v4u o; o.x = s[0]; o.y = s[1]; o.z = s[2]; o.w = s[3];
        if (stream) __builtin_nontemporal_store(o, (v4u*)(dst + (size_t)(8 * q + nr) * Kb + 16 * ch)); else *(v4u*)(dst + (size_t)(8 * q + nr) * Kb + 16 * ch) = o; }
    LDS_WAIT(); asm volatile("" ::: "memory");
}
__device__ __forceinline__ void cvt8_item(const float* src0, const float* src1, size_t ld_src, unsigned char* dst, int Kb, const float* scale, LAS unsigned* tile, LAS float* scl  , int lane, int nsub  ) {
    const int rq = lane >> 4, nq = lane & 15;
    if (lane < 32) { f32x4 s4 = {256.f, 256.f, 256.f, 256.f}; if (scale) s4 = *(const f32x4*)(scale + 4 * lane) * 256.f; *(LAS f32x4*)(scl + 4 * lane) = s4; }
    LDS_WAIT(); asm volatile("" ::: "memory");
    f32x4 va[16], vb[16];
    cvt8_load(va, src0, ld_src, rq, nq); cvt8_load(vb, src0 + 64 * ld_src, ld_src, rq, nq);
#pragma unroll 1
    for (int s = 0; s + 1 < nsub; ++s) {
        const float* nsrc = (s + 1 < 2 ? src0 : src1) + 64 * ((s + 1) & 1);
        cvt8_pack(va, scl, tile, 0, rq, nq); __builtin_amdgcn_sched_barrier(0);
        cvt8_load(va, nsrc, ld_src, rq, nq); __builtin_amdgcn_sched_barrier(0);
        cvt8_pack(vb, scl, tile, 1, rq, nq); __builtin_amdgcn_sched_barrier(0);
        cvt8_load(vb, nsrc + 64 * ld_src, ld_src, rq, nq); __builtin_amdgcn_sched_barrier(0);
        cvt8_flush(tile, dst + (size_t)(64 * s) * Kb, Kb, lane, nsub == 4);
    }
    cvt8_pack(va, scl, tile, 0, rq, nq);
    cvt8_pack(vb, scl, tile, 1, rq, nq);
    cvt8_flush(tile, dst + (size_t)(64 * (nsub - 1)) * Kb, Kb, lane, nsub == 4);
}
constexpr int I_W13 = NEXP * 16 * 8, I_W2 = NEXP * 8 * 8;
__device__ __forceinline__ void cvt8_moe_item(const float* const* in, unsigned char* ws, int r, LAS unsigned* tile, LAS float* scl, int lane) {
    const float* s0; const float* s1; size_t ld; unsigned char* dst8; int K; const float* scale;
    if (r < I_W13) { const int e = r / 128, q = r % 128, kb = q / 8, nb = q % 8, k0 = 128 * kb;
        const size_t so = (size_t)e * DM * DFF + (size_t)k0 * DFF + 128 * nb;
        s0 = in[14] + so; s1 = in[15] + so; ld = DFF; dst8 = ws + WS_W13 + ((size_t)e * 2048 + 256 * nb) * DM + k0; K = DM; scale = in[9] + k0; }
    else { r -= I_W13; const int e = r / 64, q = r % 64, kb = q / 8, nb = q % 8, k0 = 128 * kb, n = 256 * nb;
        s0 = in[16] + (size_t)e * DFF * DM + (size_t)k0 * DM + n; s1 = s0 + 128; ld = DM; dst8 = ws + WS_W2 + ((size_t)e * 2048 + n) * DFF + k0; K = DFF; scale = nullptr; }
    cvt8_item(s0, s1, ld, dst8, K, scale, tile, scl, lane, 4);
}
__device__ __forceinline__ void p0_prologue(Frame& F) {
    const int gw = F.vcu * NWAVES + F.wave, NGW = F.G * NWAVES, lane = F.lane;
    const float* x = F.in[0]; const float* g1 = F.in[1]; const float* w_in = F.in[2]; const float* b_fg = F.in[3];
    LAS float* tb = (LAS float*)(F.lds + RING_OFF);
    for (int k = F.tid; k < DM; k += NWAVES * 64) { const int j = k >> 8, l = (k & 255) >> 2, i = k & 3; const float g = g1[k];
        const f32x4 a = *(const f32x4*)(w_in + (size_t)k * NCOLS + 3072), b = *(const f32x4*)(w_in + (size_t)k * NCOLS + 3076);
        LAS f32x4* d = (LAS f32x4*)(tb + ((j * 4 + i) * 64 + l) * 8); d[0] = a * g; d[1] = b * g; }
    __syncthreads();
    bf16* xb = (bf16*)(F.ws + WS_XB); float* rstd1 = (float*)(F.ws + WS_RSTD1); float* logf = (float*)(F.ws + WS_LOGF);
    for (int m = gw; m < T; m += NGW) {
        const GAS f32x4* xr = (const GAS f32x4*)(x + (size_t)m * DM) + lane;
        f32x4 v[8]; float ss = 0.f;
#pragma unroll
        for (int j = 0; j < 8; ++j) { v[j] = xr[64 * j]; ss += (v[j].x * v[j].x + v[j].y * v[j].y) + (v[j].z * v[j].z + v[j].w * v[j].w); }
        const float rstd = __builtin_amdgcn_rsqf(wave_sum(ss) * (1.0f / DM) + EPS);
        float fa[8];
#pragma unroll
        for (int h = 0; h < 8; ++h) fa[h] = 0.f;
#pragma unroll
        for (int j = 0; j < 8; ++j)
#pragma unroll
            for (int i = 0; i < 4; ++i) { const LAS f32x4* d = (const LAS f32x4*)(tb + ((j * 4 + i) * 64 + lane) * 8); const f32x4 a = d[0], b = d[1]; const float xv = v[j][i];
                fa[0] += xv * a.x; fa[1] += xv * a.y; fa[2] += xv * a.z; fa[3] += xv * a.w; fa[4] += xv * b.x; fa[5] += xv * b.y; fa[6] += xv * b.z; fa[7] += xv * b.w; }
        GAS v2u* o8 = (GAS v2u*)(xb + (size_t)m * DM) + lane; GAS unsigned* o4 = (GAS unsigned*)(F.ws + WS_X8 + (size_t)m * DM) + lane;
#pragma unroll
        for (int j = 0; j < 8; ++j) { v2u w; w.x = pk2(v[j].x, v[j].y); w.y = pk2(v[j].z, v[j].w); o8[64 * j] = w; o4[64 * j] = pg8::pk4_fp8(16.f * v[j].x, 16.f * v[j].y, 16.f * v[j].z, 16.f * v[j].w); }
        float mine = 0.f;
#pragma unroll
        for (int h = 0; h < 8; ++h) { const float s = wave_sum(fa[h]); if (lane == h) mine = s; }
        if (lane == 0) rstd1[m] = rstd;
        if (lane < 8) { const float z = mine * rstd + b_fg[lane];
            const float ez = __expf(-fabsf(z)); const float ls = fminf(z, 0.f) - (ez < 1e-4f ? ez * (1.0f - 0.5f * ez) : __logf(1.0f + ez));
            const int b = m >> 12, s = m & 4095; logf[(size_t)(b * 8 + lane) * SEQ + s] = ls; }
    }
    { bf16* wr = (bf16*)(F.ws + WS_WR); const float* g2 = F.in[9]; const float* wg = F.in[10]; const float* we = F.in[12];
      for (int idx = (F.vcu * NWAVES * 64 + F.tid); idx < 64 * DM; idx += F.G * NWAVES * 64) { const int r = idx >> 11, k = idx & 2047;
          float v = 0.f; if (r < 4) v = wg[k * 4 + r] * g2[k]; else if (r < 36) v = we[k * 32 + (r - 4)] * g2[k];
          wr[idx] = (bf16)(pk2(v, 0.f) & 0xffffu); } }
    __syncthreads();
    LAS unsigned* tile = (LAS unsigned*)(F.lds + RING_OFF) + F.wave * (64 * 33);
    constexpr int NT16 = 4 * PJ16.n, I_WIN = 32 * NT16, I_WIN8 = 16 * 16, H_X8 = 16 * 8 * PJ8.n, I_PA = P5_F8 ? 0 : 16 * 8, I_PB = P5_F8 ? 0 : 16 * 8, I_WOUT = P6_F8 ? 0 : 32 * 8;
    constexpr int H_PAB = P5_F8 ? 16 * 16 : 0, H_WOUT = P6_F8 ? 16 * 16 : 0;
    constexpr int NITEMS16 = I_WIN + I_PA + I_PB + I_WOUT;
#pragma unroll 1
    for (int it = gw; it < NITEMS16; it += NGW) {
        int r = it; const float* s0; size_t ld; bf16* dst; int K; const float* scale;
        if (r < I_WIN) { const int kb = r / NT16, nb = r % NT16, k0 = 64 * kb, n = 256 * nb, nsrc = pj_srccol(pj_kind16(nb >> 2)) + 256 * (nb & 3);
            s0 = w_in + (size_t)k0 * NCOLS + nsrc; ld = NCOLS; dst = (bf16*)(F.ws + WS_WIN) + (size_t)n * DM + k0; K = DM; scale = g1 + k0; }
        else if ((r -= I_WIN) < I_PA) { const int kb = r / 8, nb = r % 8, k0 = 64 * kb, n = 256 * nb;
            s0 = F.in[6] + (size_t)k0 * DM + n; ld = DM; dst = (bf16*)(F.ws + WS_PAB) + (size_t)n * DM + k0; K = DM; scale = nullptr; }
        else if ((r -= I_PA) < I_PB) { const int kb = r / 8, nb = r % 8, k0 = 64 * kb, n = 256 * nb;
            s0 = F.in[7] + (size_t)k0 * DM + n; ld = DM; dst = (bf16*)(F.ws + WS_PAB) + (size_t)n * DM + MW + k0; K = DM; scale = F.in[5] + k0; }
        else { r -= I_PB; const int kb = r / 8, nb = r % 8, k0 = 64 * kb, n = 256 * nb;
            s0 = F.in[8] + (size_t)k0 * DM + n; ld = DM; dst = (bf16*)(F.ws + WS_WOUT) + (size_t)n * DM + k0; K = DM; scale = nullptr; }
        cvt_item(s0, s0 + 128, ld, dst, K, scale, tile, lane);
    }
#pragma unroll 1
    for (int hi = (gw + NGW - NITEMS16 % NGW) % NGW; hi < 2 * I_WIN8 + H_X8 + H_PAB + H_WOUT; hi += NGW) {
        const float* s0; size_t ld; unsigned char* dst; const float* scale;
        if (hi < 2 * I_WIN8 + H_X8) { int kb, n, scol;
            if (hi < 2 * I_WIN8) { kb = hi / 32; const int nh = hi % 32; n = 128 * nh; scol = GATE_COL0 + (nh & 1) * DM + 128 * (nh >> 1); }
            else { const int r = hi - 2 * I_WIN8, per = 8 * PJ8.n; kb = r / (per > 0 ? per : 1); const int nh = r % (per > 0 ? per : 1); n = 4096 + 128 * nh; scol = pj_srccol(pj_kind8(nh >> 3)) + 128 * (nh & 7); }
            const int k0 = 128 * kb; s0 = w_in + (size_t)k0 * NCOLS + scol; ld = NCOLS; dst = F.ws + WS_WIN8 + (size_t)n * DM + k0; scale = g1 + k0; }
        else if (hi < 2 * I_WIN8 + H_X8 + H_PAB) { const int r = hi - (2 * I_WIN8 + H_X8), kb = r >> 4, n = 128 * (r & 15), k0 = 128 * kb;
            s0 = (kb < 8 ? F.in[6] + (size_t)k0 * DM : F.in[7] + (size_t)(k0 - MW) * DM) + n; ld = DM; dst = F.ws + WS_PAB + (size_t)n * DM + k0; scale = kb < 8 ? nullptr : F.in[5] + (k0 - MW); }
        else { const int r = hi - (2 * I_WIN8 + H_X8 + H_PAB), kb = r >> 4, n = 128 * (r & 15), k0 = 128 * kb;
            s0 = F.in[8] + (size_t)k0 * DM + n; ld = DM; dst = F.ws + WS_WOUT + (size_t)n * DM + k0; scale = nullptr; }
        cvt8_item(s0, s0, ld, dst, DM, scale, tile, (LAS float*)(F.lds + PARK_OFF) + F.wave * 128, lane, 2);
    }
}

__device__ __forceinline__ void naive_cumsum(Frame& F) {
    const float* logf = (const float*)(F.ws + WS_LOGF); float* cum = (float*)(F.ws + WS_CUM);
    LAS float* part = (LAS float*)(F.lds + RING_OFF);
    for (int bh = blockIdx.x; bh < BATCH * NH; bh += F.G) {
        const float* src = logf + (size_t)bh * SEQ + F.tid * 8; float v[8]; float s = 0.f;
#pragma unroll
        for (int i = 0; i < 8; ++i) { v[i] = src[i]; s += v[i]; v[i] = s; }
        part[F.tid] = s; __syncthreads();
        float pre = 0.f; for (int i = 0; i < F.tid; ++i) pre += part[i];
#pragma unroll
        for (int i = 0; i < 8; ++i) cum[(size_t)bh * SEQ + F.tid * 8 + i] = v[i] + pre;
        __syncthreads();
    }
}
__device__ __forceinline__ void naive_attention(Frame& F) {
    const bf16* Q = (const bf16*)(F.ws + WS_QKV); const bf16* Kt = Q + (size_t)T * MW; const bf16* V = Kt + (size_t)T * MW;
    const float* cum = (const float*)(F.ws + WS_CUM); bf16* oa = (bf16*)(F.ws + WS_OAB);
    const int qi = F.tid >> 4, part = F.tid & 15;
    for (int u = blockIdx.x; u < BATCH * NH * (SEQ / 32); u += F.G) {
        const int bh = u / (SEQ / 32), qb = u % (SEQ / 32), row = qb * 32 + qi;
        const bf16* kb = Kt + (size_t)bh * SEQ * HD + part * 8; const bf16* vb = V + (size_t)bh * SEQ * HD + part * 8;
        float q[8], o[8]; { const v4u w = *(const v4u*)(Q + ((size_t)bh * SEQ + row) * HD + part * 8);
            q[0] = bflo(w.x); q[1] = bfhi(w.x); q[2] = bflo(w.y); q[3] = bfhi(w.y); q[4] = bflo(w.z); q[5] = bfhi(w.z); q[6] = bflo(w.w); q[7] = bfhi(w.w); }
#pragma unroll
        for (int d = 0; d < 8; ++d) o[d] = 0.f;
        float m = -1e30f, l = 0.f; const float ci = cum[(size_t)bh * SEQ + row]; const float* cj = cum + (size_t)bh * SEQ;
        const int jend = qb * 32 + 32;
        for (int j0 = 0; j0 < jend; j0 += 4) {
            v4u kw[4], vw[4]; float cjv[4];
#pragma unroll
            for (int e = 0; e < 4; ++e) { kw[e] = *(const v4u*)(kb + (size_t)(j0 + e) * HD); vw[e] = *(const v4u*)(vb + (size_t)(j0 + e) * HD); cjv[e] = cj[j0 + e]; }
#pragma unroll
            for (int e = 0; e < 4; ++e) {
                float s = q[0] * bflo(kw[e].x) + q[1] * bfhi(kw[e].x) + q[2] * bflo(kw[e].y) + q[3] * bfhi(kw[e].y) + q[4] * bflo(kw[e].z) + q[5] * bfhi(kw[e].z) + q[6] * bflo(kw[e].w) + q[7] * bfhi(kw[e].w);
                s += __shfl_xor(s, 1); s += __shfl_xor(s, 2); s += __shfl_xor(s, 4); s += __shfl_xor(s, 8);
                s = s * ATT_SCALE + (ci - cjv[e]);
                if (j0 + e <= row) { const float mn = fmaxf(m, s), al = __expf(m - mn), p = __expf(s - mn); l = l * al + p; m = mn;
                    o[0] = o[0] * al + p * bflo(vw[e].x); o[1] = o[1] * al + p * bfhi(vw[e].x); o[2] = o[2] * al + p * bflo(vw[e].y); o[3] = o[3] * al + p * bfhi(vw[e].y);
                    o[4] = o[4] * al + p * bflo(vw[e].z); o[5] = o[5] * al + p * bfhi(vw[e].z); o[6] = o[6] * al + p * bflo(vw[e].w); o[7] = o[7] * al + p * bfhi(vw[e].w); }
            }
        }
        const float il = 1.0f / l; const int b = bh >> 3, h = bh & 7;
        v4u w; w.x = pk2(o[0] * il, o[1] * il); w.y = pk2(o[2] * il, o[3] * il); w.z = pk2(o[4] * il, o[5] * il); w.w = pk2(o[6] * il, o[7] * il);
        *(v4u*)(oa + ((size_t)(b * SEQ + row)) * (2 * MW) + h * HD + part * 8) = w;
    }
}
__device__ __forceinline__ void naive_hgrn(Frame& F) {
    const bf16* QB = (const bf16*)(F.ws + WS_HG); const bf16* FB = QB + (size_t)T * MW; const bf16* IB = FB + (size_t)T * MW;
    float* obf = (float*)(F.ws + WS_OBF); const float* lbl = F.in[4];
    const int gw = F.vcu * NWAVES + F.wave, NGW = F.G * NWAVES, lane = F.lane, vc = lane & 31, kh = lane >> 5;
    LAS f32x4* fq = (LAS f32x4*)(F.lds + RING_OFF + 65536) + F.wave * 64;
    for (int u = gw; u < BATCH * NH * 4; u += NGW) {
        const int bh = u >> 2, vg = u & 3, b = bh >> 3, h = bh & 7, vcol = vg * 32 + vc;
        const float lb0 = sigm(lbl[h * HD + 2 * lane] - lbl[MW + h * HD + 2 * lane]), lb1 = sigm(lbl[h * HD + 2 * lane + 1] - lbl[MW + h * HD + 2 * lane + 1]);
        float S[64];
#pragma unroll
        for (int k = 0; k < 64; ++k) S[k] = 0.f;
        const size_t base = (size_t)b * SEQ * MW + h * HD;
        unsigned fw = *(const unsigned*)(FB + base + 2 * lane), qw = *(const unsigned*)(QB + base + 2 * lane); bf16 vw = IB[base + vcol];
#pragma unroll 1
        for (int t = 0; t < SEQ; ++t) {
            const unsigned fc = fw, qc = qw; const float v = bf1(vw);
            if (t + 1 < SEQ) { const size_t nb_ = base + (size_t)(t + 1) * MW; fw = *(const unsigned*)(FB + nb_ + 2 * lane); qw = *(const unsigned*)(QB + nb_ + 2 * lane); vw = IB[nb_ + vcol]; }
            const float f0 = lb0 + (1.f - lb0) * sigm(bflo(fc)), f1 = lb1 + (1.f - lb1) * sigm(bfhi(fc));
            fq[lane] = (f32x4){f0, bflo(qc), f1, bfhi(qc)};
            LDS_WAIT(); asm volatile("" ::: "memory");
            float o = 0.f;
#pragma unroll
            for (int i = 0; i < 32; ++i) { const f32x4 w = fq[kh * 32 + i];
                S[2 * i] = w.x * S[2 * i] + (1.f - w.x) * v; o += S[2 * i] * w.y;
                S[2 * i + 1] = w.z * S[2 * i + 1] + (1.f - w.z) * v; o += S[2 * i + 1] * w.w; }
            o += __shfl_xor(o, 32);
            if (kh == 0) obf[base + (size_t)t * MW + vcol] = o;
            LDS_WAIT(); asm volatile("" ::: "memory");
        }
    }
}
__device__ __forceinline__ void naive_hgrn_norm(Frame& F) {
    const float* obf = (const float*)(F.ws + WS_OBF); const bf16* GB = (const bf16*)(F.ws + WS_HG) + (size_t)3 * T * MW; bf16* obn = (bf16*)(F.ws + WS_OAB) + MW;
    const int gw = F.vcu * NWAVES + F.wave, NGW = F.G * NWAVES, lane = F.lane;
    for (int u = gw; u < T * NH; u += NGW) {
        const size_t off = (size_t)u * HD + 2 * lane;
        const float a = obf[off], b = obf[off + 1]; const float ss = wave_sum(a * a + b * b);
        const float rs = 1.0f / sqrtf(ss * (1.0f / HD) + EPS); const unsigned gw_ = *(const unsigned*)(GB + off); const float g0 = bflo(gw_), g1 = bfhi(gw_);
        *(unsigned*)(obn + (size_t)(u >> 3) * (2 * MW) + (u & 7) * HD + 2 * lane) = pk2(a * rs * g0 * sigm(g0), b * rs * g1 * sigm(g1));
    }
}

__device__ __forceinline__ void router_phase(Frame& F) {
    const bf16* x1b = (const bf16*)(F.ws + WS_X1B); const bf16* wr = (const bf16*)(F.ws + WS_WR);
    int* tlist = (int*)(F.ws + WS_TLIST); float* slot_rs = (float*)(F.ws + WS_SLOTRS);
    float* rstd2 = (float*)(F.ws + WS_RSTD2); int* a_e = (int*)(F.ws + WS_AE); int* a_slot = (int*)(F.ws + WS_ASLOT); float* a_w = (float*)(F.ws + WS_AW);
    const float* bgp = F.in[11]; const float* bex = F.in[13];
    const int lane = F.lane, fr = lane & 15, fq = lane >> 4, sub = F.wave & 3, half = F.wave >> 2;
    LAS float* Lg = (LAS float*)(F.lds + RING_OFF) + (sub * 2 + half) * (16 * 48 + 16);
    for (int base = F.vcu * 4; base < T / 16; base += F.G * 4) {
        const int g = base + sub;
        const bf16* arow = x1b + (size_t)(g * 16 + fr) * DM + half * (DM / 2) + 8 * fq; const bf16* brow = wr + (size_t)fr * DM + half * (DM / 2) + 8 * fq;
        pg8::f32x4 acc[3]; for (int n = 0; n < 3; ++n) acc[n] = (pg8::f32x4){0.f, 0.f, 0.f, 0.f};
        float ss = 0.f;
#pragma unroll 8
        for (int k0 = 0; k0 < DM / 2; k0 += 32) {
            const v4u aw = *(const v4u*)(arow + k0);
            ss += bflo(aw.x) * bflo(aw.x) + bfhi(aw.x) * bfhi(aw.x) + bflo(aw.y) * bflo(aw.y) + bfhi(aw.y) * bfhi(aw.y) + bflo(aw.z) * bflo(aw.z) + bfhi(aw.z) * bfhi(aw.z) + bflo(aw.w) * bflo(aw.w) + bfhi(aw.w) * bfhi(aw.w);
            const bf16x8 a = __builtin_bit_cast(bf16x8, aw);
#pragma unroll
            for (int n = 0; n < 3; ++n) { const bf16x8 bfrag = *(const bf16x8*)(brow + (size_t)(n * 16) * DM + k0);
                acc[n] = __builtin_amdgcn_mfma_f32_16x16x32_bf16(a, bfrag, acc[n], 0, 0, 0); }
        }
        ss += __shfl_xor(ss, 16); ss += __shfl_xor(ss, 32);
#pragma unroll
        for (int n = 0; n < 3; ++n)
#pragma unroll
            for (int j = 0; j < 4; ++j) Lg[(4 * fq + j) * 48 + n * 16 + fr] = acc[n][j];
        if (fq == 0) Lg[16 * 48 + fr] = ss;
        __syncthreads();
        if (half == 0 && lane < 16) {
            const LAS float* l0 = Lg + lane * 48; const LAS float* l1 = l0 + (16 * 48 + 16);
            const int t = g * 16 + lane; const float r = __builtin_amdgcn_rsqf((Lg[16 * 48 + lane] + Lg[(16 * 48 + 16) + 16 * 48 + lane]) * (1.0f / DM) + EPS);
            float lg[4]; int gi = 0; float gm = -3.0e38f;
#pragma unroll
            for (int i = 0; i < 4; ++i) { lg[i] = (l0[i] + l1[i]) * r + bgp[i]; if (lg[i] > gm) { gm = lg[i]; gi = i; } }
            float gs = 0.f;
#pragma unroll
            for (int i = 0; i < 4; ++i) gs += __expf(lg[i] - gm);
            const float g_w = __builtin_amdgcn_rcpf(gs);
            float le[8]; int i1 = 0; float m1 = -3.0e38f;
#pragma unroll
            for (int i = 0; i < 8; ++i) { le[i] = (l0[4 + gi * 8 + i] + l1[4 + gi * 8 + i]) * r + bex[gi * 8 + i]; if (le[i] > m1) { m1 = le[i]; i1 = i; } }
            int i2 = 0; float m2 = -3.0e38f;
#pragma unroll
            for (int i = 0; i < 8; ++i) if (i != i1 && le[i] > m2) { m2 = le[i]; i2 = i; }
            const float p2 = __expf(m2 - m1), w1 = __builtin_amdgcn_rcpf(1.0f + p2), w2 = p2 * w1;
            const int e1 = gi * 8 + i1, e2 = gi * 8 + i2;
            const int s1 = (int)__hip_atomic_fetch_add(F.ctl + CW_CNT + e1, 1u, RLX_AGENT), s2 = (int)__hip_atomic_fetch_add(F.ctl + CW_CNT + e2, 1u, RLX_AGENT);
            a_e[2 * t] = e1; a_e[2 * t + 1] = e2; a_slot[2 * t] = s1; a_slot[2 * t + 1] = s2; a_w[2 * t] = g_w * w1; a_w[2 * t + 1] = g_w * w2; rstd2[t] = r;
            tlist[(size_t)e1 * 16384 + s1] = t; tlist[(size_t)e2 * 16384 + s2] = t; slot_rs[(size_t)e1 * 16384 + s1] = r; slot_rs[(size_t)e2 * 16384 + s2] = r;
        }
        __syncthreads();
    }
}
__device__ __forceinline__ void moe_tables(Frame& F) {
    LAS int* tab = (LAS int*)(F.lds + MOE_TAB_OFF);
    if (F.wave == 0) { const int lane = F.lane; const int e = lane & 31;
        const int c = (int)__hip_atomic_load(F.ctl + CW_CNT + e, RLX_AGENT); const int nb = (c + 255) >> 8; int incl = nb;
#pragma unroll
        for (int off = 1; off < 32; off <<= 1) { const int n = __shfl_up(incl, off, 32); if (e >= off) incl += n; }
        const int sb = incl - nb;
        if (lane < 32) { tab[e] = sb * 256; tab[194 + e] = c; for (int b = 0; b < nb; ++b) tab[34 + sb + b] = e; if (e == 31) { tab[32] = incl * 256; tab[33] = incl; } }
    }
    __syncthreads();
}
__device__ __forceinline__ void gather_phase(Frame& F) {
    LAS int* tab = (LAS int*)(F.lds + MOE_TAB_OFF);
    const bf16* x1b = (const bf16*)(F.ws + WS_X1B); bf16* xbuf = (bf16*)(F.ws + WS_XBUF);
    const float* rstd2 = (const float*)(F.ws + WS_RSTD2); const int* a_e = (const int*)(F.ws + WS_AE); const int* a_slot = (const int*)(F.ws + WS_ASLOT);
    int* tokrow = (int*)(F.ws + WS_TOKROW); float* rowscale = (float*)(F.ws + WS_ROWSCALE);
    const int gw = F.vcu * NWAVES + F.wave, NGW = F.G * NWAVES, lane = F.lane;
    for (int a = gw; a < 2 * T; a += NGW) {
        const int t = a >> 1, e = a_e[a], row = tab[e] + a_slot[a];
        const GAS v4u* src = (const GAS v4u*)(x1b + (size_t)t * DM) + lane; GAS v4u* dst = (GAS v4u*)(xbuf + (size_t)row * DM) + lane;
#pragma unroll
        for (int j = 0; j < 4; ++j) dst[64 * j] = src[64 * j];
        if (lane == 0) { tokrow[a] = row; rowscale[row] = rstd2[t]; }
    }
    for (int e = gw; e < NEXP; e += NGW) { const int c = tab[34 + 160 + e], r0 = tab[e] + c, r1 = tab[e] + ((c + 255) & ~255);
        for (int row = r0; row < r1; ++row) { GAS v4u* dst = (GAS v4u*)(xbuf + (size_t)row * DM) + lane;
#pragma unroll
            for (int j = 0; j < 4; ++j) dst[64 * j] = (v4u){0u, 0u, 0u, 0u};
            if (lane == 0) rowscale[row] = 0.f; } }
}
__device__ __forceinline__ void final_rows(const bf16* x1b, const unsigned char* ybuf, int t, int r0, int r1, int lane, v4u (&a)[4], v2u (&b)[4], v2u (&c)[4]) {
    const GAS v4u* xs = (const GAS v4u*)(x1b + (size_t)t * DM) + lane; const GAS v2u* y0 = (const GAS v2u*)(ybuf + (size_t)r0 * DM) + lane; const GAS v2u* y1 = (const GAS v2u*)(ybuf + (size_t)r1 * DM) + lane;
#pragma unroll
    for (int j = 0; j < 4; ++j) { a[j] = xs[64 * j]; b[j] = __builtin_nontemporal_load(y0 + 64 * j); c[j] = __builtin_nontemporal_load(y1 + 64 * j); }
}
typedef float f32x2q __attribute__((ext_vector_type(2)));
__device__ __forceinline__ void fp8x4_to_f32(unsigned w, float (&o)[4]) { const f32x2q lo = __builtin_amdgcn_cvt_pk_f32_fp8((int)w, false), hi = __builtin_amdgcn_cvt_pk_f32_fp8((int)w, true); o[0] = lo.x; o[1] = lo.y; o[2] = hi.x; o[3] = hi.y; }
__device__ __forceinline__ void final_token(float* out, const float* gF, int t, float w0, float w1, int lane, const v4u (&a)[4], const v2u (&b)[4], const v2u (&c)[4]) {
    float v[4][8]; float ss = 0.f;
#pragma unroll
    for (int j = 0; j < 4; ++j) {
        float y0[8], y1[8]; fp8x4_to_f32(b[j].x, *(float(*)[4])&y0[0]); fp8x4_to_f32(b[j].y, *(float(*)[4])&y0[4]); fp8x4_to_f32(c[j].x, *(float(*)[4])&y1[0]); fp8x4_to_f32(c[j].y, *(float(*)[4])&y1[4]);
        const float xx[8] = {bflo(a[j].x), bfhi(a[j].x), bflo(a[j].y), bfhi(a[j].y), bflo(a[j].z), bfhi(a[j].z), bflo(a[j].w), bfhi(a[j].w)};
#pragma unroll
        for (int i = 0; i < 8; ++i) { v[j][i] = xx[i] + w0 * y0[i] + w1 * y1[i]; ss += v[j][i] * v[j][i]; } }
    const float rs = __builtin_amdgcn_rsqf(wave_sum(ss) * (1.0f / DM) + EPS);
#pragma unroll
    for (int j = 0; j < 4; ++j) { const int c0 = 512 * j + 8 * lane; const f32x4 ga = *(const f32x4*)(gF + c0), gb = *(const f32x4*)(gF + c0 + 4);
        f32x4 o0 = {v[j][0] * rs * ga.x, v[j][1] * rs * ga.y, v[j][2] * rs * ga.z, v[j][3] * rs * ga.w}, o1 = {v[j][4] * rs * gb.x, v[j][5] * rs * gb.y, v[j][6] * rs * gb.z, v[j][7] * rs * gb.w};
        __builtin_nontemporal_store(o0, (f32x4*)(out + (size_t)t * DM + c0)); __builtin_nontemporal_store(o1, (f32x4*)(out + (size_t)t * DM + c0 + 4)); }
}
__device__ __forceinline__ void final_phase(Frame& F) {
    const bf16* x1b = (const bf16*)(F.ws + WS_X1B); const unsigned char* ybuf = F.ws + WS_YBUF;
    const int* a_e = (const int*)(F.ws + WS_AE); const int* a_slot = (const int*)(F.ws + WS_ASLOT); const LAS int* tab = (const LAS int*)(F.lds + MOE_TAB_OFF); const float* a_w = (const float*)(F.ws + WS_AW); const float* gF = F.in[17];
    const int gw = F.vcu * NWAVES + F.wave, NGW = F.G * NWAVES, lane = F.lane;
#pragma unroll 1
    for (int t = gw; t < T; t += 2 * NGW) {
        const int t2 = t + NGW; const bool has2 = t2 < T; const int tb = has2 ? t2 : t;
        const int ra0 = tab[a_e[2 * t]] + a_slot[2 * t], ra1 = tab[a_e[2 * t + 1]] + a_slot[2 * t + 1], rb0 = tab[a_e[2 * tb]] + a_slot[2 * tb], rb1 = tab[a_e[2 * tb + 1]] + a_slot[2 * tb + 1];
        const float wa0 = a_w[2 * t] * (1.0f / 32.0f), wa1 = a_w[2 * t + 1] * (1.0f / 32.0f), wb0 = a_w[2 * tb] * (1.0f / 32.0f), wb1 = a_w[2 * tb + 1] * (1.0f / 32.0f);
        v4u a[4], a2[4]; v2u b[4], c[4], b2[4], c2[4];
        final_rows(x1b, ybuf, t, ra0, ra1, lane, a, b, c); final_rows(x1b, ybuf, tb, rb0, rb1, lane, a2, b2, c2);
        final_token(F.out, gF, t, wa0, wa1, lane, a, b, c);
        if (has2) final_token(F.out, gF, t2, wb0, wb1, lane, a2, b2, c2);
    }
}
constexpr int HG_VT_STRIDE = 144, HG_QK_STRIDE = 272, HG_OL_STRIDE = 132;
typedef float f32x16 __attribute__((ext_vector_type(16)));
typedef __bf16 bf16m_t;
__device__ __forceinline__ bf16 f2bf_m(float x) { const bf16m_t b = (bf16m_t)x; return __builtin_bit_cast(bf16, b); }
__device__ __forceinline__ int crow32(int r, int hi) { return (r & 3) + 8 * (r >> 2) + 4 * hi; }
__device__ __forceinline__ float ex2(float x) { return __builtin_amdgcn_exp2f(x); }
__device__ __forceinline__ float sig2(float x) { return __builtin_amdgcn_rcpf(1.0f + __builtin_amdgcn_exp2f(-1.4426950408889634f * x)); }
__device__ __forceinline__ void hg_pre(const unsigned (&fw)[8], float lb0, float lb1, LAS float* tot, int wave, int lane, float (&bl)[8][2], float (&kk)[8][2], float (&blast)[2], float (&bmid)[2]) {
    float r0 = 0.f, r1 = 0.f;
#pragma unroll
    for (int i = 0; i < 8; ++i) { const float f0 = lb0 + (1.f - lb0) * sig2(bflo(fw[i])), f1 = lb1 + (1.f - lb1) * sig2(bfhi(fw[i]));
        kk[i][0] = 1.f - f0; kk[i][1] = 1.f - f1; r0 += __builtin_amdgcn_logf(f0); r1 += __builtin_amdgcn_logf(f1); bl[i][0] = r0; bl[i][1] = r1; }
    *(LAS f32x2v*)(tot + wave * 128 + 2 * lane) = (f32x2v){r0, r1};
    __syncthreads();
    float p0 = 0.f, p1 = 0.f, m0 = 0.f, m1 = 0.f, a0 = 0.f, a1 = 0.f;
#pragma unroll
    for (int w = 0; w < 8; ++w) { const f32x2v tv = *(const LAS f32x2v*)(tot + w * 128 + 2 * lane); if (w < wave) { p0 += tv.x; p1 += tv.y; } if (w < 4) { m0 += tv.x; m1 += tv.y; } a0 += tv.x; a1 += tv.y; }
#pragma unroll
    for (int i = 0; i < 8; ++i) { bl[i][0] += p0; bl[i][1] += p1; }
    blast[0] = a0; blast[1] = a1; bmid[0] = m0; bmid[1] = m1;
}
__device__ __forceinline__ v4u pack8col(const float (&x)[8][2], int j) { v4u o; o.x = pk2(x[0][j], x[1][j]); o.y = pk2(x[2][j], x[3][j]); o.z = pk2(x[4][j], x[5][j]); o.w = pk2(x[6][j], x[7][j]); return o; }
__device__ __forceinline__ float lb_of(const float* lbl, int idx) { return sig2(lbl[idx] - lbl[MW + idx]); }

__device__ __forceinline__ void hgrn_a1(Frame& F) {
    const bf16* FB = (const bf16*)(F.ws + WS_HG) + (size_t)T * MW; const bf16* IB = FB + (size_t)T * MW;
    bf16* UT = (bf16*)(F.ws + WS_U); float* dec = (float*)(F.ws + WS_DEC);
    LAS unsigned char* VT = F.lds + RING_OFF; LAS unsigned char* KET = VT + 128 * HG_VT_STRIDE; LAS float* tot = (LAS float*)(KET + 128 * HG_VT_STRIDE);
    const int wave = F.wave, lane = F.lane, c32 = lane & 31, hi = lane >> 5;
    unsigned fwn[8], vwn[8]; f32x2v lbn[2];
#define HG_A1_LOAD(uu) do { const int bh_ = (uu) >> 6, c_ = (uu) & 63; const size_t rb_ = ((size_t)(bh_ >> 3) * SEQ + 64 * c_) * MW + (bh_ & 7) * HD + (size_t)(8 * wave) * MW + 2 * lane; \
        lbn[0] = *(const f32x2v*)(F.in[4] + (bh_ & 7) * HD + 2 * lane); lbn[1] = *(const f32x2v*)(F.in[4] + MW + (bh_ & 7) * HD + 2 * lane); \
        _Pragma("unroll") for (int i = 0; i < 8; ++i) { fwn[i] = *(const unsigned*)(FB + rb_ + (size_t)i * MW); vwn[i] = *(const unsigned*)(IB + rb_ + (size_t)i * MW); } } while (0)
    if (F.vcu < BATCH * NH * 64) HG_A1_LOAD(F.vcu);
    for (int u = F.vcu; u < BATCH * NH * 64; u += F.G) {
        const int bh = u >> 6, c = u & 63, b = bh >> 3, h = bh & 7;
        const float lb0 = sig2(lbn[0].x - lbn[1].x), lb1 = sig2(lbn[0].y - lbn[1].y);
        unsigned vw[8], fw[8];
#pragma unroll
        for (int i = 0; i < 8; ++i) { vw[i] = vwn[i]; fw[i] = fwn[i]; }
        if (u + F.G < BATCH * NH * 64) HG_A1_LOAD(u + F.G);
        float bl[8][2], kk[8][2], blast[2], bmid[2];
        hg_pre(fw, lb0, lb1, tot, wave, lane, bl, kk, blast, bmid);
        float ke[8][2], vv[8][2];
#pragma unroll
        for (int i = 0; i < 8; ++i) { ke[i][0] = kk[i][0] * ex2(blast[0] - bl[i][0]); ke[i][1] = kk[i][1] * ex2(blast[1] - bl[i][1]); vv[i][0] = bflo(vw[i]); vv[i][1] = bfhi(vw[i]); }
#pragma unroll
        for (int j = 0; j < 2; ++j) { *(LAS v4u*)(KET + (2 * lane + j) * HG_VT_STRIDE + 16 * wave) = pack8col(ke, j); *(LAS v4u*)(VT + (2 * lane + j) * HG_VT_STRIDE + 16 * wave) = pack8col(vv, j); }
        if (wave == 0) *(f32x2v*)(dec + (size_t)u * 128 + 2 * lane) = (f32x2v){ex2(blast[0]), ex2(blast[1])};
        __syncthreads();
        const int vt = wave >> 1, kt0 = 2 * (wave & 1);
        bf16x8 a[4];
#pragma unroll
        for (int ks = 0; ks < 4; ++ks) a[ks] = *(const LAS bf16x8*)(VT + (32 * vt + c32) * HG_VT_STRIDE + (16 * ks + 8 * hi) * 2);
        LAS bf16* stg = (LAS bf16*)(F.lds + RING_OFF + 40960 + wave * 4608);
#pragma unroll
        for (int kq = 0; kq < 2; ++kq) { const int kt = kt0 + kq; f32x16 acc = {};
#pragma unroll
            for (int ks = 0; ks < 4; ++ks) { const bf16x8 bq = *(const LAS bf16x8*)(KET + (32 * kt + c32) * HG_VT_STRIDE + (16 * ks + 8 * hi) * 2); acc = __builtin_amdgcn_mfma_f32_32x32x16_bf16(a[ks], bq, acc, 0, 0, 0); }
#pragma unroll
            for (int r = 0; r < 16; ++r) stg[crow32(r, hi) * 72 + 32 * kq + c32] = f2bf_m(acc[r]); }
        LDS_WAIT(); asm volatile("" ::: "memory");
        { bf16* dst = UT + (size_t)u * 16384 + (size_t)(32 * vt) * 128 + 64 * (wave & 1); const int row = lane >> 3, ch = lane & 7;
#pragma unroll
          for (int q = 0; q < 4; ++q) { const v4u o = *(const LAS v4u*)((LAS unsigned char*)stg + (8 * q + row) * 144 + 16 * ch); *(v4u*)(dst + (size_t)(8 * q + row) * 128 + 8 * ch) = o; } }
        __syncthreads();
    }
}
__device__ __forceinline__ void hgrn_scan(Frame& F) {
    const bf16* UT = (const bf16*)(F.ws + WS_U); bf16* ST = (bf16*)(F.ws + WS_S); const float* dec = (const float*)(F.ws + WS_DEC);
    for (int g = F.vcu * NWAVES * 64 + F.tid; g < BATCH * NH * 4096; g += F.G * NWAVES * 64) {
        const int bh = g >> 12, e = g & 4095, k0 = (e * 4) & 127;
        const bf16* up = UT + (size_t)bh * 64 * 16384 + e * 4; bf16* sp = ST + (size_t)bh * 64 * 16384 + e * 4; const float* dp = dec + (size_t)bh * 64 * 128 + k0;
        float s0 = 0.f, s1 = 0.f, s2 = 0.f, s3 = 0.f;
#pragma unroll 1
        for (int c0 = 0; c0 < 64; c0 += 16) {
            v2u uw[16]; f32x4 d[16];
#pragma unroll
            for (int j = 0; j < 16; ++j) { uw[j] = *(const v2u*)(up + (size_t)(c0 + j) * 16384); d[j] = *(const f32x4*)(dp + (c0 + j) * 128); }
            __builtin_amdgcn_sched_barrier(0);
#pragma unroll
            for (int j = 0; j < 16; ++j) {
                v2u sw; sw.x = pk2(s0, s1); sw.y = pk2(s2, s3); *(v2u*)(sp + (size_t)(c0 + j) * 16384) = sw;
                s0 = d[j].x * s0 + bflo(uw[j].x); s1 = d[j].y * s1 + bfhi(uw[j].x); s2 = d[j].z * s2 + bflo(uw[j].y); s3 = d[j].w * s3 + bfhi(uw[j].y); }
        }
    }
}
__device__ __forceinline__ void hgrn_scan_item(Frame& F, int it, unsigned* cnt) {
    const bf16* UT = (const bf16*)(F.ws + WS_U); const float* dec = (const float*)(F.ws + WS_DEC);
    const __amdgpu_buffer_rsrc_t rsS = __builtin_amdgcn_make_buffer_rsrc((void*)(F.ws + WS_S), 0, 64 * 1024 * 1024, 0x00020000);
    int tid = F.tid; asm volatile("" : "+v"(tid));
    const int g = it * (NWAVES * 64) + tid, bh = g >> 12, e = g & 4095, k0 = (e * 4) & 127;
    const bf16* up = UT + (size_t)bh * 64 * 16384 + e * 4; const float* dp = dec + (size_t)bh * 64 * 128 + k0; const int sbyte = (bh * 64 * 16384 + e * 4) * 2;
    float s0 = 0.f, s1 = 0.f, s2 = 0.f, s3 = 0.f;
#pragma unroll 1
    for (int c0 = 0; c0 < 64; c0 += 16) {
        v2u uw[16]; f32x4 d[16];
#pragma unroll
        for (int j = 0; j < 16; ++j) { uw[j] = *(const v2u*)(up + (size_t)(c0 + j) * 16384); d[j] = *(const f32x4*)(dp + (c0 + j) * 128); }
        __builtin_amdgcn_sched_barrier(0);
#pragma unroll
        for (int j = 0; j < 16; ++j) {
            v2u sw; sw.x = pk2(s0, s1); sw.y = pk2(s2, s3); __builtin_amdgcn_raw_buffer_store_b64(sw, rsS, sbyte + (c0 + j) * 32768, 0, 16);
            s0 = d[j].x * s0 + bflo(uw[j].x); s1 = d[j].y * s1 + bfhi(uw[j].x); s2 = d[j].z * s2 + bflo(uw[j].y); s3 = d[j].w * s3 + bfhi(uw[j].y); }
    }
    asm volatile("s_waitcnt vmcnt(0)" ::: "memory");
    if ((tid & 63) == 0) __hip_atomic_fetch_add(cnt + 64 * bh, 1u, __ATOMIC_RELAXED, __HIP_MEMORY_SCOPE_AGENT);
}
__device__ __forceinline__ void hgrn_a2(Frame& F, int u0, int ustep, int uend) {
    const bf16* QB = (const bf16*)(F.ws + WS_HG); const bf16* FB = QB + (size_t)T * MW; const bf16* IB = FB + (size_t)T * MW; const bf16* GB = IB + (size_t)T * MW;
    const bf16* ST = (const bf16*)(F.ws + WS_S); OAB_t* obn = (OAB_t*)(F.ws + WS_OAB) + MW;
    LAS unsigned char* QE = F.lds + RING_OFF; LAS unsigned char* KD = QE + 64 * HG_QK_STRIDE; LAS unsigned char* QBL = KD + 64 * HG_QK_STRIDE; LAS unsigned char* VT = QBL + 64 * HG_QK_STRIDE;
    LAS unsigned char* AL = VT + 128 * HG_VT_STRIDE; LAS float* OL = (LAS float*)(AL + 64 * HG_VT_STRIDE); LAS float* tot = OL + 64 * HG_OL_STRIDE;
    const int wave = F.wave;
#pragma unroll 1
    for (int u = u0; u < uend; u += ustep) {
        int tid_ = F.tid; asm volatile("" : "+v"(tid_)); const int lane = tid_ & 63, c32 = lane & 31, hi = lane >> 5;
        const int bh = u >> 6, c = u & 63, b = bh >> 3, h = bh & 7; const size_t rowbase = ((size_t)b * SEQ + 64 * c) * MW + h * HD;
        const float lb0 = lb_of(F.in[4], h * HD + 2 * lane), lb1 = lb_of(F.in[4], h * HD + 2 * lane + 1);
        const int tt = wave >> 2, vt = wave & 3;
        bf16x8 st[8];
#pragma unroll
        for (int ks = 0; ks < 8; ++ks) st[ks] = *(const bf16x8*)(ST + (size_t)u * 16384 + (size_t)(32 * vt + c32) * 128 + 16 * ks + 8 * hi);
        unsigned qw[8], vw[8], gw[8], fw[8];
#pragma unroll
        for (int i = 0; i < 8; ++i) { const size_t o = rowbase + (size_t)(8 * wave + i) * MW + 2 * lane; fw[i] = *(const unsigned*)(FB + o); qw[i] = *(const unsigned*)(QB + o); vw[i] = *(const unsigned*)(IB + o); gw[i] = *(const unsigned*)(GB + o); }
        float bl[8][2], kk[8][2], blast[2], bmid[2];
        hg_pre(fw, lb0, lb1, tot, wave, lane, bl, kk, blast, bmid);
        { float vv[8][2];
#pragma unroll
          for (int i = 0; i < 8; ++i) { const int t = 8 * wave + i; const float q0 = bflo(qw[i]), q1 = bfhi(qw[i]);
              *(LAS unsigned*)(QE + t * HG_QK_STRIDE + 4 * lane) = pk2(q0 * ex2(bl[i][0] - bmid[0]), q1 * ex2(bl[i][1] - bmid[1]));
              *(LAS unsigned*)(KD + t * HG_QK_STRIDE + 4 * lane) = pk2(kk[i][0] * ex2(bmid[0] - bl[i][0]), kk[i][1] * ex2(bmid[1] - bl[i][1]));
              *(LAS unsigned*)(QBL + t * HG_QK_STRIDE + 4 * lane) = pk2(q0 * ex2(bl[i][0]), q1 * ex2(bl[i][1]));
              vv[i][0] = bflo(vw[i]); vv[i][1] = bfhi(vw[i]); }
#pragma unroll
          for (int j = 0; j < 2; ++j) *(LAS v4u*)(VT + (2 * lane + j) * HG_VT_STRIDE + 16 * wave) = pack8col(vv, j); }
        __syncthreads();
        if (wave < 3) { const int ta = wave >= 1, sa = wave == 2; f32x16 acc = {};
#pragma unroll
            for (int ks = 0; ks < 8; ++ks) { const bf16x8 a = *(const LAS bf16x8*)(QE + (32 * ta + c32) * HG_QK_STRIDE + (16 * ks + 8 * hi) * 2), bq = *(const LAS bf16x8*)(KD + (32 * sa + c32) * HG_QK_STRIDE + (16 * ks + 8 * hi) * 2);
                acc = __builtin_amdgcn_mfma_f32_32x32x16_bf16(a, bq, acc, 0, 0, 0); }
#pragma unroll
            for (int r = 0; r < 16; ++r) { const int tl = crow32(r, hi); float v = acc[r]; if (ta == sa && c32 > tl) v = 0.f;
                *(LAS bf16*)(AL + (32 * ta + tl) * HG_VT_STRIDE + (32 * sa + c32) * 2) = f2bf_m(v); }
        } else if (wave == 3) { const int row = lane >> 1, half = lane & 1; LAS v4u* p = (LAS v4u*)(AL + row * HG_VT_STRIDE + 64 + half * 32); p[0] = (v4u){0u, 0u, 0u, 0u}; p[1] = (v4u){0u, 0u, 0u, 0u}; }
        __syncthreads();
        { f32x16 acc = {};
#pragma unroll
          for (int ks = 0; ks < 4; ++ks) { const bf16x8 a = *(const LAS bf16x8*)(AL + (32 * tt + c32) * HG_VT_STRIDE + (16 * ks + 8 * hi) * 2), bq = *(const LAS bf16x8*)(VT + (32 * vt + c32) * HG_VT_STRIDE + (16 * ks + 8 * hi) * 2);
              acc = __builtin_amdgcn_mfma_f32_32x32x16_bf16(a, bq, acc, 0, 0, 0); }
#pragma unroll
          for (int ks = 0; ks < 8; ++ks) { const bf16x8 a = *(const LAS bf16x8*)(QBL + (32 * tt + c32) * HG_QK_STRIDE + (16 * ks + 8 * hi) * 2); acc = __builtin_amdgcn_mfma_f32_32x32x16_bf16(a, st[ks], acc, 0, 0, 0); }
#pragma unroll
          for (int r = 0; r < 16; ++r) OL[(32 * tt + crow32(r, hi)) * HG_OL_STRIDE + 32 * vt + c32] = acc[r]; }
        __syncthreads();
        f32x2v o2a[8]; float ssq[8];
#pragma unroll
        for (int i = 0; i < 8; ++i) { o2a[i] = *(const LAS f32x2v*)(OL + (8 * wave + i) * HG_OL_STRIDE + 2 * lane); ssq[i] = o2a[i].x * o2a[i].x + o2a[i].y * o2a[i].y; }
#pragma unroll
        for (int i = 0; i < 8; ++i) { ssq[i] += dpp_f<0xB1>(ssq[i]); ssq[i] += dpp_f<0x4E>(ssq[i]); ssq[i] += dpp_f<0x141>(ssq[i]); ssq[i] += dpp_f<0x140>(ssq[i]); }
#pragma unroll
        for (int i = 0; i < 8; ++i) ssq[i] += __shfl_xor(ssq[i], 16);
#pragma unroll
        for (int i = 0; i < 8; ++i) ssq[i] += __shfl_xor(ssq[i], 32);
#pragma unroll
        for (int i = 0; i < 8; ++i) { const int t = 8 * wave + i; const f32x2v o2 = o2a[i];
            const float rs = __builtin_amdgcn_rsqf(ssq[i] * (1.0f / HD) + EPS); const float g0 = bflo(gw[i]), g1 = bfhi(gw[i]);
            const float y0 = o2.x * rs * g0 * sig2(g0), y1 = o2.y * rs * g1 * sig2(g1);
#if P5_F8
            { const float z0 = 16.f * y0, z1 = 16.f * y1, n0 = dpp_f<0xB1>(z0), n1 = dpp_f<0xB1>(z1);
              if ((lane & 1) == 0) *(unsigned*)(obn + ((size_t)b * SEQ + 64 * c + t) * (2 * MW) + h * HD + 2 * lane) = pg8::pk4_fp8(z0, z1, n0, n1); }
#else
            *(unsigned*)(obn + ((size_t)b * SEQ + 64 * c + t) * (2 * MW) + h * HD + 2 * lane) = pk2(y0, y1);
#endif
            }
    }
}
__device__ __forceinline__ void attn_phase_fast(Frame& F, char* lds) {
    fox::bf16* O = (fox::bf16*)(F.ws + WS_OAB);
    const float* logf = (const float*)(F.ws + WS_LOGF);
    float* cumL = (float*)(lds + fox::LDS_CUM); float* kbL = (float*)(lds + fox::LDS_KB); float* wsum = (float*)(lds + 2 * fox::SHM_V + 2 * fox::SHM_K);
    const int wave = F.wave;
    fox::Seam<fox::bf16> S;
    const fox::rsrc_t rs = __builtin_amdgcn_make_buffer_rsrc((void*)(F.ws + WS_QKV), 0, (int)(3u * (unsigned)T * MW * 2u), 0x00020000);
    for (int L = F.vcu; L < BATCH * NH * 8; L += F.G) {
        const int bh = L >> 3, y = L & 7, b = bh >> 3, h = bh & 7;
        {
            int tid = F.tid; asm volatile("" : "+v"(tid)); const int lane = tid & 63;
            const float* src = logf + (size_t)bh * SEQ + tid * 8; const f32x4 a = *(const f32x4*)src, c = *(const f32x4*)(src + 4);
            float v[8] = {a.x, a.y, a.z, a.w, c.x, c.y, c.z, c.w};
#pragma unroll
            for (int i = 1; i < 8; ++i) v[i] += v[i - 1];
            const float tot = v[7]; float inc = tot;
#pragma unroll
            for (int off = 1; off < 64; off <<= 1) { const float n = __shfl_up(inc, off); if (lane >= off) inc += n; }
            if (lane == 63) wsum[wave] = inc;
            __syncthreads();
            float pre = 0.f; for (int w = 0; w < wave; ++w) pre += wsum[w];
            const float excl = inc - tot + pre;
#pragma unroll
            for (int i = 0; i < 8; ++i) cumL[tid * 8 + i] = v[i] + excl;
            __syncthreads();
        }
        const unsigned TB = (unsigned)T * MW * 2u, hb = (unsigned)bh * SEQ * HD * 2u;
        int jlo0, jlo1;
        {   const float* nq = (const float*)(F.ctl + CW_NRM) + (size_t)bh * 4; const float* nk = nq + 32 * 4;
            const float q2 = (nq[0] + nq[1]) + (nq[2] + nq[3]), k2 = (nk[0] + nk[1]) + (nk[2] + nk[3]);
            const float thrsk = 30.0f + 2.0f * 1.02f * fox::SCALE * sqrtf(q2) * sqrtf(k2);
            int tid = F.tid; asm volatile("" : "+v"(tid)); const int lane = tid & 63;
            const int P0 = y * 256, P1 = (15 - y) * 256; const float c0 = cumL[P0], c1 = cumL[P1]; int n0 = 0, n1 = 0;
#pragma unroll
            for (int i = 0; i < 8; ++i) { const int j = tid * 8 + i; const float cj = cumL[j]; n0 += (j < P0 && cj - c0 >= thrsk) ? 1 : 0; n1 += (j < P1 && cj - c1 >= thrsk) ? 1 : 0; }
#pragma unroll
            for (int o = 1; o < 64; o <<= 1) { n0 += __shfl_xor(n0, o); n1 += __shfl_xor(n1, o); }
            int* wcnt = (int*)wsum + 8;
            if (lane == 0) { wcnt[2 * wave] = n0; wcnt[2 * wave + 1] = n1; }
            __syncthreads();
            int t0 = 0, t1 = 0;
#pragma unroll
            for (int w = 0; w < 8; ++w) { t0 += wcnt[2 * w]; t1 += wcnt[2 * w + 1]; }
            jlo0 = __builtin_amdgcn_readfirstlane(t0) >> 6; jlo1 = __builtin_amdgcn_readfirstlane(t1) >> 6;
        }
        fox::BlockRef<fox::bf16, fox::bf16> cur, nxt;
        { const int P0 = y * 256; cur.Q = hb + (unsigned)P0 * 256u; cur.K = TB + hb; cur.V = 2u * TB + hb; cur.O = O + ((size_t)(b * SEQ + P0)) * (2 * MW) + h * HD; cur.P0 = P0; cur.jlo = jlo0; }
        { const int P1 = (15 - y) * 256; nxt.Q = hb + (unsigned)P1 * 256u; nxt.K = TB + hb; nxt.V = 2u * TB + hb; nxt.O = O + ((size_t)(b * SEQ + P1)) * (2 * MW) + h * HD; nxt.P0 = P1; nxt.jlo = jlo1; }
        fox::causal_swa_prime<fox::bf16, fox::bf16>(rs, cur, SEQ, lds, S);
#pragma unroll 1
        for (int pass = 0; pass < 2; ++pass) {
            {
                int tid = F.tid; asm volatile("" : "+v"(tid));
                const float cref = cumL[cur.P0]; const int j0 = tid * 8;
                if (j0 < cur.P0 + 256) {
#pragma unroll
                    for (int i = 0; i < 8; ++i) kbL[j0 + i] = (cref - cumL[j0 + i]) * (1.0f / fox::SCALE);
                }
                __syncthreads();
            }
            fox::causal_swa_block<fox::bf16, fox::bf16>(rs, cur, nxt, SEQ, SEQ, lds, S);
            cur = nxt;
        }
    }
}

constexpr int QSLOT_OFF = MISC_OFF + 64;
__device__ __forceinline__ void mixer_queue_phase(Frame& F, char* lds) {
    constexpr int NATT = BATCH * NH * 16, NCONV = (I_W13 + I_W2) / NWAVES, NMIX = NATT + NCONV, NA2 = BATCH * NH * 32, NSCAN = BATCH * NH * 8, NQ = NMIX + NA2 + NSCAN + 256;
    static_assert(NCONV * 2 == NATT * 3 && NA2 == 2 * NATT && NATT == 2 * NSCAN, "the item interleave");
    gu32* qctr = F.ctl + CW_QUEUE; volatile LAS int* qslot = (volatile LAS int*)(F.lds + QSLOT_OFF);
    OAB_t* O = (OAB_t*)(F.ws + WS_OAB);
    const float* logf = (const float*)(F.ws + WS_LOGF);
    float* cumL = (float*)(lds + fox::LDS_CUM); float* kbL = (float*)(lds + fox::LDS_KB); float* wsum = (float*)(lds + 2 * fox::SHM_V + 2 * fox::SHM_K);
    const int wave = F.wave;
    fox::Seam<fox::bf16> S;
    const fox::rsrc_t rs = __builtin_amdgcn_make_buffer_rsrc((void*)(F.ws + WS_QKV), 0, (int)(3u * (unsigned)T * MW * 2u), 0x00020000);
    int cached_bh = -1; unsigned scan_mask = 0u; bool conv_done = false;
    unsigned mine = 0u;
    if (F.tid == 0) mine = __hip_atomic_fetch_add(qctr, 1u, RLX_AGENT);
#pragma unroll 1
    for (;;) {
        { int tid = F.tid; asm volatile("" : "+v"(tid)); if (tid == 0) qslot[0] = (int)mine; }
        __syncthreads();
        const int idx = __builtin_amdgcn_readfirstlane(qslot[0]);
        __syncthreads();
        if (idx >= NQ) break;
        { int tid = F.tid; asm volatile("" : "+v"(tid)); if (tid == 0) mine = __hip_atomic_fetch_add(qctr, 1u, RLX_AGENT); }
        int kind, sub, a2u0 = 0, a2u1 = 0;
        if (idx < 4 * NSCAN) { const int per = idx >> 2, sl = idx & 3; kind = sl == 0 ? 3 : (sl == 2 ? 1 : 0); sub = sl == 0 ? per : (sl == 1 ? 2 * per : 2 * per + 1); }
        else if (idx < 4 * NSCAN + 1152) { const int r = idx - 4 * NSCAN, per = r / 3, sl = r - 3 * per; kind = sl == 0 ? 1 : 2; sub = 2 * per + (sl - 1); a2u0 = 2 * sub; a2u1 = a2u0 + 2; }
        else { const int r = idx - (4 * NSCAN + 1152), per = r / 5, sl = r - 5 * per; kind = sl == 0 ? 1 : 2; a2u0 = 1536 + 4 * per + (sl - 1); a2u1 = a2u0 + 1; sub = a2u0 >> 1; }
        if (kind == 3) { hgrn_scan_item(F, sub, (unsigned*)(F.ctl + CW_SCAN)); continue; }
        if (kind == 2) {
            const int bh2 = sub >> 5;
            if (!((scan_mask >> bh2) & 1u)) {
                int tid = F.tid; asm volatile("" : "+v"(tid));
                if (tid < 64) { unsigned polls = 0, m;
                    for (;;) { const unsigned v = (tid < 32) ? __hip_atomic_load(F.ctl + CW_SCAN + 64 * tid, RLX_AGENT) : 0u; m = (unsigned)__ballot(tid < 32 && v >= 64u);
                        if (((m >> bh2) & 1u) || ++polls > (1u << 18)) break; __builtin_amdgcn_s_sleep(8); }
                    __builtin_amdgcn_fence(__ATOMIC_ACQUIRE, "agent");
                    asm volatile("s_waitcnt vmcnt(0)" ::: "memory");
                    if (tid == 0) qslot[2] = (int)m; }
                __syncthreads(); scan_mask |= (unsigned)__builtin_amdgcn_readfirstlane(qslot[2]) | (1u << bh2); __syncthreads();
            }
            hgrn_a2(F, a2u0, 1, a2u1); cached_bh = -1; continue; }
        if (kind == 1) {
            if (conv_done) continue;
            int tid = F.tid; asm volatile("" : "+v"(tid));
            if (tid == 0) qslot[1] = (int)__hip_atomic_fetch_add(F.ctl + CW_CONVQ, 1u, RLX_AGENT);
            __syncthreads(); const int ci = __builtin_amdgcn_readfirstlane(qslot[1]); __syncthreads();
            conv_done = ci >= NCONV;
            if (ci < NCONV) cvt8_moe_item(F.in, F.ws, ci * NWAVES + wave, (LAS unsigned*)(F.lds + RING_OFF) + wave * (64 * 33), (LAS float*)(F.lds + PARK_OFF) + wave * 128, tid & 63);
            continue; }
        const int ai = sub;
        const int bh = ai & 31, qb = 15 - (ai >> 5), b = bh >> 3, h = bh & 7, P0 = qb * 256;
        if (bh != cached_bh) {
            cached_bh = bh;
            int tid = F.tid; asm volatile("" : "+v"(tid)); const int lane = tid & 63;
            const float* src = logf + (size_t)bh * SEQ + tid * 8; const f32x4 a = *(const f32x4*)src, c = *(const f32x4*)(src + 4);
            float v[8] = {a.x, a.y, a.z, a.w, c.x, c.y, c.z, c.w};
#pragma unroll
            for (int i = 1; i < 8; ++i) v[i] += v[i - 1];
            const float tot = v[7]; float inc = tot;
#pragma unroll
            for (int off = 1; off < 64; off <<= 1) { const float n = __shfl_up(inc, off); if (lane >= off) inc += n; }
            if (lane == 63) wsum[wave] = inc;
            __syncthreads();
            float pre = 0.f; for (int w = 0; w < wave; ++w) pre += wsum[w];
            const float excl = inc - tot + pre;
#pragma unroll
            for (int i = 0; i < 8; ++i) cumL[tid * 8 + i] = v[i] + excl;
            __syncthreads();
        }
        const unsigned TB = (unsigned)T * MW * 2u, hb = (unsigned)bh * SEQ * HD * 2u;
        int jlo0;
        {
            const float* nk = (const float*)(F.ctl + CW_NRM) + (size_t)(32 + bh) * 4; const float k2 = (nk[0] + nk[1]) + (nk[2] + nk[3]);
            int tid = F.tid; asm volatile("" : "+v"(tid)); const int lane = tid & 63;
            const float c0 = cumL[P0];
            float amax;
            {   const int row = tid >> 1, half = tid & 1;
                const v4u* qp = (const v4u*)(F.ws + WS_QKV + hb + (size_t)(P0 + row) * 256 + half * 128); const v4u* kp = (const v4u*)((const unsigned char*)qp + TB);
                float qq = 0.f, qk = 0.f;
#pragma unroll
                for (int i = 0; i < 8; ++i) { const v4u a = qp[i], k = kp[i];
                    qq += (bflo(a.x) * bflo(a.x) + bfhi(a.x) * bfhi(a.x)) + (bflo(a.y) * bflo(a.y) + bfhi(a.y) * bfhi(a.y)) + (bflo(a.z) * bflo(a.z) + bfhi(a.z) * bfhi(a.z)) + (bflo(a.w) * bflo(a.w) + bfhi(a.w) * bfhi(a.w));
                    qk += (bflo(a.x) * bflo(k.x) + bfhi(a.x) * bfhi(k.x)) + (bflo(a.y) * bflo(k.y) + bfhi(a.y) * bfhi(k.y)) + (bflo(a.z) * bflo(k.z) + bfhi(a.z) * bfhi(k.z)) + (bflo(a.w) * bflo(k.w) + bfhi(a.w) * bfhi(k.w)); }
                qq += dpp_f<0xB1>(qq); qk += dpp_f<0xB1>(qk);
                float a = 1.02f * fox::SCALE * __builtin_amdgcn_sqrtf(qq) * __builtin_amdgcn_sqrtf(k2) - fox::SCALE * qk + (cumL[P0 + row] - c0);
                a = wave_fmax(a);
                if (lane == 0) wsum[16 + wave] = a;
                __syncthreads();
                amax = wsum[16];
#pragma unroll
                for (int w = 1; w < 8; ++w) amax = fmaxf(amax, wsum[16 + w]);
            }
            const float thrsk = SKIP_T0 + amax;
            int n0 = 0;
#pragma unroll
            for (int i = 0; i < 8; ++i) { const int j = tid * 8 + i; n0 += (j < P0 && cumL[j] - c0 >= thrsk) ? 1 : 0; }
            n0 = wave_isum(n0);
            int* wcnt = (int*)wsum + 8;
            if (lane == 0) wcnt[wave] = n0;
            __syncthreads();
            int t0 = 0;
#pragma unroll
            for (int w = 0; w < 8; ++w) t0 += wcnt[w];
            jlo0 = __builtin_amdgcn_readfirstlane(t0) >> 6;
        }
        fox::BlockRef<fox::bf16, OAB_t> cur;
        cur.Q = hb + (unsigned)P0 * 256u; cur.K = TB + hb; cur.V = 2u * TB + hb; cur.O = O + ((size_t)(b * SEQ + P0)) * (2 * MW) + h * HD; cur.P0 = P0; cur.jlo = jlo0;
        fox::causal_swa_prime<fox::bf16, OAB_t>(rs, cur, SEQ, lds, S);
        {
            int tid = F.tid; asm volatile("" : "+v"(tid));
            const float cref = cumL[P0]; const int j0 = tid * 8;
            if (j0 < P0 + 256) {
#pragma unroll
                for (int i = 0; i < 8; ++i) kbL[j0 + i] = (cref - cumL[j0 + i]) * (1.0f / fox::SCALE);
            }
            __syncthreads();
        }
        fox::causal_swa_block<fox::bf16, OAB_t>(rs, cur, cur, SEQ, SEQ, lds, S);
    }
}

__device__ __forceinline__ void p1_converter(Frame& F) {
    constexpr int NCONV = (I_W13 + I_W2) / NWAVES; volatile LAS int* qslot = (volatile LAS int*)(F.lds + MISC_OFF + 64);
#pragma unroll 1
    for (;;) {
        int tid = F.tid; asm volatile("" : "+v"(tid));
        if (tid == 0) { const unsigned stop = __hip_atomic_load(F.ctl + CW_P1STOP, RLX_AGENT); qslot[1] = stop ? NCONV : (int)__hip_atomic_fetch_add(F.ctl + CW_CONVQ, 1u, RLX_AGENT); }
        __syncthreads(); const int ci = __builtin_amdgcn_readfirstlane(qslot[1]); __syncthreads();
        if (ci >= NCONV) break;
        cvt8_moe_item(F.in, F.ws, ci * NWAVES + F.wave, (LAS unsigned*)(F.lds + RING_OFF) + F.wave * (64 * 33), (LAS float*)(F.lds + PARK_OFF) + F.wave * 128, tid & 63);
    }
}

#ifndef MK_N_LAUNCHES
#define MK_N_LAUNCHES 1
#endif
constexpr int PER_PHASE = 12;
constexpr int N_LAUNCHES = MK_N_LAUNCHES;
static_assert(N_LAUNCHES == 1 || N_LAUNCHES == PER_PHASE, "MK_N_LAUNCHES is 1 or 12");
__device__ __forceinline__ bool fresh(Frame& F) { int t_ = threadIdx.x; asm volatile("" : "+v"(t_)); F.tid = t_; F.lane = t_ & 63; return true; }
struct Args { const float* in[18]; float* out; unsigned char* ws; int ph_lo, ph_hi, li, pad; };
__global__ void __launch_bounds__(NWAVES * 64, 2) fwd_kernel(Args args) {
    extern __shared__ __attribute__((aligned(16))) unsigned char lds[];
    Frame F;
    F.lds = (LAS unsigned char*)lds;
    F.MISC = (volatile LAS unsigned*)(F.lds + MISC_OFF);
    F.tid = threadIdx.x; F.lane = F.tid & 63; F.wave = __builtin_amdgcn_readfirstlane(F.tid >> 6);
    F.G = gridDim.x; { const int bx = blockIdx.x; F.vcu = (F.G % 8 == 0) ? (bx % 8) * (F.G / 8) + bx / 8 : bx; }
    F.ws = args.ws; F.ctl = (gu32*)(args.ws + WS_CTL); F.out = args.out;
    F.in = args.in;
    for (int u = F.tid; u < (LDS_BYTES - LDSCTL_OFF) / 4; u += NWAVES * 64) ((LAS unsigned*)(F.lds + LDSCTL_OFF))[u] = 0u;
    __syncthreads();
    XcdBarrier bar; bar.bar = (unsigned*)(F.ctl + CW_BAR); bar.x = 0; bar.st = nullptr;
    if (N_LAUNCHES != PER_PHASE) bar = xcd_barrier_post((unsigned*)(F.ctl + CW_BAR), F.MISC + 8);
#define GRID_BAR() do { if (N_LAUNCHES != PER_PHASE) xcd_barrier(bar); } while (0)
    const int lo = args.ph_lo, hi = args.ph_hi;
#ifndef PHASE_MASK
#define PHASE_MASK 0xfff
#endif
#define IN(k) (((PHASE_MASK >> (k)) & 1) && lo <= (k) && (k) < hi && fresh(F))
#ifndef DUP_MASK
#define DUP_MASK 0
#endif
#define REP(k) for (int rep_ = 0; rep_ < (((DUP_MASK >> (k)) & 1) ? 2 : 1); ++rep_)
    unsigned char* ws = args.ws;
    bf16* const HG = (bf16*)(ws + WS_HG); bf16* const GT = (bf16*)(ws + WS_GT);

    if (IN(0)) REP(0) { p0_prologue(F); GRID_BAR(); }
    if (IN(1)) REP(1) {
        const int GC = (F.G >= 128 && F.G % 8 == 0) ? P1_CONV_WGS : 0, Gg = F.G - GC;
        if ((int)blockIdx.x < Gg) {
            { pg8::Gemm g{(const bf16*)(ws + WS_XB), (const bf16*)(ws + WS_WIN), T, NPROJ16, DM, ws}; pg8::StaticOrder S; S.init(T, NPROJ16, Gg, (int)blockIdx.x);
              pg8::EpiProj E{(bf16*)(ws + WS_QKV), HG, GT, (const float*)(ws + WS_RSTD1), (unsigned*)(F.ctl + CW_NRM)};
              pg8::gemm_phase<pg8::EpiProj, pg8::StaticOrder, true, true>(F.lds + RING_OFF, g, S, E); }
            { pg8::Gemm g{(const bf16*)(ws + WS_X8), (const bf16*)(ws + WS_WIN8), T, NPROJ8, DM / 2, ws}; pg8::StaticOrderSig S; S.init_sig(T, NPROJ8, Gg, (int)blockIdx.x, (unsigned*)(F.ctl + CW_P1STOP));
              pg8::EpiProjG8 E{GT, (const float*)(ws + WS_RSTD1), (bf16*)(ws + WS_QKV), HG};
              pg8::gemm_phase<pg8::EpiProjG8, pg8::StaticOrderSig, true, true, false, true>(F.lds + RING_OFF, g, S, E); }
        } else p1_converter(F);
        GRID_BAR();
    }
    if (IN(2)) REP(2) { hgrn_a1(F); GRID_BAR(); }
    if (IN(4)) { mixer_queue_phase(F, (char*)lds); GRID_BAR(); }
    if (IN(5)) REP(5) {
        pg8::Gemm g{(const bf16*)(ws + WS_OAB), (const bf16*)(ws + WS_PAB), T, DM, P5_F8 ? DM / 2 : DM, ws}; pg8::StaticOrder S; S.init(T, DM, F.G, (int)blockIdx.x);
        typedef pg8::EpiGate2T<P5_F8 != 0, P6_F8 != 0> EG; EG E{(bf16*)(ws + WS_MRG), GT, GT + (size_t)T * DM};
        pg8::gemm_phase<EG, pg8::StaticOrder, true, true, false, P5_F8 != 0>(F.lds + RING_OFF, g, S, E);
        GRID_BAR();
    }
    if (IN(6)) REP(6) {
        pg8::Gemm g{(const bf16*)(ws + WS_MRG), (const bf16*)(ws + WS_WOUT), T, DM, P6_F8 ? DM / 2 : DM, ws}; pg8::StaticOrder S; S.init(T, DM, F.G, (int)blockIdx.x);
        typedef pg8::EpiResid8T<P6_F8 != 0> ER; ER E{(bf16*)(ws + WS_X1B), (const bf16*)(ws + WS_XB), ws + WS_X1F8};
        pg8::gemm_phase<ER, pg8::StaticOrder, true, true, false, P6_F8 != 0>(F.lds + RING_OFF, g, S, E);
        GRID_BAR();
    }
    if (IN(7)) { router_phase(F); GRID_BAR(); }
#ifdef MOE_XBUF
    if (IN(8)) REP(8) { moe_tables(F); gather_phase(F); GRID_BAR(); }
#endif
    if (IN(9)) REP(9) {
        moe_tables(F);
        const LAS int* tab = (const LAS int*)(F.lds + MOE_TAB_OFF);
#ifdef MOE_XBUF
        pg8::Gemm g{(const bf16*)(ws + WS_XBUF), (const bf16*)(ws + WS_W13), MAXROWS, 2048, DM, ws};
        pg8::MoeOrder S{tab[33], F.G, (int)blockIdx.x, 8, tab + 34};
        pg8::EpiMoe1 E{(bf16*)(ws + WS_HBUF), (const float*)(ws + WS_ROWSCALE)};
        pg8::gemm_phase<pg8::EpiMoe1, pg8::MoeOrder, true, true>(F.lds + RING_OFF, g, S, E);
#else
        pg8::Gemm g{(const bf16*)(ws + WS_X1F8), (const bf16*)(ws + WS_W13), T, 2048, DM / 2, ws};
        pg8::MoeGatherOrder S{tab[33], F.G, (int)blockIdx.x, 8, tab, (const int*)(ws + WS_TLIST), (LAS unsigned*)(F.lds + PARK_OFF), (unsigned*)(F.ctl + CW_HB), -1};
        pg8::EpiMoe1G8 E{ws + WS_HBUF, (const float*)(ws + WS_SLOTRS), tab};
        pg8::gemm_phase<pg8::EpiMoe1G8, pg8::MoeGatherOrder, true, true, true, true>(F.lds + RING_OFF, g, S, E);
        S.flush();
#endif
    }
    if (IN(10)) REP(10) {
        if (N_LAUNCHES == PER_PHASE) moe_tables(F);
        const LAS int* tab = (const LAS int*)(F.lds + MOE_TAB_OFF);
        pg8::Gemm g{(const bf16*)(ws + WS_HBUF), (const bf16*)(ws + WS_W2), MAXROWS, 2048, DFF / 2, ws};
        const int n1 = tab[33] * 8, cb = (int)blockIdx.x, i0 = cb < n1 ? (n1 - cb + F.G - 1) / F.G : 0;
        pg8::MoeCountedOrder S{tab[33], F.G, cb, i0, n1, 8, tab + 34, (const unsigned*)(F.ctl + CW_HB), (volatile LAS int*)(F.lds + QSLOT_OFF) + 3, 0u};
        pg8::EpiPlainS8 E{ws + WS_YBUF, DM, 32.0f / 2048.0f};
        pg8::gemm_phase<pg8::EpiPlainS8, pg8::MoeCountedOrder, true, true, false, true>(F.lds + RING_OFF, g, S, E);
        GRID_BAR();
    }
    if (IN(11)) REP(11) { if (N_LAUNCHES == PER_PHASE) moe_tables(F); final_phase(F); }
#undef IN
}

extern "C" void kernel_launch(void* const* d_in, const int* in_sizes, int n_in, void* d_out, int out_size, void* d_ws, size_t ws_size, hipStream_t stream) {
    static int grid = 0;
    if (grid == 0) {
        if (n_in != 18 || in_sizes[0] != T * DM || out_size != T * DM || ws_size < WS_END) { fprintf(stderr, "kernel_launch: unexpected shapes (n_in %d, in0 %d, out %d, ws %zu)\n", n_in, n_in > 0 ? in_sizes[0] : -1, out_size, ws_size); grid = -1; return; }
        int dev = 0, cus = 0, per_cu = 0;
        if (hipGetDevice(&dev) != hipSuccess || hipDeviceGetAttribute(&cus, hipDeviceAttributeMultiprocessorCount, dev) != hipSuccess) { grid = -1; return; }
        if (hipFuncSetAttribute((const void*)fwd_kernel, hipFuncAttributeMaxDynamicSharedMemorySize, LDS_BYTES) != hipSuccess) { fprintf(stderr, "kernel_launch: hipFuncSetAttribute failed\n"); grid = -1; return; }
        if (hipOccupancyMaxActiveBlocksPerMultiprocessor(&per_cu, (const void*)fwd_kernel, NWAVES * 64, LDS_BYTES) != hipSuccess || per_cu < 1) fprintf(stderr, "kernel_launch: occupancy query says %d\n", per_cu);
        (void)hipGetLastError();
        grid = cus - (cus % 8);
        if (grid <= 0) grid = 8;
    }
    if (grid < 0) return;
    if (hipMemsetAsync((char*)d_ws + WS_CTL, 0, CTL_ZERO_BYTES, stream) != hipSuccess) return;
    Args a{};
    for (int i = 0; i < 18; ++i) a.in[i] = (const float*)d_in[i];
    a.out = (float*)d_out; a.ws = (unsigned char*)d_ws;
    for (int li = 0; li < N_LAUNCHES; ++li) {
        a.ph_lo = (N_LAUNCHES == PER_PHASE) ? li : 0; a.ph_hi = (N_LAUNCHES == PER_PHASE) ? li + 1 : PER_PHASE; a.li = li; a.pad = 0;
        hipLaunchKernelGGL(fwd_kernel, dim3(grid), dim3(NWAVES * 64), LDS_BYTES, stream, a);
    }
}
```
